# Optimizing an MI355X kernel written in HIP

```python
import math
import jax
import jax.numpy as jnp
from jax import lax
import numpy as np

D_MODEL = 1024
BATCH = 8
SEQ = 2048
DEPTH = 2

GRID_W = 64
CTX_LEN = 256

HG_HEADS = 4
HG_DK = 128
HG_DV = 128
RET_HEADS = 4
RET_DK = 64
RET_DV = 128
GQA_HEADS = 4
GQA_KV_HEADS = 2
GQA_HD = 128
DIFF_HEADS = 4
DIFF_HD = 64

N_EXPERTS = 32
TOP_K = 4
D_EXPERT = D_MODEL
SWIGLU_LIMIT = 7.0
SWIGLU_ALPHA = 1.702

CHUNK = 64
Q_BLOCK = 128
MOE_BLOCK = 256
ROPE_THETA = 10000.0
NORM_EPS = 1e-6

N_REC_LAYERS = (DEPTH + 1) // 2
N_ATT_LAYERS = DEPTH // 2

HG_W = HG_HEADS * HG_DK
REC_SPLITS = (HG_W, HG_W, HG_W, HG_HEADS * HG_DV, HG_HEADS * HG_DV,
              RET_HEADS * RET_DK, RET_HEADS * RET_DK, RET_HEADS * RET_DV, RET_HEADS * RET_DV)
REC_IN = sum(REC_SPLITS)
REC_MIX = HG_HEADS * HG_DV + RET_HEADS * RET_DV
ATT_SPLITS = (GQA_HEADS * GQA_HD, GQA_KV_HEADS * GQA_HD, GQA_KV_HEADS * GQA_HD,
              DIFF_HEADS * 2 * DIFF_HD, DIFF_HEADS * 2 * DIFF_HD, DIFF_HEADS * 2 * DIFF_HD)
ATT_IN = sum(ATT_SPLITS)
ATT_MIX = GQA_HEADS * GQA_HD + DIFF_HEADS * 2 * DIFF_HD

kernel_name = 'hybrid_flow_backbone'

F32 = jnp.float32


def rms_norm(x, gain):
    xf = x.astype(F32)
    y = xf * lax.rsqrt(jnp.mean(xf * xf, axis=-1, keepdims=True) + NORM_EPS)
    return (y * gain.astype(F32)).astype(x.dtype)


def head_group_norm(x, gain):
    xf = x.astype(F32)
    xc = xf - jnp.mean(xf, axis=-1, keepdims=True)
    y = xc * lax.rsqrt(jnp.mean(xc * xc, axis=-1, keepdims=True) + NORM_EPS)
    return (y * gain.astype(F32)).astype(x.dtype)


def _split(x, sizes):
    cuts = [int(s) for s in np.cumsum(sizes)[:-1]]
    return jnp.split(x, cuts, axis=-1)


def _heads(x, n_heads):
    b, t, _ = x.shape
    return x.reshape(b, t, n_heads, -1).transpose(0, 2, 1, 3)


def _unheads(x):
    b, h, t, d = x.shape
    return x.transpose(0, 2, 1, 3).reshape(b, t, h * d)


def axial_rope(n_tok, head_dim):
    rows = n_tok // GRID_W
    row = jnp.broadcast_to(jnp.arange(rows, dtype=F32)[:, None], (rows, GRID_W)).reshape(-1)
    col = jnp.broadcast_to(jnp.arange(GRID_W, dtype=F32)[None, :], (rows, GRID_W)).reshape(-1)
    axis_dim = head_dim // 2
    inv_freq = ROPE_THETA ** (-jnp.arange(0, axis_dim, 2, dtype=F32) / axis_dim)
    ang = jnp.concatenate([row[:, None] * inv_freq, col[:, None] * inv_freq], axis=-1)
    return jnp.cos(ang), jnp.sin(ang)


def apply_rope(x, cos, sin):
    xf = x.astype(F32).reshape(*x.shape[:-1], -1, 2)
    x1, x2 = xf[..., 0], xf[..., 1]
    y = jnp.stack([x1 * cos - x2 * sin, x1 * sin + x2 * cos], axis=-1)
    return y.reshape(x.shape).astype(x.dtype)


def modulation(cond, w_ada, b_ada):
    m = jax.nn.silu(cond) @ w_ada + b_ada
    return jnp.split(m[..., None, :], 6, axis=-1)


def chunk_recurrence(q, k, v, log_f, s0):
    bsz, h, t, _ = q.shape
    dv = v.shape[-1]
    n = t // CHUNK

    def rs(a):
        return a.astype(F32).reshape(a.shape[0], a.shape[1], n, CHUNK, a.shape[-1])

    q, k, v, log_f = rs(q), rs(k), rs(v), rs(log_f)
    b = jnp.cumsum(log_f, axis=3)
    b_last = b[:, :, :, -1:, :]
    q_in = q * jnp.exp(b)
    k_in = k * jnp.exp(-b)
    k_state = k * jnp.exp(b_last - b)
    mask = jnp.tril(jnp.ones((CHUNK, CHUNK), dtype=bool))
    att = jnp.where(mask, jnp.einsum('bhncd,bhnsd->bhncs', q_in, k_in), 0.0)
    o_intra = jnp.einsum('bhncs,bhnsv->bhncv', att, v)
    kv = jnp.einsum('bhnsd,bhnsv->nbhdv', k_state, v)
    decay = jnp.moveaxis(jnp.exp(b_last[:, :, :, 0, :]), 2, 0)

    def step(s, inp):
        d, kv_n = inp
        return s * d[..., None] + kv_n, s

    s_last, s_prev = lax.scan(step, s0.astype(F32), (decay, kv))
    o_inter = jnp.einsum('bhncd,nbhdv->bhncv', q_in, s_prev)
    return (o_intra + o_inter).reshape(bsz, h, t, dv), s_last


def _directional(q, k, v, log_f, s0, reverse):
    if reverse:
        fl = lambda a: jnp.flip(a, axis=2)
        o, s = chunk_recurrence(fl(q), fl(k), fl(v), fl(log_f), s0)
        return jnp.flip(o, axis=2), s
    return chunk_recurrence(q, k, v, log_f, s0)


def _to_blocks(x):
    *lead, t, d = x.shape
    return jnp.moveaxis(x.reshape(*lead, t // Q_BLOCK, Q_BLOCK, d), -3, 0)


def _from_blocks(y):
    y = jnp.moveaxis(y, 0, -3)
    *lead, nb, qb, d = y.shape
    return y.reshape(*lead, nb * qb, d)


def gqa_attend(q, k, v):
    scale = q.shape[-1] ** -0.5

    def block(qb):
        s = jnp.einsum('bkgqd,bksd->bkgqs', qb, k).astype(F32) * scale
        p = jax.nn.softmax(s, axis=-1).astype(v.dtype)
        return jnp.einsum('bkgqs,bksd->bkgqd', p, v)

    return _from_blocks(lax.map(block, _to_blocks(q)))


def diff_attend(q, k, v, lam):
    scale = q.shape[-1] ** -0.5

    def block(qb):
        s = jnp.einsum('bhiqd,bhisd->bhiqs', qb, k).astype(F32) * scale
        p = jax.nn.softmax(s, axis=-1)
        a = (p[:, :, 0] - lam * p[:, :, 1]).astype(v.dtype)
        return jnp.einsum('bhqs,bhsv->bhqv', a, v)

    return _from_blocks(lax.map(block, _to_blocks(q)))


def recurrent_mixer(a_lat, a_ctx, w_in, lb, w_out, hg_gain, ret_gain, rope_r, need_ctx):
    log_gamma = jnp.log(1.0 - 2.0 ** (-5.0 - jnp.arange(RET_HEADS, dtype=F32)))
    log_gammas = (log_gamma, log_gamma[::-1])

    def prep(a, rope):
        hq, hf_f, hf_b, hi, hg, rq, rk, rv, rg = _split(a @ w_in, REC_SPLITS)
        q = jax.nn.silu(_heads(hq, HG_HEADS).astype(F32)) * HG_DK ** -0.5
        f = tuple(_heads(lb[d] + (1.0 - lb[d]) * jax.nn.sigmoid(z.astype(F32)), HG_HEADS)
                  for d, z in enumerate((hf_f, hf_b)))
        i = _heads(hi, HG_HEADS)
        rq_h = _heads(rq, RET_HEADS)
        rk_h = _heads(rk, RET_HEADS) * RET_DK ** -0.5
        if rope is not None:
            rq_h, rk_h = apply_rope(rq_h, *rope), apply_rope(rk_h, *rope)
        return q, f, i, hg, rq_h, rk_h, _heads(rv, RET_HEADS), rg

    cq, cf, ci, cg, crq, crk, crv, crg = prep(a_ctx, None)
    lq, lf, li, lg, lrq, lrk, lrv, lrg = prep(a_lat, rope_r)
    bsz, n_ctx, n_lat = a_lat.shape[0], a_ctx.shape[1], a_lat.shape[1]
    hg_c = hg_l = ret_c = ret_l = 0.0
    for d, rev in enumerate((False, True)):
        s0 = jnp.zeros((bsz, HG_HEADS, HG_DK, HG_DV), F32)
        o, s = _directional(cq, 1.0 - cf[d], ci, jnp.log(cf[d]), s0, rev)
        if need_ctx:
            hg_c = hg_c + o
        o, _ = _directional(lq, 1.0 - lf[d], li, jnp.log(lf[d]), s, rev)
        hg_l = hg_l + o
        s0 = jnp.zeros((bsz, RET_HEADS, RET_DK, RET_DV), F32)
        dec = log_gammas[d][None, :, None, None]
        o, s = _directional(crq, crk, crv, jnp.broadcast_to(dec, (1, RET_HEADS, n_ctx, 1)), s0, rev)
        if need_ctx:
            ret_c = ret_c + o
        o, _ = _directional(lrq, lrk, lrv, jnp.broadcast_to(dec, (1, RET_HEADS, n_lat, 1)), s, rev)
        ret_l = ret_l + o

    def merge(o_hg, o_ret, g_hg, g_ret, dtype):
        y_hg = rms_norm(o_hg, hg_gain) * jax.nn.silu(_heads(g_hg, HG_HEADS).astype(F32))
        y_ret = head_group_norm(o_ret, ret_gain) * jax.nn.silu(_heads(g_ret, RET_HEADS).astype(F32))
        y = jnp.concatenate([_unheads(y_hg), _unheads(y_ret)], axis=-1).astype(dtype)
        return y @ w_out

    y_lat = merge(hg_l, ret_l, lg, lrg, a_lat.dtype)
    y_ctx = merge(hg_c, ret_c, cg, crg, a_ctx.dtype) if need_ctx else None
    return y_lat, y_ctx


def attention_mixer(a_lat, a_ctx, w_in, w_out, q_gain, k_gain, dq_gain, dk_gain, lam_params,
                    diff_gain, lam_init, rope_g, rope_d, need_ctx):
    lp = lam_params.astype(F32)
    lam = jnp.exp(jnp.sum(lp[0] * lp[1])) - jnp.exp(jnp.sum(lp[2] * lp[3])) + lam_init

    def prep(a, ropes):
        gq, gk, gv, dq, dk, dv = _split(a @ w_in, ATT_SPLITS)
        b, t, _ = a.shape
        gq = rms_norm(_heads(gq, GQA_HEADS), q_gain)
        gk = rms_norm(_heads(gk, GQA_KV_HEADS), k_gain)
        dq = rms_norm(_heads(dq, 2 * DIFF_HEADS), dq_gain)
        dk = rms_norm(_heads(dk, 2 * DIFF_HEADS), dk_gain)
        if ropes is not None:
            (cg, sg), (cd, sd) = ropes
            gq, gk = apply_rope(gq, cg, sg), apply_rope(gk, cg, sg)
            dq, dk = apply_rope(dq, cd, sd), apply_rope(dk, cd, sd)
        gq = gq.reshape(b, GQA_KV_HEADS, GQA_HEADS // GQA_KV_HEADS, t, GQA_HD)
        dq = dq.reshape(b, DIFF_HEADS, 2, t, DIFF_HD)
        dk = dk.reshape(b, DIFF_HEADS, 2, t, DIFF_HD)
        return gq, gk, _heads(gv, GQA_KV_HEADS), dq, dk, _heads(dv, DIFF_HEADS)

    cgq, cgk, cgv, cdq, cdk, cdv = prep(a_ctx, None)
    lgq, lgk, lgv, ldq, ldk, ldv = prep(a_lat, (rope_g, rope_d))
    cat = lambda u, w: jnp.concatenate([u, w], axis=-2)

    def merge(o_g, o_d, dtype):
        b, _, _, t, _ = o_g.shape
        o_g = o_g.reshape(b, GQA_HEADS, t, GQA_HD)
        o_d = rms_norm(o_d, diff_gain) * (1.0 - lam_init)
        y = jnp.concatenate([_unheads(o_g), _unheads(o_d)], axis=-1).astype(dtype)
        return y @ w_out

    y_lat = merge(gqa_attend(lgq, cat(cgk, lgk), cat(cgv, lgv)),
                  diff_attend(ldq, cat(cdk, ldk), cat(cdv, ldv), lam), a_lat.dtype)
    y_ctx = merge(gqa_attend(cgq, cgk, cgv), diff_attend(cdq, cdk, cdv, lam), a_ctx.dtype) if need_ctx else None
    return y_lat, y_ctx


def clamped_swiglu(gu):
    gate, up = jnp.split(gu, 2, axis=-1)
    gate = jnp.minimum(gate, SWIGLU_LIMIT)
    up = jnp.clip(up, -SWIGLU_LIMIT, SWIGLU_LIMIT)
    return (up + 1.0) * gate * jax.nn.sigmoid(SWIGLU_ALPHA * gate)


def moe(xf, w_router, b_router, w_gu, b_gu, w_down, b_down):
    n, d = xf.shape
    logits = (xf @ w_router + b_router).astype(F32)
    top_val, top_idx = lax.top_k(logits, TOP_K)
    gates = jax.nn.softmax(top_val, axis=-1).reshape(-1)
    flat_e = top_idx.reshape(-1)
    n_assign = n * TOP_K
    order = jnp.argsort(flat_e)
    sorted_e = flat_e[order]
    tok = order // TOP_K
    counts = jnp.zeros((N_EXPERTS,), jnp.int32).at[flat_e].add(1)
    padded = (counts + MOE_BLOCK - 1) // MOE_BLOCK * MOE_BLOCK
    pad_end = jnp.cumsum(padded)
    pad_start = pad_end - padded
    start = jnp.cumsum(counts) - counts
    dest = pad_start[sorted_e] + jnp.arange(n_assign, dtype=jnp.int32) - start[sorted_e]
    n_blocks = -(-n_assign // MOE_BLOCK) + N_EXPERTS
    row_tok = jnp.full((n_blocks * MOE_BLOCK,), n, jnp.int32).at[dest].set(tok)
    block_e = jnp.minimum(jnp.searchsorted(pad_end, jnp.arange(n_blocks, dtype=jnp.int32) * MOE_BLOCK,
                                           side='right'), N_EXPERTS - 1)
    x_rows = jnp.concatenate([xf, jnp.zeros((1, d), xf.dtype)], axis=0)[row_tok]
    x_rows = x_rows.reshape(n_blocks, MOE_BLOCK, d)

    def expert_block(args):
        xb, e = args
        hb = clamped_swiglu(xb @ w_gu[e] + b_gu[e])
        return hb @ w_down[e] + b_down[e]

    y_rows = lax.map(expert_block, (x_rows, block_e)).reshape(n_blocks * MOE_BLOCK, d)
    y_assign = y_rows[dest] * gates[order][:, None].astype(y_rows.dtype)
    return jax.ops.segment_sum(y_assign, tok, num_segments=n)


def setup_inputs(seed: int = 0) -> dict:
    key = jax.random.key(seed)
    k = jax.random.split(key, 27)
    nrm = lambda i, shape, scale: jax.random.normal(k[i], shape, F32) * scale
    gain = lambda i, shape: 1.0 + 0.05 * jax.random.normal(k[i], shape, F32)
    D = D_MODEL
    return {
        'x': nrm(0, (BATCH, SEQ, D), 1.0),
        'c': nrm(1, (BATCH, D), 1.0),
        'ctx': nrm(2, (BATCH, CTX_LEN, D), 1.0),
        'c_ctx': nrm(3, (D,), 1.0),
        'norm_mix': gain(4, (DEPTH, D)),
        'norm_ffn': gain(5, (DEPTH, D)),
        'w_ada': nrm(6, (DEPTH, D, 6 * D), 0.5 * D ** -0.5),
        'b_ada': nrm(7, (DEPTH, 6 * D), 0.01),
        'rec_w_in': nrm(8, (N_REC_LAYERS, D, REC_IN), D ** -0.5),
        'rec_lb_logits': nrm(9, (DEPTH + 1, 2, HG_W), 0.5),
        'rec_w_out': nrm(10, (N_REC_LAYERS, REC_MIX, D), REC_MIX ** -0.5),
        'rec_hg_gain': gain(11, (N_REC_LAYERS, HG_DV)),
        'rec_ret_gain': gain(12, (N_REC_LAYERS, RET_DV)),
        'att_w_in': nrm(13, (N_ATT_LAYERS, D, ATT_IN), D ** -0.5),
        'att_w_out': nrm(14, (N_ATT_LAYERS, ATT_MIX, D), ATT_MIX ** -0.5),
        'att_q_gain': gain(15, (N_ATT_LAYERS, GQA_HD)),
        'att_k_gain': gain(16, (N_ATT_LAYERS, GQA_HD)),
        'diff_q_gain': gain(17, (N_ATT_LAYERS, DIFF_HD)),
        'diff_k_gain': gain(18, (N_ATT_LAYERS, DIFF_HD)),
        'diff_lambda': nrm(19, (N_ATT_LAYERS, 4, DIFF_HD), 0.1),
        'diff_gain': gain(20, (N_ATT_LAYERS, 2 * DIFF_HD)),
        'w_router': nrm(21, (DEPTH, D, N_EXPERTS), D ** -0.5),
        'b_router': nrm(22, (DEPTH, N_EXPERTS), 0.01),
        'w_gu': nrm(23, (DEPTH, N_EXPERTS, D, 2 * D_EXPERT), D ** -0.5),
        'b_gu': nrm(24, (DEPTH, N_EXPERTS, 2 * D_EXPERT), 0.01),
        'w_down': nrm(25, (DEPTH, N_EXPERTS, D_EXPERT, D), D_EXPERT ** -0.5),
        'b_down': nrm(26, (DEPTH, N_EXPERTS, D), 0.01),
    }


def reference(x, c, ctx, c_ctx, norm_mix, norm_ffn, w_ada, b_ada, rec_w_in, rec_lb_logits, rec_w_out,
              rec_hg_gain, rec_ret_gain, att_w_in, att_w_out, att_q_gain, att_k_gain, diff_q_gain,
              diff_k_gain, diff_lambda, diff_gain, w_router, b_router, w_gu, b_gu, w_down, b_down):
    d = x.shape[-1]
    n_lat = x.shape[1]
    ropes = {hd: axial_rope(n_lat, hd) for hd in sorted({GQA_HD, DIFF_HD, RET_DK})}
    lb_all = jnp.cumsum(jax.nn.softmax(rec_lb_logits.astype(F32), axis=0), axis=0)
    h_lat, h_ctx = x, ctx
    for l in range(DEPTH):
        need_ctx = l < DEPTH - 1
        sh1, sc1, g1, sh2, sc2, g2 = modulation(c, w_ada[l], b_ada[l])
        csh1, csc1, cg1, csh2, csc2, cg2 = modulation(c_ctx, w_ada[l], b_ada[l])
        a_lat = rms_norm(h_lat, norm_mix[l]) * (1.0 + sc1) + sh1
        a_ctx = rms_norm(h_ctx, norm_mix[l]) * (1.0 + csc1) + csh1
        j = l // 2
        if l % 2 == 0:
            m_lat, m_ctx = recurrent_mixer(a_lat, a_ctx, rec_w_in[j], lb_all[l], rec_w_out[j],
                                           rec_hg_gain[j], rec_ret_gain[j], ropes[RET_DK], need_ctx)
        else:
            m_lat, m_ctx = attention_mixer(a_lat, a_ctx, att_w_in[j], att_w_out[j], att_q_gain[j],
                                           att_k_gain[j], diff_q_gain[j], diff_k_gain[j], diff_lambda[j],
                                           diff_gain[j], 0.8 - 0.6 * math.exp(-0.3 * l),
                                           ropes[GQA_HD], ropes[DIFF_HD], need_ctx)
        h_lat = h_lat + g1 * m_lat
        f_lat = rms_norm(h_lat, norm_ffn[l]) * (1.0 + sc2) + sh2
        moe_args = (w_router[l], b_router[l], w_gu[l], b_gu[l], w_down[l], b_down[l])
        if need_ctx:
            h_ctx = h_ctx + cg1 * m_ctx
            f_ctx = rms_norm(h_ctx, norm_ffn[l]) * (1.0 + csc2) + csh2
            n_l = f_lat.shape[0] * f_lat.shape[1]
            y = moe(jnp.concatenate([f_lat.reshape(-1, d), f_ctx.reshape(-1, d)], axis=0), *moe_args)
            h_lat = h_lat + g2 * y[:n_l].reshape(f_lat.shape)
            h_ctx = h_ctx + cg2 * y[n_l:].reshape(f_ctx.shape)
        else:
            h_lat = h_lat + g2 * moe(f_lat.reshape(-1, d), *moe_args).reshape(f_lat.shape)
    return h_lat
```

```cpp
#define MK_N_LAUNCHES 20
#include <hip/hip_runtime.h>
#include <cstdio>
#include <cstdint>

#define GAS __attribute__((address_space(1)))
#define LAS __attribute__((address_space(3)))
typedef unsigned short bf16;
typedef float f32x2 __attribute__((ext_vector_type(2)));
typedef float f32x4 __attribute__((ext_vector_type(4)));
typedef float f32x16 __attribute__((ext_vector_type(16)));
typedef unsigned u32x2 __attribute__((ext_vector_type(2)));
typedef unsigned u32x4 __attribute__((ext_vector_type(4)));
typedef short bf16x8 __attribute__((ext_vector_type(8)));
typedef short s16x4 __attribute__((ext_vector_type(4)));

constexpr int BATCH = 8, SEQ = 2048, CTXL = 256, DM = 1024;
constexpr int NLAT = BATCH * SEQ, NCTX = BATCH * CTXL, NTOK = NLAT + NCTX;
constexpr int REC_IN = 4096, ATT_IN = 2560, NEXP = 32, MAXRB = 320;
constexpr float NORM_EPS = 1e-6f;
constexpr float LAM_INIT = 0.35550906759f;
constexpr int NWAVES = 8, NTHR = 512;

constexpr size_t MiB = 1u << 20;
constexpr size_t WS_CTL = 0, CTL_ZERO_BYTES = 1 * MiB;
constexpr size_t WS_MOD = 1 * MiB;
constexpr size_t WS_LB = 2 * MiB;
constexpr size_t WS_ROPE64 = 2 * MiB + 65536;
constexpr size_t WS_ROPE128 = 3 * MiB;
constexpr size_t WS_TOPE = 4 * MiB;
constexpr size_t WS_TOPG = WS_TOPE + 512 * 1024;
constexpr size_t WS_RANK = WS_TOPG + 512 * 1024;
constexpr size_t WS_BCNT = WS_RANK + 512 * 1024;
constexpr size_t WS_RTOK = WS_BCNT + 64 * 1024;
constexpr size_t WS_RGATE = WS_RTOK + 512 * 1024;
constexpr size_t WS_BLKE = WS_RGATE + 512 * 1024;
constexpr size_t WS_WT_RECIN = 8 * MiB, WS_WT_RECOUT = 16 * MiB, WS_WT_ATTIN = 18 * MiB, WS_WT_ATTOUT = 24 * MiB;
constexpr size_t WS_WT_GU = 32 * MiB, WS_WT_DN = 288 * MiB;
constexpr size_t WS_ABF = 416 * MiB, WS_PROJ = 452 * MiB, WS_FF = 596 * MiB, WS_OREC = 668 * MiB;
constexpr size_t WS_H1 = 740 * MiB, WS_H2 = 812 * MiB, WS_H3 = 884 * MiB;
constexpr size_t WS_XS = 948 * MiB, WS_H1S = 1108 * MiB, WS_YS = 1268 * MiB;
constexpr size_t WS_GQ = 1412 * MiB, WS_GK = 1428 * MiB, WS_GV = 1438 * MiB, WS_DQ = 1448 * MiB, WS_DK = 1464 * MiB, WS_DV = 1482 * MiB, WS_O0 = 1500 * MiB;
constexpr size_t WS_END = 1532 * MiB;
constexpr int CW_BAR = 4096;

constexpr int RING_BYTES = 131072;
constexpr int LDSCTL_OFF = RING_BYTES, MISC_OFF = LDSCTL_OFF + 320;
constexpr int LDS_BYTES = 147456;

#define RLX_AGENT __ATOMIC_RELAXED, __HIP_MEMORY_SCOPE_AGENT
#define LDS_WAIT() asm volatile("s_waitcnt lgkmcnt(0)" ::: "memory")
#define VM_WAIT() asm volatile("s_waitcnt vmcnt(0)" ::: "memory")

__device__ __forceinline__ float bf2f(unsigned u) { return __uint_as_float(u << 16); }
__device__ __forceinline__ float bflo(unsigned w) { return __uint_as_float(w << 16); }
__device__ __forceinline__ float bfhi(unsigned w) { return __uint_as_float(w & 0xffff0000u); }
typedef __bf16 bf16x2_t __attribute__((ext_vector_type(2)));
__device__ __forceinline__ unsigned pk2(float lo, float hi) { f32x2 v = {lo, hi}; bf16x2_t b = __builtin_convertvector(v, bf16x2_t); return __builtin_bit_cast(unsigned, b); }
__device__ __forceinline__ float wave_sum(float v) {
#pragma unroll
    for (int o = 1; o < 64; o <<= 1) v += __shfl_xor(v, o);
    return v;
}
__device__ __forceinline__ float fsigmoid(float x) { return 1.0f / (1.0f + __expf(-x)); }
__device__ __forceinline__ float fsilu(float x) { return x / (1.0f + __expf(-x)); }

#define XB_TMO      128
#define XB_XCNT(j)  (256  + 64 * (j))
#define XB_XSUB(j)  (1280 + 64 * (j))
#define XB_XGEN(j)  (2304 + 64 * (j))
#define XB_TOP      3328
#define XB_TOPGEN   3392
#define XCD_BAR_WORDS 3456
#define XB_SPIN_CAP (1u << 18)
__device__ __forceinline__ unsigned xb_ld(unsigned* p)              { return __hip_atomic_load(p, __ATOMIC_RELAXED, __HIP_MEMORY_SCOPE_AGENT); }
__device__ __forceinline__ unsigned xb_add(unsigned* p, unsigned v) { return __hip_atomic_fetch_add(p, v, __ATOMIC_RELAXED, __HIP_MEMORY_SCOPE_AGENT); }
__device__ __forceinline__ unsigned xb_xcc_id() { return (unsigned)__builtin_amdgcn_s_getreg((3 << 11) | 20) & 0xFu; }
#define XB_SPIN(cond, bar) do { unsigned _sp = 0; while (cond) { __builtin_amdgcn_s_sleep(1); \
    if ((++_sp & 255u) == 0u) { if (xb_ld(&(bar)[XB_TMO])) break; if (_sp > XB_SPIN_CAP) { atomicAdd(&(bar)[XB_TMO], 1u); break; } } } } while (0)
struct XcdBarrier { unsigned* bar; unsigned x; volatile LAS unsigned* st; };
__device__ __forceinline__ XcdBarrier xcd_barrier_post(unsigned* bar, volatile LAS unsigned* st) {
    XcdBarrier b; b.bar = bar; b.x = xb_xcc_id(); b.st = st;
    if (threadIdx.x == 0) (void)xb_add(&bar[XB_XCNT(b.x)], 1u);
    return b;
}
__device__ __forceinline__ void xcd_barrier_complete(unsigned* bar, unsigned x, unsigned& nloc, unsigned& nx) {
    const unsigned G = gridDim.x * gridDim.y * gridDim.z;
    unsigned sum, cnt, mine, sp = 0u;
    for (;;) {
        sum = 0u; cnt = 0u; mine = 0u;
#pragma unroll
        for (unsigned j = 0; j < 16; ++j) { const unsigned c = xb_ld(&bar[XB_XCNT(j)]); sum += c; cnt += (c > 0u) ? 1u : 0u; mine = (j == x) ? c : mine; }
        if (sum == G) break;
        __builtin_amdgcn_s_sleep(1);
        if ((++sp & 255u) == 0u) { if (xb_ld(&bar[XB_TMO])) break; if (sp > XB_SPIN_CAP) { atomicAdd(&bar[XB_TMO], 1u); break; } }
    }
    nloc = mine > 0u ? mine : 1u; nx = cnt > 0u ? cnt : 1u;
}
__device__ __forceinline__ void xcd_barrier(const XcdBarrier& b) {
    asm volatile("s_waitcnt vmcnt(0)" ::: "memory");
    __syncthreads();
    if (threadIdx.x == 0) {
        unsigned* bar = b.bar;
        __builtin_amdgcn_s_waitcnt(0);
        unsigned nloc = b.st[0], nx = b.st[1];
        if (nloc == 0u) { xcd_barrier_complete(bar, b.x, nloc, nx); b.st[0] = nloc; b.st[1] = nx; }
        const unsigned old = xb_add(&bar[XB_XSUB(b.x)], 1u);
        const unsigned gen = old / nloc;
        if (old + 1u == (gen + 1u) * nloc) {
            __builtin_amdgcn_fence(__ATOMIC_RELEASE, "agent");
            asm volatile("s_waitcnt vmcnt(0)" ::: "memory");
            const unsigned og = xb_add(&bar[XB_TOP], 1u);
            const unsigned tg = og / nx;
            if (og + 1u == (tg + 1u) * nx) xb_add(&bar[XB_TOPGEN], 1u);
            else XB_SPIN(xb_ld(&bar[XB_TOPGEN]) == tg, bar);
            __builtin_amdgcn_fence(__ATOMIC_ACQUIRE, "agent");
            xb_add(&bar[XB_XGEN(b.x)], 1u);
            asm volatile("s_waitcnt vmcnt(0)" ::: "memory");
        } else {
            XB_SPIN(xb_ld(&bar[XB_XGEN(b.x)]) == gen, bar);
            __builtin_amdgcn_fence(__ATOMIC_ACQUIRE, "agent");
            asm volatile("s_waitcnt vmcnt(0)" ::: "memory");
        }
    }
    __syncthreads();
}

struct Params { const float* in[27]; float* out; unsigned char* ws; int ph_lo, ph_hi; };
struct Frame {
    LAS unsigned char* lds;
    unsigned char* ws;
    int tid, lane, wave, bid, vcu;
};
enum { I_X = 0, I_C, I_CTX, I_CCTX, I_NORM_MIX, I_NORM_FFN, I_W_ADA, I_B_ADA, I_REC_W_IN, I_REC_LB, I_REC_W_OUT, I_HG_GAIN, I_RET_GAIN,
       I_ATT_W_IN, I_ATT_W_OUT, I_ATT_Q_GAIN, I_ATT_K_GAIN, I_DQ_GAIN, I_DK_GAIN, I_DLAMBDA, I_DGAIN, I_W_ROUTER, I_B_ROUTER, I_W_GU, I_B_GU, I_W_DOWN, I_B_DOWN };
#define WSP(T, off) ((T*)(F.ws + (off)))
__device__ __forceinline__ int mod_row(int r) { return r < NLAT ? (r >> 11) : 8; }
__device__ __forceinline__ void pre_modulation(const Params& P, Frame& F) {
    LAS float* s = (LAS float*)F.lds;
    LAS float* red = (LAS float*)(F.lds + 36864);
    const float* c = P.in[I_C]; const float* cctx = P.in[I_CCTX];
    for (int idx = F.tid; idx < 9 * 1024; idx += NTHR) { const int r = idx >> 10, k = idx & 1023; const float cv = r < 8 ? c[r * 1024 + k] : cctx[k]; s[idx] = fsilu(cv); }
    __syncthreads();
    const int l = F.bid / 96, col0 = (F.bid % 96) * 64;
    const float* W = P.in[I_W_ADA] + (size_t)l * 1024 * 6144 + col0 + F.lane;
    float acc[9];
#pragma unroll
    for (int r = 0; r < 9; ++r) acc[r] = 0.f;
    const int k0 = F.wave * 128;
#pragma unroll 2
    for (int kk = 0; kk < 128; kk += 4) {
        float wv[4];
#pragma unroll
        for (int i = 0; i < 4; ++i) wv[i] = W[(size_t)(k0 + kk + i) * 6144];
#pragma unroll
        for (int r = 0; r < 9; ++r) { const f32x4 sv = *(const LAS f32x4*)(s + r * 1024 + k0 + kk); acc[r] += sv.x * wv[0] + sv.y * wv[1] + sv.z * wv[2] + sv.w * wv[3]; }
    }
#pragma unroll
    for (int r = 0; r < 9; ++r) red[(F.wave * 9 + r) * 64 + F.lane] = acc[r];
    __syncthreads();
    float* mod = WSP(float, WS_MOD);
    for (int idx = F.tid; idx < 9 * 64; idx += NTHR) { const int r = idx >> 6, cl = idx & 63; float t = P.in[I_B_ADA][l * 6144 + col0 + cl];
#pragma unroll
        for (int w = 0; w < 8; ++w) t += red[(w * 9 + r) * 64 + cl];
        mod[(size_t)(l * 9 + r) * 6144 + col0 + cl] = t; }
    __syncthreads();
}
__device__ __forceinline__ void pre_tables(const Params& P, Frame& F) {
    const int gt = F.bid * NTHR + F.tid, GT = 256 * NTHR;
    if (gt < 1024) { const float* lg = P.in[I_REC_LB]; const float a = lg[gt], b = lg[1024 + gt], c = lg[2048 + gt]; const float m = fmaxf(a, fmaxf(b, c));
        const float ea = expf(a - m), eb = expf(b - m), ec = expf(c - m); WSP(float, WS_LB)[gt] = ea / (ea + eb + ec); }
    for (int idx = gt; idx < 2048 * 96; idx += GT) {
        const int t = idx / 96, p = idx % 96; const int row = t >> 6, col = t & 63;
        float* dst; int axis_dim, pp;
        if (p < 32) { dst = WSP(float, WS_ROPE64) + ((size_t)t * 32 + p) * 2; axis_dim = 32; pp = p; }
        else { dst = WSP(float, WS_ROPE128) + ((size_t)t * 64 + (p - 32)) * 2; axis_dim = 64; pp = p - 32; }
        const int nf = axis_dim / 2; const int fi = pp < nf ? pp : pp - nf; const float pos = pp < nf ? (float)row : (float)col;
        const float inv = powf(10000.0f, -(float)(2 * fi) / (float)axis_dim); const float ang = pos * inv;
        dst[0] = cosf(ang); dst[1] = sinf(ang);
    }
}
constexpr int TI_RECIN = 1024, TI_RECOUT = 256, TI_ATTIN = 640, TI_ATTOUT = 256, TI_GU = 64 * 512, TI_DN = 64 * 256;
constexpr int TI_TOTAL = TI_RECIN + TI_RECOUT + TI_ATTIN + TI_ATTOUT + TI_GU + TI_DN;
__device__ __forceinline__ void titem_decode(const Params& P, Frame& F, int it, const float*& src, bf16*& dst, int& N) {
    const float* m; bf16* d; int local;
    if (it < TI_RECIN) { N = 4096; m = P.in[I_REC_W_IN]; d = WSP(bf16, WS_WT_RECIN); local = it; }
    else if ((it -= TI_RECIN) < TI_RECOUT) { N = 1024; m = P.in[I_REC_W_OUT]; d = WSP(bf16, WS_WT_RECOUT); local = it; }
    else if ((it -= TI_RECOUT) < TI_ATTIN) { N = 2560; m = P.in[I_ATT_W_IN]; d = WSP(bf16, WS_WT_ATTIN); local = it; }
    else if ((it -= TI_ATTIN) < TI_ATTOUT) { N = 1024; m = P.in[I_ATT_W_OUT]; d = WSP(bf16, WS_WT_ATTOUT); local = it; }
    else if ((it -= TI_ATTOUT) < TI_GU) { N = 2048; const int mat = it >> 9; local = it & 511; m = P.in[I_W_GU] + (size_t)mat * 1024 * 2048; d = WSP(bf16, WS_WT_GU) + (size_t)mat * 2048 * 1024; }
    else { it -= TI_GU; N = 1024; const int mat = it >> 8; local = it & 255; m = P.in[I_W_DOWN] + (size_t)mat * 1024 * 1024; d = WSP(bf16, WS_WT_DN) + (size_t)mat * 1024 * 1024; }
    const int nblk = N >> 6, nb = local % nblk, kb = local / nblk;
    src = m + (size_t)(kb * 64) * N + nb * 64; dst = d + (size_t)(nb * 64) * 1024 + kb * 64;
}
__device__ __forceinline__ void pre_transposes(const Params& P, Frame& F) {
    LAS float* scr = (LAS float*)(F.lds + F.wave * 16384);
    const int gw = F.vcu * NWAVES + F.wave, NGW = 256 * NWAVES;
    const int lr = F.lane >> 4, lc = (F.lane & 15) * 4;
    f32x4 cur[16];
    const float* src; bf16* dst; int N;
    int it = gw;
    if (it < TI_TOTAL) { titem_decode(P, F, it, src, dst, N);
#pragma unroll
        for (int i = 0; i < 16; ++i) cur[i] = *(const f32x4*)(src + (size_t)(4 * i + lr) * N + lc); }
    while (it < TI_TOTAL) {
        const int itn = it + NGW; f32x4 nxt[16]; const float* srcn; bf16* dstn; int Nn;
        if (itn < TI_TOTAL) { titem_decode(P, F, itn, srcn, dstn, Nn);
#pragma unroll
            for (int i = 0; i < 16; ++i) nxt[i] = *(const f32x4*)(srcn + (size_t)(4 * i + lr) * Nn + lc); }
#pragma unroll
        for (int i = 0; i < 16; ++i) { const int k = 4 * i + lr; *(LAS f32x4*)(scr + k * 64 + (lc ^ (((k >> 3) & 7) << 2))) = cur[i]; }
        const int c = F.lane & 7;
#pragma unroll
        for (int j = 0; j < 8; ++j) { const int n = (F.lane >> 3) + 8 * j; const LAS float* sp = scr + (8 * c) * 64 + (n ^ (c << 2));
            u32x4 o; o.x = pk2(sp[0], sp[64]); o.y = pk2(sp[128], sp[192]); o.z = pk2(sp[256], sp[320]); o.w = pk2(sp[384], sp[448]);
            *(u32x4*)(dst + (size_t)n * 1024 + 8 * c) = o; }
        if (itn < TI_TOTAL) {
#pragma unroll
            for (int i = 0; i < 16; ++i) cur[i] = nxt[i];
            dst = dstn; }
        it = itn;
    }
}
__device__ __forceinline__ void phase_pre(const Params& P, Frame& F) {
    if (F.bid < 192) pre_modulation(P, F);
    pre_tables(P, F);
    pre_transposes(P, F);
}

__device__ __forceinline__ void norm_mod_store(const f32x4 (&v)[4], const float* gain, const float* sc, const float* sh, bf16* orow, int lane) {
    float ss = 0.f;
#pragma unroll
    for (int j = 0; j < 4; ++j) ss += (v[j].x * v[j].x + v[j].y * v[j].y) + (v[j].z * v[j].z + v[j].w * v[j].w);
    const float rstd = rsqrtf(wave_sum(ss) * (1.0f / 1024.0f) + NORM_EPS);
#pragma unroll
    for (int j = 0; j < 4; ++j) { const int c = 4 * lane + 256 * j; const f32x4 g = *(const f32x4*)(gain + c), s1 = *(const f32x4*)(sc + c), s0 = *(const f32x4*)(sh + c);
        const f32x4 a = v[j] * rstd * g * (s1 + 1.0f) + s0; u32x2 w; w.x = pk2(a.x, a.y); w.y = pk2(a.z, a.w); *(u32x2*)(orow + c) = w; }
}
__device__ __forceinline__ void phase_norm0(const Params& P, Frame& F) {
    const int gw = F.vcu * NWAVES + F.wave, NGW = 256 * NWAVES; const float* mod = WSP(float, WS_MOD);
    for (int r = gw; r < NTOK; r += NGW) {
        const float* src = r < NLAT ? P.in[I_X] + (size_t)r * 1024 : P.in[I_CTX] + (size_t)(r - NLAT) * 1024; f32x4 v[4];
#pragma unroll
        for (int j = 0; j < 4; ++j) v[j] = *(const f32x4*)(src + 4 * F.lane + 256 * j);
        const float* m = mod + (size_t)mod_row(r) * 6144;
        norm_mod_store(v, P.in[I_NORM_MIX], m + 1024, m, WSP(bf16, WS_ABF) + (size_t)r * 1024, F.lane);
    }
}
__device__ __forceinline__ void load_moe_sum(const float* h1row, const bf16* ysrow  , const float* g2, f32x4 (&v)[4], int lane) {
#pragma unroll
    for (int j = 0; j < 4; ++j) { const int c = 4 * lane + 256 * j; f32x4 s = {0.f, 0.f, 0.f, 0.f};
#pragma unroll
        for (int sl = 0; sl < 4; ++sl) { const u32x2 w = *(const u32x2*)(ysrow + sl * 1024 + c); s.x += bflo(w.x); s.y += bfhi(w.x); s.z += bflo(w.y); s.w += bfhi(w.y); }
        v[j] = *(const f32x4*)(h1row + c) + *(const f32x4*)(g2 + c) * s; }
}
__device__ __forceinline__ void phase_norm1(const Params& P, Frame& F) {
    const int gw = F.vcu * NWAVES + F.wave, NGW = 256 * NWAVES; const float* mod = WSP(float, WS_MOD);
    for (int r = gw; r < NTOK; r += NGW) {
        f32x4 v[4]; const int mr = mod_row(r);
        load_moe_sum(WSP(float, WS_H1) + (size_t)r * 1024, WSP(bf16, WS_YS) + (size_t)r * 4096, mod + (size_t)mr * 6144 + 5 * 1024, v, F.lane);
        float* h2 = WSP(float, WS_H2) + (size_t)r * 1024;
#pragma unroll
        for (int j = 0; j < 4; ++j) *(f32x4*)(h2 + 4 * F.lane + 256 * j) = v[j];
        const float* m = mod + (size_t)(9 + mr) * 6144;
        norm_mod_store(v, P.in[I_NORM_MIX] + 1024, m + 1024, m, WSP(bf16, WS_ABF) + (size_t)r * 1024, F.lane);
    }
}
__device__ __forceinline__ void phase_final(const Params& P, Frame& F) {
    const int gw = F.vcu * NWAVES + F.wave, NGW = 256 * NWAVES; const float* mod = WSP(float, WS_MOD);
    for (int r = gw; r < NLAT; r += NGW) {
        f32x4 v[4]; const int mr = mod_row(r);
        load_moe_sum(WSP(float, WS_H3) + (size_t)r * 1024, WSP(bf16, WS_YS) + (size_t)r * 4096, mod + (size_t)(9 + mr) * 6144 + 5 * 1024, v, F.lane);
        float* o = P.out + (size_t)r * 1024;
#pragma unroll
        for (int j = 0; j < 4; ++j) *(f32x4*)(o + 4 * F.lane + 256 * j) = v[j];
    }
}
namespace pg8 {
constexpr int BM = 256, BK = 64, HALF = 128, HTB = HALF * BK * 2, STAGE_BYTES = 8 * HTB, KD = 1024;
__device__ __forceinline__ int lds_byte(int r, int c) { const int st = (r >> 4) * 2 + (c >> 5), rr = r & 15, cc = c & 31, ob = rr * 64 + cc * 2; return st * 1024 + (ob ^ (((ob >> 9) & 1) << 5)); }
__device__ __forceinline__ void stage_rc(int b, int& R, int& C) { const int st = b / 1024, sb = b % 1024, swz = sb ^ (((sb >> 9) & 1) << 5); R = (st >> 1) * 16 + swz / 64; C = (st & 1) * 32 + (swz % 64) / 2; }
__device__ __forceinline__ int perm32(int rho) { const int n = rho >> 4, i = rho & 15; return 8 * (i >> 2) + 4 * n + (i & 3); }

struct Unit { const char *A0, *A1, *B0, *B1; int r0, c0, aux; };

template <class Epi, class Sched>
__device__ __forceinline__ void gemm_phase(LAS unsigned char* lds, const Sched& S, const Epi& E) {
    const int tid = threadIdx.x, wid = __builtin_amdgcn_readfirstlane(tid >> 6), lane = tid & 63, wr = wid >> 2, wc = wid & 3, fr = lane & 15, fq = lane >> 4;
    constexpr int K = KD, nt = K / BK;
    unsigned voffA[2], voffB[2];
#pragma unroll
    for (int i = 0; i < 2; ++i) { int R, C; stage_rc(tid * 16 + i * 8192, R, C); const int Rb = Epi::PERM ? ((R & ~31) + perm32(R & 31)) : R;
        voffA[i] = (unsigned)(R * K + C) * 2u; voffB[i] = (unsigned)(Rb * K + C) * 2u; }
    constexpr size_t kstep = (size_t)(BK * 2);
    const unsigned ldsw = (unsigned)wid * 1024u;
    const int aoff = lds_byte(wr * 64 + fr, fq * 8), boff = lds_byte(wc * 32 + fr, fq * 8);
#define PG8_SA(b, h) (((b) * 2 + (h)) * HTB)
#define PG8_SB(b, h) ((4 + (b) * 2 + (h)) * HTB)
#define PG8_STAGE(bufoff, gbase, voff) do { _Pragma("unroll") for (int _i = 0; _i < 2; ++_i) \
        __builtin_amdgcn_global_load_lds((const unsigned*)((const char*)(gbase) + (voff)[_i]), (LAS unsigned*)(lds + (bufoff) + ldsw + _i * 8192), 16, 0, 0); } while (0)
#define PG8_LDA(dst, b, h) do { _Pragma("unroll") for (int m = 0; m < 4; ++m) _Pragma("unroll") for (int k = 0; k < 2; ++k) dst[m][k] = *(const LAS bf16x8*)(lds + PG8_SA(b, h) + aoff + m * 2048 + k * 1024); } while (0)
#define PG8_LDB(dst, b, h) do { _Pragma("unroll") for (int n = 0; n < 2; ++n) _Pragma("unroll") for (int k = 0; k < 2; ++k) dst[n][k] = *(const LAS bf16x8*)(lds + PG8_SB(b, h) + boff + n * 2048 + k * 1024); } while (0)
#define PG8_MMA(ai, bj, At, Bt) do { __builtin_amdgcn_s_setprio(1); _Pragma("unroll") for (int m = 0; m < 4; ++m) _Pragma("unroll") for (int n = 0; n < 2; ++n) _Pragma("unroll") for (int k = 0; k < 2; ++k) \
        acc[ai][bj][m][n] = __builtin_amdgcn_mfma_f32_16x16x32_bf16(Bt[n][k], At[m][k], acc[ai][bj][m][n], 0, 0, 0); __builtin_amdgcn_s_setprio(0); } while (0)
#define PG8_WAIT_V(n) asm volatile("s_waitcnt vmcnt(" #n ")" ::: "memory")
#define PG8_WAIT_L(n) asm volatile("s_waitcnt lgkmcnt(" #n ")" ::: "memory")
#define PG8_BAR __builtin_amdgcn_s_barrier()
#define PG8_SCHED __builtin_amdgcn_sched_barrier(0)
    Unit cur, nxt; int ui = 0;
    if (!S.next(0, cur)) return;
    f32x4 acc[2][2][4][2];
#pragma unroll
    for (int a = 0; a < 2; ++a)
#pragma unroll
        for (int b = 0; b < 2; ++b)
#pragma unroll
            for (int m = 0; m < 4; ++m)
#pragma unroll
                for (int n = 0; n < 2; ++n) acc[a][b][m][n] = (f32x4){0.f, 0.f, 0.f, 0.f};
    bf16x8 At[4][2], B0[2][2], B1[2][2];
    PG8_STAGE(PG8_SB(0, 0), cur.B0, voffB); PG8_STAGE(PG8_SB(0, 1), cur.B1, voffB); PG8_STAGE(PG8_SA(0, 0), cur.A0, voffA); PG8_STAGE(PG8_SA(0, 1), cur.A1, voffA);
    if (wr == 1) PG8_BAR;
    PG8_WAIT_V(2); PG8_BAR;
    PG8_STAGE(PG8_SB(1, 0), cur.B0 + kstep, voffB); PG8_STAGE(PG8_SA(1, 0), cur.A0 + kstep, voffA); PG8_STAGE(PG8_SB(1, 1), cur.B1 + kstep, voffB);
    PG8_WAIT_V(6); PG8_BAR;
    for (;;) {
        const bool has_next = S.next(ui + 1, nxt);
        const char* nA0 = has_next ? nxt.A0 : cur.A0; const char* nA1 = has_next ? nxt.A1 : cur.A1;
        const char* nB0 = has_next ? nxt.B0 : cur.B0; const char* nB1 = has_next ? nxt.B1 : cur.B1;
        for (int t = 0; t < nt; t += 2) {
            const bool last = (t == nt - 2);
            const char* a1_1 = cur.A1 + (size_t)(t + 1) * kstep;
            const char* a2_0 = last ? nA0 : cur.A0 + (size_t)(t + 2) * kstep; const char* a2_1 = last ? nA1 : cur.A1 + (size_t)(t + 2) * kstep;
            const char* b2_0 = last ? nB0 : cur.B0 + (size_t)(t + 2) * kstep; const char* b2_1 = last ? nB1 : cur.B1 + (size_t)(t + 2) * kstep;
            const char* a3_0 = a2_0 + kstep; const char* b3_0 = b2_0 + kstep; const char* b3_1 = b2_1 + kstep;
            PG8_LDB(B0, 0, 0); PG8_LDB(B1, 0, 1); PG8_SCHED; PG8_LDA(At, 0, 0); PG8_STAGE(PG8_SA(1, 1), a1_1, voffA);
            PG8_WAIT_V(8); PG8_WAIT_L(0); PG8_BAR; PG8_MMA(0, 0, At, B0); PG8_MMA(0, 1, At, B1); PG8_BAR; PG8_SCHED;
            PG8_LDA(At, 0, 1); PG8_STAGE(PG8_SB(0, 0), b2_0, voffB); PG8_STAGE(PG8_SB(0, 1), b2_1, voffB); PG8_STAGE(PG8_SA(0, 0), a2_0, voffA);
            PG8_WAIT_V(8); PG8_WAIT_L(0); PG8_BAR; PG8_MMA(1, 0, At, B0); PG8_MMA(1, 1, At, B1); PG8_BAR; PG8_SCHED;
            PG8_LDB(B0, 1, 0); PG8_LDB(B1, 1, 1); PG8_SCHED; PG8_LDA(At, 1, 0); PG8_STAGE(PG8_SA(0, 1), a2_1, voffA);
            PG8_WAIT_V(8); PG8_WAIT_L(0); PG8_BAR; PG8_MMA(0, 0, At, B0); PG8_MMA(0, 1, At, B1); PG8_BAR; PG8_SCHED;
            PG8_LDA(At, 1, 1); PG8_STAGE(PG8_SB(1, 0), b3_0, voffB); PG8_STAGE(PG8_SB(1, 1), b3_1, voffB); PG8_STAGE(PG8_SA(1, 0), a3_0, voffA);
            PG8_WAIT_V(8); PG8_WAIT_L(0); PG8_BAR; PG8_MMA(1, 0, At, B0); PG8_MMA(1, 1, At, B1); PG8_BAR; PG8_SCHED;
        }
        if (wr == 0) PG8_BAR;
        E(acc, cur, wr, wc, fr, fq);
        if (!has_next) break;
#pragma unroll
        for (int a = 0; a < 2; ++a)
#pragma unroll
            for (int b = 0; b < 2; ++b)
#pragma unroll
                for (int m = 0; m < 4; ++m)
#pragma unroll
                    for (int n = 0; n < 2; ++n) acc[a][b][m][n] = (f32x4){0.f, 0.f, 0.f, 0.f};
        cur = nxt; ++ui;
        if (wr == 1) PG8_BAR;
    }
    PG8_WAIT_V(0);
    PG8_BAR;
#undef PG8_SA
#undef PG8_SB
#undef PG8_STAGE
#undef PG8_LDA
#undef PG8_LDB
#undef PG8_MMA
#undef PG8_WAIT_V
#undef PG8_WAIT_L
#undef PG8_BAR
#undef PG8_SCHED
}

struct DenseOrder {
    const char* A; const char* Bt; int nM, nN, nwg, c;
    __device__ __forceinline__ void init(const void* A_, const void* Bt_, int M, int N, int c_) { A = (const char*)A_; Bt = (const char*)Bt_; nM = M / BM; nN = N / BM; nwg = nM * nN; c = c_; }
    __device__ __forceinline__ bool next(int i, Unit& u) const {
        const int L = i * 256 + c; if (L >= nwg) return false;
        int wgid = L; { const int q = nwg / 8, r = nwg % 8, xcd = wgid % 8, off = wgid / 8; wgid = (xcd < r ? xcd * (q + 1) : r * (q + 1) + (xcd - r) * q) + off; }
        const int nig = 8 * nN, gid = wgid / nig, fm = gid * 8, gsz = (nM - fm) < 8 ? (nM - fm) : 8;
        const int pm = fm + ((wgid % nig) % gsz), pn = (wgid % nig) / gsz;
        u.A0 = A + (size_t)pm * (BM * 2048); u.A1 = u.A0 + (size_t)HALF * 2048; u.B0 = Bt + (size_t)pn * (BM * 2048); u.B1 = u.B0 + (size_t)HALF * 2048;
        u.r0 = pm * BM; u.c0 = pn * BM; u.aux = pn; return true;
    }
};
template <int NPN, bool GU>
struct MoeOrder {
    const char* A; const char* W; const int* blke; int nrb, vcu;
    __device__ __forceinline__ bool next(int i, Unit& u) const {
        const int L = i * 256 + vcu; const int rb = L / NPN, pn = L % NPN; if (rb >= nrb) return false;
        const int e = __builtin_amdgcn_readfirstlane(__hip_atomic_load(blke + rb, RLX_AGENT));
        u.A0 = A + (size_t)rb * (BM * 2048); u.A1 = u.A0 + (size_t)HALF * 2048;
        if (GU) { u.B0 = W + (size_t)e * (2048 * 2048) + (size_t)pn * (HALF * 2048); u.B1 = u.B0 + (size_t)1024 * 2048; u.c0 = pn * HALF; }
        else    { u.B0 = W + (size_t)e * (1024 * 2048) + (size_t)pn * (BM * 2048); u.B1 = u.B0 + (size_t)HALF * 2048; u.c0 = pn * BM; }
        u.r0 = rb * BM; u.aux = e; return true;
    }
};

#define EPI_ROWS_BEGIN _Pragma("unroll") for (int ai = 0; ai < 2; ++ai) _Pragma("unroll") for (int m = 0; m < 4; ++m) { const int row = u.r0 + ai * HALF + wr * 64 + m * 16 + fr;
#define EPI_ROWS_END }
struct EpiBf16 {
    static constexpr bool PERM = true;
    bf16* O; int ldc;
    __device__ __forceinline__ void operator()(const f32x4 (&acc)[2][2][4][2], const Unit& u, int wr, int wc, int fr, int fq) const {
        const int col0 = u.c0 + wc * 32 + 8 * fq;
        EPI_ROWS_BEGIN bf16* rowp = O + (size_t)row * ldc + col0;
#pragma unroll
            for (int bj = 0; bj < 2; ++bj) { const f32x4 v0 = acc[ai][bj][m][0], v1 = acc[ai][bj][m][1]; u32x4 w; w.x = pk2(v0[0], v0[1]); w.y = pk2(v0[2], v0[3]); w.z = pk2(v1[0], v1[1]); w.w = pk2(v1[2], v1[3]);
                *(u32x4*)(rowp + bj * HALF) = w; }
        EPI_ROWS_END
    }
};
struct EpiRecIn {
    static constexpr bool PERM = true;
    bf16* O; float* FFo; const float* lb; const float* rope;
    __device__ __forceinline__ void operator()(const f32x4 (&acc)[2][2][4][2], const Unit& u, int wr, int wc, int fr, int fq) const {
        const int pn = u.aux; const int col0 = u.c0 + wc * 32 + 8 * fq;
        if (pn >= 2 && pn < 6) {
            f32x4 lbv[2][2];
#pragma unroll
            for (int bj = 0; bj < 2; ++bj)
#pragma unroll
                for (int n = 0; n < 2; ++n) lbv[bj][n] = *(const f32x4*)(lb + col0 - 512 + bj * HALF + 4 * n);
            EPI_ROWS_BEGIN float* rowp = FFo + (size_t)row * 1024 + (col0 - 512);
#pragma unroll
                for (int bj = 0; bj < 2; ++bj)
#pragma unroll
                    for (int n = 0; n < 2; ++n) { const f32x4 z = acc[ai][bj][m][n]; f32x4 o;
#pragma unroll
                        for (int j = 0; j < 4; ++j) o[j] = lbv[bj][n][j] + (1.0f - lbv[bj][n][j]) * fsigmoid(z[j]);
                        *(f32x4*)(rowp + bj * HALF + 4 * n) = o; }
            EPI_ROWS_END
            return;
        }
        const int mode = (pn < 2) ? 1 : (pn == 8 || pn == 9 || pn >= 14) ? 2 : (pn == 10) ? 3 : (pn == 11) ? 4 : 0;
        EPI_ROWS_BEGIN bf16* rowp = O + (size_t)row * REC_IN + col0;
#pragma unroll
            for (int bj = 0; bj < 2; ++bj) { f32x4 v[2] = {acc[ai][bj][m][0], acc[ai][bj][m][1]};
                if (mode == 1) {
#pragma unroll
                    for (int n = 0; n < 2; ++n)
#pragma unroll
                        for (int j = 0; j < 4; ++j) v[n][j] = fsilu(v[n][j]) * 0.08838834764831845f;
                } else if (mode == 2) {
#pragma unroll
                    for (int n = 0; n < 2; ++n)
#pragma unroll
                        for (int j = 0; j < 4; ++j) v[n][j] = fsilu(v[n][j]);
                } else if (mode >= 3) {
                    const float sc = (mode == 4) ? 0.125f : 1.0f;
                    if (row < NLAT) { const int t = row & 2047; const int p0 = ((col0 + bj * HALF) & 63) >> 1;
                        const f32x4 cs0 = *(const f32x4*)(rope + ((size_t)t * 32 + p0) * 2), cs1 = *(const f32x4*)(rope + ((size_t)t * 32 + p0 + 2) * 2);
                        f32x4 a = v[0], b = v[1];
                        v[0][0] = (a[0] * cs0[0] - a[1] * cs0[1]) * sc; v[0][1] = (a[0] * cs0[1] + a[1] * cs0[0]) * sc;
                        v[0][2] = (a[2] * cs0[2] - a[3] * cs0[3]) * sc; v[0][3] = (a[2] * cs0[3] + a[3] * cs0[2]) * sc;
                        v[1][0] = (b[0] * cs1[0] - b[1] * cs1[1]) * sc; v[1][1] = (b[0] * cs1[1] + b[1] * cs1[0]) * sc;
                        v[1][2] = (b[2] * cs1[2] - b[3] * cs1[3]) * sc; v[1][3] = (b[2] * cs1[3] + b[3] * cs1[2]) * sc;
                    } else { v[0] = v[0] * sc; v[1] = v[1] * sc; }
                }
                u32x4 w; w.x = pk2(v[0][0], v[0][1]); w.y = pk2(v[0][2], v[0][3]); w.z = pk2(v[1][0], v[1][1]); w.w = pk2(v[1][2], v[1][3]);
                *(u32x4*)(rowp + bj * HALF) = w; }
        EPI_ROWS_END
    }
};
struct EpiResidual {
    static constexpr bool PERM = false;
    const float* baseLat; const float* baseCtx; float* out; const float* gate;
    __device__ __forceinline__ void operator()(const f32x4 (&acc)[2][2][4][2], const Unit& u, int wr, int wc, int fr, int fq) const {
        const int col0 = u.c0 + wc * 32 + 4 * fq; const float* g = gate + (size_t)mod_row(u.r0) * 6144 + col0;
        f32x4 gv[2][2];
#pragma unroll
        for (int bj = 0; bj < 2; ++bj)
#pragma unroll
            for (int n = 0; n < 2; ++n) gv[bj][n] = *(const f32x4*)(g + bj * HALF + n * 16);
        EPI_ROWS_BEGIN const float* bp = (row < NLAT ? baseLat + (size_t)row * 1024 : baseCtx + (size_t)(row - NLAT) * 1024) + col0; float* op = out + (size_t)row * 1024 + col0;
#pragma unroll
            for (int bj = 0; bj < 2; ++bj)
#pragma unroll
                for (int n = 0; n < 2; ++n) *(f32x4*)(op + bj * HALF + n * 16) = *(const f32x4*)(bp + bj * HALF + n * 16) + gv[bj][n] * acc[ai][bj][m][n];
        EPI_ROWS_END
    }
};
struct EpiSwiglu {
    static constexpr bool PERM = true;
    bf16* O; const float* bgu;
    __device__ __forceinline__ void operator()(const f32x4 (&acc)[2][2][4][2], const Unit& u, int wr, int wc, int fr, int fq) const {
        const int col0 = u.c0 + wc * 32 + 8 * fq; const float* bb = bgu + (size_t)u.aux * 2048 + col0;
        f32x4 bg[2], bu[2];
#pragma unroll
        for (int n = 0; n < 2; ++n) { bg[n] = *(const f32x4*)(bb + 4 * n); bu[n] = *(const f32x4*)(bb + 1024 + 4 * n); }
        EPI_ROWS_BEGIN f32x4 h[2];
#pragma unroll
            for (int n = 0; n < 2; ++n)
#pragma unroll
                for (int j = 0; j < 4; ++j) { const float g = fminf(acc[ai][0][m][n][j] + bg[n][j], 7.0f); const float up = fminf(fmaxf(acc[ai][1][m][n][j] + bu[n][j], -7.0f), 7.0f);
                    h[n][j] = (up + 1.0f) * g * fsigmoid(1.702f * g); }
            u32x4 w; w.x = pk2(h[0][0], h[0][1]); w.y = pk2(h[0][2], h[0][3]); w.z = pk2(h[1][0], h[1][1]); w.w = pk2(h[1][2], h[1][3]);
            *(u32x4*)(O + (size_t)row * 1024 + col0) = w;
        EPI_ROWS_END
    }
};
struct EpiMoeOut {
    static constexpr bool PERM = true;
    bf16* YS; const float* bdn; const int* rtok; const float* rgate;
    __device__ __forceinline__ void operator()(const f32x4 (&acc)[2][2][4][2], const Unit& u, int wr, int wc, int fr, int fq) const {
        const int col0 = u.c0 + wc * 32 + 8 * fq; const float* bb = bdn + (size_t)u.aux * 1024 + col0;
        f32x4 bv[2][2];
#pragma unroll
        for (int bj = 0; bj < 2; ++bj)
#pragma unroll
            for (int n = 0; n < 2; ++n) bv[bj][n] = *(const f32x4*)(bb + bj * HALF + 4 * n);
        EPI_ROWS_BEGIN const int tk = rtok[row]; const float gt = rgate[row];
            if (tk >= 0) { bf16* rowp = YS + (size_t)tk * 1024 + col0;
#pragma unroll
                for (int bj = 0; bj < 2; ++bj) { const f32x4 v0 = (acc[ai][bj][m][0] + bv[bj][0]) * gt, v1 = (acc[ai][bj][m][1] + bv[bj][1]) * gt;
                    u32x4 w; w.x = pk2(v0[0], v0[1]); w.y = pk2(v0[2], v0[3]); w.z = pk2(v1[0], v1[1]); w.w = pk2(v1[2], v1[3]); *(u32x4*)(rowp + bj * HALF) = w; } }
        EPI_ROWS_END
    }
};
}
namespace rec {
template <int DK> struct LL {
    static constexpr int SD = (DK + 8) * 2;
    static constexpr int QIN = 0, KIN = QIN + 64 * SD, ST = KIN + 64 * SD, KSTT = ST + 64 * SD, VT = KSTT + DK * 144, ATT = VT + 64 * 144, TOT = ATT + 64 * 144, DEC = TOT + 8 * 128 * 4, END = DEC + 128 * 4;
};
template <bool RET>
__device__ __forceinline__ void rec_unit(const Params& P, Frame& F, int b, int head, int dir, int vh) {
    constexpr int DK = RET ? 64 : 128, NT_ = RET ? 4 : 8, NVT = RET ? 2 : 4, KS = DK / 32;
    typedef LL<DK> L; constexpr int SD = L::SD;
    LAS unsigned char* lds = F.lds;
    const bf16* PROJ = WSP(bf16, WS_PROJ); const float* FFp = WSP(float, WS_FF); bf16* OR = WSP(bf16, WS_OREC) + (size_t)dir * NTOK * 1024;
    const int qcol = RET ? 2560 + head * 64 : head * 128, kcol = 2816 + head * 64, fcol = dir * 512 + head * 128;
    const int vcol = (RET ? 3072 : 1536) + head * 128 + vh * 64, ocol = (RET ? 512 : 0) + head * 128 + vh * 64;
    const float lg = RET ? __logf(1.0f - exp2f(-5.0f - (float)(dir ? 3 - head : head))) : 0.f;
    const int dp = RET ? (F.tid & 31) : F.lane, tg = RET ? (F.tid >> 5) : F.wave;
    const int vs = F.tid >> 3, vc = (F.tid & 7) * 8;
    const int fr = F.lane & 15, fq = F.lane >> 4;
    const int sdt = RET ? (F.wave >> 1) : F.wave, svt0 = RET ? 2 * (F.wave & 1) : 0;
    f32x4 sacc[NVT];
#pragma unroll
    for (int i = 0; i < NVT; ++i) sacc[i] = (f32x4){0.f, 0.f, 0.f, 0.f};
    for (int idx = F.tid; idx < 64 * SD / 4; idx += NTHR) ((LAS unsigned*)(lds + L::ST))[idx] = 0u;
    if (RET && F.tid < 64) ((LAS float*)(lds + L::DEC))[F.tid] = __expf(64.0f * lg);
    f32x2 fv[NT_]; unsigned qv[NT_], kv[NT_]; u32x4 vv;
#define REC_BASE(n) ((n) < 4 ? NLAT + b * 256 + (dir ? 3 - (n) : (n)) * 64 : b * 2048 + (dir ? 35 - (n) : (n) - 4) * 64)
#define REC_ROW(base, j) ((base) + (dir ? 63 - (j) : (j)))
#define REC_LOAD(n) do { const int _bs = REC_BASE(n); _Pragma("unroll") for (int i = 0; i < NT_; ++i) { const size_t _r = (size_t)REC_ROW(_bs, NT_ * tg + i); \
        qv[i] = *(const unsigned*)(PROJ + _r * REC_IN + qcol + 2 * dp); \
        if (RET) kv[i] = *(const unsigned*)(PROJ + _r * REC_IN + kcol + 2 * dp); else fv[i] = *(const f32x2*)(FFp + _r * 1024 + fcol + 2 * dp); } \
        vv = *(const u32x4*)(PROJ + (size_t)REC_ROW(_bs, vs) * REC_IN + vcol + vc); } while (0)
    REC_LOAD(0);
    for (int n = 0; n < 36; ++n) {
        const int base = REC_BASE(n);
        float kst0[NT_], kst1[NT_];
        if (!RET) {
            f32x2 cs[NT_]; f32x2 run = {0.f, 0.f};
#pragma unroll
            for (int i = 0; i < NT_; ++i) { run.x += __logf(fv[i].x); run.y += __logf(fv[i].y); cs[i] = run; }
            *(LAS f32x2*)(lds + L::TOT + (tg * 128 + 2 * dp) * 4) = run;
            __syncthreads();
            f32x2 pre = {0.f, 0.f}, all = {0.f, 0.f};
#pragma unroll
            for (int g = 0; g < 8; ++g) { const f32x2 t = *(const LAS f32x2*)(lds + L::TOT + (g * 128 + 2 * dp) * 4); all += t; if (g < tg) pre += t; }
#pragma unroll
            for (int i = 0; i < NT_; ++i) { const int j = NT_ * tg + i; const float bx = pre.x + cs[i].x, by = pre.y + cs[i].y;
                const float q0 = bflo(qv[i]), q1 = bfhi(qv[i]), k0 = 1.0f - fv[i].x, k1 = 1.0f - fv[i].y;
                *(LAS unsigned*)(lds + L::QIN + j * SD + 4 * dp) = pk2(q0 * __expf(bx), q1 * __expf(by));
                *(LAS unsigned*)(lds + L::KIN + j * SD + 4 * dp) = pk2(k0 * __expf(fminf(-bx, 80.f)), k1 * __expf(fminf(-by, 80.f)));
                kst0[i] = k0 * __expf(all.x - bx); kst1[i] = k1 * __expf(all.y - by); }
            if (tg == 0) *(LAS f32x2*)(lds + L::DEC + 8 * dp) = (f32x2){__expf(all.x), __expf(all.y)};
            u32x4 w0, w1; w0.x = pk2(kst0[0], kst0[1]); w0.y = pk2(kst0[2], kst0[3]); w0.z = pk2(kst0[4], kst0[5]); w0.w = pk2(kst0[6], kst0[7]);
            w1.x = pk2(kst1[0], kst1[1]); w1.y = pk2(kst1[2], kst1[3]); w1.z = pk2(kst1[4], kst1[5]); w1.w = pk2(kst1[6], kst1[7]);
            *(LAS u32x4*)(lds + L::KSTT + (2 * dp) * 144 + tg * 16) = w0; *(LAS u32x4*)(lds + L::KSTT + (2 * dp + 1) * 144 + tg * 16) = w1;
        } else {
#pragma unroll
            for (int i = 0; i < NT_; ++i) { const int j = NT_ * tg + i; const float eb = __expf((float)(j + 1) * lg), enb = __expf(-(float)(j + 1) * lg), est = __expf((float)(63 - j) * lg);
                const float q0 = bflo(qv[i]), q1 = bfhi(qv[i]), k0 = bflo(kv[i]), k1 = bfhi(kv[i]);
                *(LAS unsigned*)(lds + L::QIN + j * SD + 4 * dp) = pk2(q0 * eb, q1 * eb);
                *(LAS unsigned*)(lds + L::KIN + j * SD + 4 * dp) = pk2(k0 * enb, k1 * enb);
                kst0[i] = k0 * est; kst1[i] = k1 * est; }
            u32x2 w0, w1; w0.x = pk2(kst0[0], kst0[1]); w0.y = pk2(kst0[2], kst0[3]); w1.x = pk2(kst1[0], kst1[1]); w1.y = pk2(kst1[2], kst1[3]);
            *(LAS u32x2*)(lds + L::KSTT + (2 * dp) * 144 + tg * 8) = w0; *(LAS u32x2*)(lds + L::KSTT + (2 * dp + 1) * 144 + tg * 8) = w1;
        }
#pragma unroll
        for (int i = 0; i < 8; ++i) *(LAS bf16*)(lds + L::VT + (vc + i) * 144 + vs * 2) = (bf16)(vv[i >> 1] >> (16 * (i & 1)));
        if (n + 1 < 36) REC_LOAD(n + 1);
        __syncthreads();
        {
            const int ti = F.wave >> 1;
#pragma unroll
            for (int q = 0; q < 2; ++q) { const int si = 2 * (F.wave & 1) + q; f32x4 a4 = {0.f, 0.f, 0.f, 0.f};
                if (si <= ti) {
#pragma unroll
                    for (int kk = 0; kk < KS; ++kk) { const bf16x8 a = *(const LAS bf16x8*)(lds + L::KIN + (si * 16 + fr) * SD + (kk * 32 + fq * 8) * 2);
                        const bf16x8 bb = *(const LAS bf16x8*)(lds + L::QIN + (ti * 16 + fr) * SD + (kk * 32 + fq * 8) * 2);
                        a4 = __builtin_amdgcn_mfma_f32_16x16x32_bf16(a, bb, a4, 0, 0, 0); }
                }
                const int t = ti * 16 + fr, s0 = si * 16 + 4 * fq;
#pragma unroll
                for (int j = 0; j < 4; ++j) if (s0 + j > t) a4[j] = 0.f;
                u32x2 w; w.x = pk2(a4[0], a4[1]); w.y = pk2(a4[2], a4[3]);
                *(LAS u32x2*)(lds + L::ATT + t * 144 + s0 * 2) = w; }
        }
        __syncthreads();
        {
            const int ti = F.wave >> 1; const int t = ti * 16 + fr; bf16* orow = OR + (size_t)REC_ROW(base, t) * 1024 + ocol;
#pragma unroll
            for (int q = 0; q < 2; ++q) { const int vi = 2 * (F.wave & 1) + q; f32x4 a4 = {0.f, 0.f, 0.f, 0.f};
#pragma unroll
                for (int kk = 0; kk < 2; ++kk) { const bf16x8 a = *(const LAS bf16x8*)(lds + L::VT + (vi * 16 + fr) * 144 + (kk * 32 + fq * 8) * 2);
                    const bf16x8 bb = *(const LAS bf16x8*)(lds + L::ATT + t * 144 + (kk * 32 + fq * 8) * 2);
                    a4 = __builtin_amdgcn_mfma_f32_16x16x32_bf16(a, bb, a4, 0, 0, 0); }
#pragma unroll
                for (int kk = 0; kk < KS; ++kk) { const bf16x8 a = *(const LAS bf16x8*)(lds + L::ST + (vi * 16 + fr) * SD + (kk * 32 + fq * 8) * 2);
                    const bf16x8 bb = *(const LAS bf16x8*)(lds + L::QIN + t * SD + (kk * 32 + fq * 8) * 2);
                    a4 = __builtin_amdgcn_mfma_f32_16x16x32_bf16(a, bb, a4, 0, 0, 0); }
                u32x2 w; w.x = pk2(a4[0], a4[1]); w.y = pk2(a4[2], a4[3]);
                *(u32x2*)(orow + vi * 16 + 4 * fq) = w; }
        }
        {
            const f32x4 dec4 = *(const LAS f32x4*)(lds + L::DEC + (sdt * 16 + 4 * fq) * 4);
#pragma unroll
            for (int vt = 0; vt < NVT; ++vt) { f32x4 a4 = sacc[vt] * dec4;
#pragma unroll
                for (int kk = 0; kk < 2; ++kk) { const bf16x8 a = *(const LAS bf16x8*)(lds + L::KSTT + (sdt * 16 + fr) * 144 + (kk * 32 + fq * 8) * 2);
                    const bf16x8 bb = *(const LAS bf16x8*)(lds + L::VT + ((svt0 + vt) * 16 + fr) * 144 + (kk * 32 + fq * 8) * 2);
                    a4 = __builtin_amdgcn_mfma_f32_16x16x32_bf16(a, bb, a4, 0, 0, 0); }
                sacc[vt] = a4; }
        }
        __syncthreads();
#pragma unroll
        for (int vt = 0; vt < NVT; ++vt) { u32x2 w; w.x = pk2(sacc[vt][0], sacc[vt][1]); w.y = pk2(sacc[vt][2], sacc[vt][3]);
            *(LAS u32x2*)(lds + L::ST + ((svt0 + vt) * 16 + fr) * SD + (sdt * 16 + 4 * fq) * 2) = w; }
    }
#undef REC_BASE
#undef REC_ROW
#undef REC_LOAD
    __syncthreads();
}
}
__device__ __forceinline__ void phase_rec(const Params& P, Frame& F) {
    const int u = F.bid; const int vh = u & 1, dir = (u >> 1) & 1, head = (u >> 2) & 3, type = (u >> 4) & 1, b = u >> 5;
    if (type) rec::rec_unit<true>(P, F, b, head, dir, vh); else rec::rec_unit<false>(P, F, b, head, dir, vh);
}
__device__ __forceinline__ void phase_merge(const Params& P, Frame& F) {
    const int gw = F.vcu * NWAVES + F.wave, NGW = 256 * NWAVES; const int c0 = 16 * F.lane; const bool isret = F.lane >= 32;
    const float* gain = (isret ? P.in[I_RET_GAIN] : P.in[I_HG_GAIN]) + (c0 & 127);
    float gn[16];
#pragma unroll
    for (int i = 0; i < 16; ++i) gn[i] = gain[i];
    for (int r = gw; r < NTOK; r += NGW) {
        const bf16* o0 = WSP(bf16, WS_OREC) + (size_t)r * 1024 + c0; const bf16* o1 = o0 + (size_t)NTOK * 1024;
        const bf16* gp = WSP(bf16, WS_PROJ) + (size_t)r * REC_IN + c0 + (isret ? 3072 : 2048);
        u32x4 a[2] = {*(const u32x4*)o0, *(const u32x4*)(o0 + 8)}, bq[2] = {*(const u32x4*)o1, *(const u32x4*)(o1 + 8)}, g[2] = {*(const u32x4*)gp, *(const u32x4*)(gp + 8)};
        float o[16], gt[16]; float s1 = 0.f;
#pragma unroll
        for (int i = 0; i < 8; ++i) { const unsigned wa = a[i >> 2][i & 3], wb = bq[i >> 2][i & 3], wg = g[i >> 2][i & 3];
            o[2 * i] = bflo(wa) + bflo(wb); o[2 * i + 1] = bfhi(wa) + bfhi(wb); gt[2 * i] = bflo(wg); gt[2 * i + 1] = bfhi(wg); s1 += o[2 * i] + o[2 * i + 1]; }
        s1 += __shfl_xor(s1, 1); s1 += __shfl_xor(s1, 2); s1 += __shfl_xor(s1, 4);
        const float mean = isret ? s1 * (1.0f / 128.0f) : 0.f; float s2 = 0.f;
#pragma unroll
        for (int i = 0; i < 16; ++i) { o[i] -= mean; s2 += o[i] * o[i]; }
        s2 += __shfl_xor(s2, 1); s2 += __shfl_xor(s2, 2); s2 += __shfl_xor(s2, 4);
        const float rstd = rsqrtf(s2 * (1.0f / 128.0f) + NORM_EPS);
        u32x4 w[2];
#pragma unroll
        for (int i = 0; i < 8; ++i) w[i >> 2][i & 3] = pk2(o[2 * i] * rstd * gn[2 * i] * gt[2 * i], o[2 * i + 1] * rstd * gn[2 * i + 1] * gt[2 * i + 1]);
        bf16* y = WSP(bf16, WS_ABF) + (size_t)r * 1024 + c0; *(u32x4*)y = w[0]; *(u32x4*)(y + 8) = w[1];
    }
}
template <int NROWS, int LAYER>
__device__ __forceinline__ void phase_route(const Params& P, Frame& F, const float* H) {
    constexpr int RPB = NROWS / 256, RPW = RPB / 8;
    LAS float* tile = (LAS float*)(F.lds + F.wave * 16384);
    LAS int* hist = (LAS int*)(F.lds + 131072);
    if (F.tid < 32) hist[F.tid] = 0;
    __syncthreads();
    const float* mod = WSP(float, WS_MOD); const float* wr = P.in[I_W_ROUTER] + (size_t)LAYER * 1024 * 32; const float* br = P.in[I_B_ROUTER] + LAYER * 32;
    const float* gain = P.in[I_NORM_FFN] + LAYER * 1024;
    int* tope = WSP(int, WS_TOPE); float* topg = WSP(float, WS_TOPG); int* rank = WSP(int, WS_RANK);
    const int e = F.lane & 31, kh = F.lane >> 5;
    const float bias = br[e];
    const int row_w0 = F.bid * RPB + F.wave * RPW;
    for (int g0 = 0; g0 < RPW; g0 += 4) {
        const int nr = (RPW - g0) < 4 ? (RPW - g0) : 4;
        for (int rr = 0; rr < nr; ++rr) {
            const int r = row_w0 + g0 + rr; const float* src = H + (size_t)r * 1024; f32x4 v[4];
#pragma unroll
            for (int j = 0; j < 4; ++j) v[j] = *(const f32x4*)(src + 4 * F.lane + 256 * j);
            float ss = 0.f;
#pragma unroll
            for (int j = 0; j < 4; ++j) ss += (v[j].x * v[j].x + v[j].y * v[j].y) + (v[j].z * v[j].z + v[j].w * v[j].w);
            const float rstd = rsqrtf(wave_sum(ss) * (1.0f / 1024.0f) + NORM_EPS);
            const float* m = mod + (size_t)(LAYER * 9 + mod_row(r)) * 6144;
            bf16* orow = WSP(bf16, WS_ABF) + (size_t)r * 1024;
#pragma unroll
            for (int j = 0; j < 4; ++j) { const int c = 4 * F.lane + 256 * j; const f32x4 gg = *(const f32x4*)(gain + c), s1 = *(const f32x4*)(m + 4096 + c), s0 = *(const f32x4*)(m + 3072 + c);
                const f32x4 a = v[j] * rstd * gg * (s1 + 1.0f) + s0; *(LAS f32x4*)(tile + rr * 1024 + c) = a;
                u32x2 w; w.x = pk2(a.x, a.y); w.y = pk2(a.z, a.w); *(u32x2*)(orow + c) = w; }
        }
        float acc[4] = {0.f, 0.f, 0.f, 0.f};
        const float* wp = wr + (size_t)(kh * 512) * 32 + e; const LAS float* tp = tile + kh * 512;
#pragma unroll 4
        for (int s = 0; s < 512; s += 4) {
            const float w0 = wp[(s + 0) * 32], w1 = wp[(s + 1) * 32], w2 = wp[(s + 2) * 32], w3 = wp[(s + 3) * 32];
#pragma unroll
            for (int rr = 0; rr < 4; ++rr) { const f32x4 fvv = *(const LAS f32x4*)(tp + rr * 1024 + s); acc[rr] += fvv.x * w0 + fvv.y * w1 + fvv.z * w2 + fvv.w * w3; }
        }
#pragma unroll
        for (int rr = 0; rr < 4; ++rr) { acc[rr] += __shfl_xor(acc[rr], 32); acc[rr] += bias; }
        for (int rr = 0; rr < nr; ++rr) {
            const int r = row_w0 + g0 + rr; float val = acc[rr]; float tv[4]; int ti[4];
#pragma unroll
            for (int k = 0; k < 4; ++k) { float mx = val;
#pragma unroll
                for (int o = 1; o < 32; o <<= 1) mx = fmaxf(mx, __shfl_xor(mx, o));
                const unsigned long long bal = __ballot(val == mx); const int idx = __ffsll((long long)bal) - 1;
                tv[k] = mx; ti[k] = idx & 31; if (e == (idx & 31)) val = -3.0e38f; }
            const float e1 = __expf(tv[1] - tv[0]), e2 = __expf(tv[2] - tv[0]), e3 = __expf(tv[3] - tv[0]); const float inv = 1.0f / (1.0f + e1 + e2 + e3);
            if (F.lane < 4) { const int k = F.lane; const int ex = k == 0 ? ti[0] : k == 1 ? ti[1] : k == 2 ? ti[2] : ti[3]; const float gv = (k == 0 ? 1.0f : k == 1 ? e1 : k == 2 ? e2 : e3) * inv;
                const int rk = atomicAdd((int*)(hist + ex), 1);
                tope[r * 4 + k] = ex; topg[r * 4 + k] = gv; rank[r * 4 + k] = rk; }
        }
    }
    __syncthreads();
    if (F.tid < 32) WSP(int, WS_BCNT)[F.bid * 32 + F.tid] = hist[F.tid];
    __syncthreads();
}
template <int NROWS>
__device__ __forceinline__ void phase_scatter(const Params& P, Frame& F) {
    constexpr int RPB = NROWS / 256;
    LAS int* part_tot = (LAS int*)F.lds;
    LAS int* part_pre = part_tot + 512;
    LAS int* baseL = part_pre + 512;
    LAS int* padS = baseL + 32;
    LAS int* totL = padS + 40;
    const int* bcnt = WSP(int, WS_BCNT);
    { const int e = F.tid & 31, part = F.tid >> 5; int t = 0, pr = 0;
        for (int bb = part * 16; bb < part * 16 + 16; ++bb) { const int c = bcnt[bb * 32 + e]; t += c; if (bb < F.bid) pr += c; }
        part_tot[part * 32 + e] = t; part_pre[part * 32 + e] = pr; }
    __syncthreads();
    if (F.tid < 32) { int t = 0, pr = 0;
        for (int p = 0; p < 16; ++p) { t += part_tot[p * 32 + F.tid]; pr += part_pre[p * 32 + F.tid]; }
        totL[F.tid] = t; baseL[F.tid] = pr; }
    __syncthreads();
    if (F.tid == 0) { int run = 0; for (int e = 0; e < 32; ++e) { padS[e] = run; run += (totL[e] + 255) & ~255; } padS[32] = run; }
    __syncthreads();
    if (F.tid < 32) baseL[F.tid] += padS[F.tid];
    __syncthreads();
    const int* tope = WSP(int, WS_TOPE); const float* topg = WSP(float, WS_TOPG); const int* rank = WSP(int, WS_RANK);
    int* rtok = WSP(int, WS_RTOK); float* rgate = WSP(float, WS_RGATE);
    for (int a = F.wave; a < RPB * 4; a += NWAVES) {
        const int r = F.bid * RPB + (a >> 2), k = a & 3; const int ex = tope[r * 4 + k]; const int dest = baseL[ex] + rank[r * 4 + k];
        const u32x4* src = (const u32x4*)(WSP(bf16, WS_ABF) + (size_t)r * 1024); u32x4* dst = (u32x4*)(WSP(bf16, WS_XS) + (size_t)dest * 1024);
        const u32x4 v0 = src[F.lane], v1 = src[64 + F.lane]; dst[F.lane] = v0; dst[64 + F.lane] = v1;
        if (F.lane == 0) { rtok[dest] = r * 4 + k; rgate[dest] = topg[r * 4 + k]; }
    }
    if (F.bid < 32) { const int e = F.bid; const int s = padS[e] + totL[e], en = padS[e + 1]; for (int i = s + F.tid; i < en; i += NTHR) { rtok[i] = -1; rgate[i] = 0.f; } }
    if (F.bid == 32) { int* blke = WSP(int, WS_BLKE); const int nrb = padS[32] >> 8;
        for (int rb = F.tid; rb < MAXRB; rb += NTHR) { int ex = -1; if (rb < nrb) { const int row = rb << 8; ex = 0; for (int e = 1; e < 32; ++e) if (row >= padS[e]) ex = e; } blke[rb] = ex; }
        if (F.tid == 0) blke[MAXRB] = nrb; }
    __syncthreads();
}
__device__ __forceinline__ void load8(const bf16* p, float (&x)[8]) { const u32x4 w = *(const u32x4*)p;
#pragma unroll
    for (int i = 0; i < 4; ++i) { x[2 * i] = bflo(w[i]); x[2 * i + 1] = bfhi(w[i]); } }
__device__ __forceinline__ void store8(bf16* p, const float (&x)[8]) { u32x4 w;
#pragma unroll
    for (int i = 0; i < 4; ++i) w[i] = pk2(x[2 * i], x[2 * i + 1]);
    *(u32x4*)p = w; }
__device__ __forceinline__ void rope8(float (&x)[8], const float* cs  ) {
    const f32x4 c0 = *(const f32x4*)cs, c1 = *(const f32x4*)(cs + 4); float y[8];
    y[0] = x[0] * c0[0] - x[1] * c0[1]; y[1] = x[0] * c0[1] + x[1] * c0[0]; y[2] = x[2] * c0[2] - x[3] * c0[3]; y[3] = x[2] * c0[3] + x[3] * c0[2];
    y[4] = x[4] * c1[0] - x[5] * c1[1]; y[5] = x[4] * c1[1] + x[5] * c1[0]; y[6] = x[6] * c1[2] - x[7] * c1[3]; y[7] = x[6] * c1[3] + x[7] * c1[2];
#pragma unroll
    for (int i = 0; i < 8; ++i) x[i] = y[i];
}
template <int GL>
__device__ __forceinline__ void headnorm8(float (&x)[8], const float* gain8) {
    float ss = 0.f;
#pragma unroll
    for (int i = 0; i < 8; ++i) ss += x[i] * x[i];
#pragma unroll
    for (int o = 1; o < GL; o <<= 1) ss += __shfl_xor(ss, o);
    const float rstd = rsqrtf(ss * (1.0f / (8.0f * GL)) + NORM_EPS);
#pragma unroll
    for (int i = 0; i < 8; ++i) x[i] = x[i] * rstd * gain8[i];
}
__device__ __forceinline__ void phase_qkv(const Params& P, Frame& F) {
    const int gw = F.vcu * NWAVES + F.wave, NGW = 256 * NWAVES; const int l = F.lane;
    const bf16* PR = WSP(bf16, WS_PROJ); const float* r64 = WSP(float, WS_ROPE64); const float* r128 = WSP(float, WS_ROPE128);
    float gq[8], gk[8], gdq[8], gdk[8];
#pragma unroll
    for (int i = 0; i < 8; ++i) { gq[i] = P.in[I_ATT_Q_GAIN][(8 * l) % 128 + i]; gk[i] = P.in[I_ATT_K_GAIN][(8 * l) % 128 + i]; gdq[i] = P.in[I_DQ_GAIN][(8 * l) % 64 + i]; gdk[i] = P.in[I_DK_GAIN][(8 * l) % 64 + i]; }
    for (int r = gw; r < NTOK; r += NGW) {
        const bool lat = r < NLAT; const int rc = r - NLAT; const int b = lat ? (r >> 11) : (rc >> 8); const int t = r & 2047; const int pos = lat ? 256 + t : (rc & 255);
        const bf16* row = PR + (size_t)r * ATT_IN; float x[8];
        const int c128 = (8 * l) % 128, c64 = (8 * l) % 64;
        if (lat) {
            load8(row + 8 * l, x); headnorm8<16>(x, gq); rope8(x, r128 + ((size_t)t * 64 + c128 / 2) * 2);
            store8(WSP(bf16, WS_GQ) + ((size_t)(b * 4 + (l >> 4)) * 2048 + t) * 128 + c128, x);
        }
        {
            load8(row + 512 + 8 * l, x); float xn[8];
#pragma unroll
            for (int i = 0; i < 8; ++i) xn[i] = x[i];
            headnorm8<16>(xn, gk); if (lat) rope8(xn, r128 + ((size_t)t * 64 + c128 / 2) * 2);
            const int kvh = (l >> 4) & 1; const size_t off = ((size_t)(b * 2 + kvh) * 2304 + pos) * 128 + c128;
            if (l < 32) store8(WSP(bf16, WS_GK) + off, xn); else store8(WSP(bf16, WS_GV) + off, x);
        }
        if (lat) {
            load8(row + 1024 + 8 * l, x); headnorm8<8>(x, gdq); rope8(x, r64 + ((size_t)t * 32 + c64 / 2) * 2);
            store8(WSP(bf16, WS_DQ) + ((size_t)(b * 8 + (l >> 3)) * 2048 + t) * 64 + c64, x);
        }
        {
            load8(row + 1536 + 8 * l, x); headnorm8<8>(x, gdk); if (lat) rope8(x, r64 + ((size_t)t * 32 + c64 / 2) * 2);
            store8(WSP(bf16, WS_DK) + ((size_t)(b * 8 + (l >> 3)) * 2304 + pos) * 64 + c64, x);
        }
        {
            load8(row + 2048 + 8 * l, x);
            store8(WSP(bf16, WS_DV) + ((size_t)(b * 4 + (l >> 4)) * 2304 + pos) * 128 + c128, x);
        }
    }
}

namespace attn {
constexpr int DV = 128, NW = 8, QBLK = 32, KVBLK = 64, SKV = 2304;
constexpr float THR = 8.f;
constexpr int SHM_V = KVBLK * DV * 2, SHM_K = KVBLK * 128 * 2;
#define KSWZ(row, colB) ((row) * 256 + ((colB) ^ (((row) & 7) << 4)))
#define SBAR() __builtin_amdgcn_sched_barrier(0)
__device__ __forceinline__ int crow(int r, int hi) { return (r & 3) + 8 * (r >> 2) + 4 * hi; }
__device__ __forceinline__ unsigned cvtpk(float lo, float hi) { return pk2(lo, hi); }
template <int NQ> struct Cst { static constexpr float SCALE = NQ == 8 ? 0.088388347648318440f : 0.125f; };
template <int NQ>
__device__ __forceinline__ void partialSM(f32x16& p0, f32x16& p1, float& m_reg, float& mn, float& alpha) {
    constexpr float SCALE = Cst<NQ>::SCALE; constexpr float C = SCALE * 1.4426950408889634f;
    float pmax = p0[0];
#pragma unroll
    for (int r = 1; r < 16; ++r) pmax = fmaxf(pmax, p0[r]);
#pragma unroll
    for (int r = 0; r < 16; ++r) pmax = fmaxf(pmax, p1[r]);
    { auto rr = __builtin_amdgcn_permlane32_swap(__float_as_uint(pmax), __float_as_uint(pmax), false, false);
      pmax = fmaxf(__uint_as_float(rr[0]), __uint_as_float(rr[1])); }
    if (__builtin_expect(__all(pmax - m_reg <= THR / SCALE), 1)) { mn = m_reg; alpha = 1.f; }
    else { mn = fmaxf(m_reg, pmax); alpha = __builtin_amdgcn_exp2f((m_reg - mn) * C); m_reg = mn; }
    const float mnC = -mn * C;
#pragma unroll
    for (int r = 0; r < 16; ++r) p0[r] = fmaf(p0[r], C, mnC);
#pragma unroll
    for (int r = 0; r < 16; ++r) p1[r] = fmaf(p1[r], C, mnC);
#pragma unroll
    for (int r = 0; r < 16; ++r) p0[r] = __builtin_amdgcn_exp2f(p0[r]);
}
__device__ __forceinline__ void finishSM(f32x16& p0, f32x16& p1, float alpha, float& l_reg, bf16x8& pa0, bf16x8& pa1, bf16x8& pa2, bf16x8& pa3) {
#pragma unroll
    for (int r = 0; r < 16; ++r) p1[r] = __builtin_amdgcn_exp2f(p1[r]);
    float ps = 0;
#pragma unroll
    for (int r = 0; r < 16; ++r) ps += p0[r];
#pragma unroll
    for (int r = 0; r < 16; ++r) ps += p1[r];
    { auto rr = __builtin_amdgcn_permlane32_swap(__float_as_uint(ps), __float_as_uint(ps), false, false);
      ps = __uint_as_float(rr[0]) + __uint_as_float(rr[1]); }
    l_reg = l_reg * alpha + ps;
#define PK4(PP, BASE, OUT) do { unsigned a0 = cvtpk(PP[BASE + 0], PP[BASE + 1]), a1 = cvtpk(PP[BASE + 2], PP[BASE + 3]);   \
    unsigned b0 = cvtpk(PP[BASE + 4], PP[BASE + 5]), b1 = cvtpk(PP[BASE + 6], PP[BASE + 7]);                              \
    auto r0 = __builtin_amdgcn_permlane32_swap(a0, b0, false, false); auto r1 = __builtin_amdgcn_permlane32_swap(a1, b1, false, false); \
    u32x4 w = {r0[0], r1[0], r0[1], r1[1]}; OUT = *reinterpret_cast<bf16x8*>(&w); } while (0)
    PK4(p0, 0, pa0); PK4(p0, 8, pa1); PK4(p1, 0, pa2); PK4(p1, 8, pa3);
#undef PK4
}
template <int NQ>
__device__ __forceinline__ void qkt(f32x16& p0, f32x16& p1, const char* Ks, const bf16x8* qr, int r32, int hi) {
    p0 = f32x16{}; p1 = f32x16{};
#pragma unroll
    for (int d0 = 0; d0 < NQ; ++d0) { const int cb = (d0 * 16 + hi * 8) * 2;
        const bf16x8 b0 = *reinterpret_cast<const bf16x8*>(Ks + KSWZ(r32, cb));
        const bf16x8 b1 = *reinterpret_cast<const bf16x8*>(Ks + KSWZ(32 + r32, cb));
        p0 = __builtin_amdgcn_mfma_f32_32x32x16_bf16(b0, qr[d0], p0, 0, 0, 0);
        p1 = __builtin_amdgcn_mfma_f32_32x32x16_bf16(b1, qr[d0], p1, 0, 0, 0); }
}
__device__ __forceinline__ int v_st(int k, int c) { const int kk = (k & ~0xC) | ((k & 4) << 1) | ((k & 8) >> 1); return ((kk >> 3) * 4 + (c >> 5)) * 512 + ((kk & 7) * 32 + (c & 31)) * 2; }
__device__ __forceinline__ int v_rd_base(int lane) { return ((lane & 3) << 3) | (((lane >> 2) & 3) << 6) | (((lane >> 4) & 1) << 5) | (((lane >> 5) & 1) << 8); }
constexpr int v_rd_off(int d0, int ks, int half) { return d0 * 512 + ks * 4096 + half * 2048; }
template <int OFF> __device__ __forceinline__ s16x4 tr_read(int vb) {
    s16x4 r; asm volatile("ds_read_b64_tr_b16 %0, %1 offset:%2" : "=&v"(r) : "v"(vb), "i"(OFF) : "memory"); return r;
}
template <int D0> __device__ __forceinline__ void pv_one(f32x16& od, int vb, bf16x8 pa0, bf16x8 pa1, bf16x8 pa2, bf16x8 pa3) {
    const s16x4 l0 = tr_read<v_rd_off(D0, 0, 0)>(vb), h0 = tr_read<v_rd_off(D0, 0, 1)>(vb), l1 = tr_read<v_rd_off(D0, 1, 0)>(vb), h1 = tr_read<v_rd_off(D0, 1, 1)>(vb);
    const s16x4 l2 = tr_read<v_rd_off(D0, 2, 0)>(vb), h2 = tr_read<v_rd_off(D0, 2, 1)>(vb), l3 = tr_read<v_rd_off(D0, 3, 0)>(vb), h3 = tr_read<v_rd_off(D0, 3, 1)>(vb);
    asm volatile("s_waitcnt lgkmcnt(0)" ::: "memory"); SBAR();
#define PKV(L, H) (bf16x8){L[0], L[1], L[2], L[3], H[0], H[1], H[2], H[3]}
    od = __builtin_amdgcn_mfma_f32_32x32x16_bf16(pa0, PKV(l0, h0), od, 0, 0, 0);
    od = __builtin_amdgcn_mfma_f32_32x32x16_bf16(pa1, PKV(l1, h1), od, 0, 0, 0);
    od = __builtin_amdgcn_mfma_f32_32x32x16_bf16(pa2, PKV(l2, h2), od, 0, 0, 0);
    od = __builtin_amdgcn_mfma_f32_32x32x16_bf16(pa3, PKV(l3, h3), od, 0, 0, 0);
#undef PKV
}
__device__ __forceinline__ void pv_d0(f32x16* o, int vb, bf16x8 pa0, bf16x8 pa1, bf16x8 pa2, bf16x8 pa3) {
    pv_one<0>(o[0], vb, pa0, pa1, pa2, pa3); pv_one<1>(o[1], vb, pa0, pa1, pa2, pa3); pv_one<2>(o[2], vb, pa0, pa1, pa2, pa3); pv_one<3>(o[3], vb, pa0, pa1, pa2, pa3);
}
template <int NQ, int EPI>
__device__ __forceinline__ void attn_body(const bf16* __restrict__ Qb, const bf16* __restrict__ Kh, const bf16* __restrict__ Vh, bf16* __restrict__ Y, float* scratch, float lam, const float* dgain, char* lds) {
    constexpr int LDQ = NQ * 16, LDK = NQ * 16, LDV = DV;
    const int tid = threadIdx.x, wid = __builtin_amdgcn_readfirstlane(tid >> 6), lane = tid & 63, r32 = lane & 31, hi = lane >> 5;
    char* V_lds = lds; char* K_lds = lds + 2 * SHM_V;
    float* wsf = (float*)(lds + 2 * SHM_V + 2 * SHM_K) + wid * 64; float* li_l = wsf; float* al_l = wsf + 32;
    float m_reg = -1e30f, l_reg = 0; f32x16 o[4] = {}; bf16x8 qr[NQ];
    const bf16* Qw = Qb + (size_t)(wid * QBLK + r32) * LDQ + hi * 8;
#pragma unroll
    for (int d0 = 0; d0 < NQ; ++d0) qr[d0] = *reinterpret_cast<const bf16x8*>(Qw + d0 * 16);
    const int sr = tid >> 4, sc = (tid & 15) * 8, vst0 = v_st(sr, sc), vst1 = v_st(32 + sr, sc);
    const int kr = NQ == 8 ? sr : (tid >> 3), kc = NQ == 8 ? sc : (tid & 7) * 8;
    const int vb0 = (int)(uintptr_t)V_lds + v_rd_base(lane);
    struct { bf16x8 vs0, vs1, ks0, ks1; } sr_[2];
    const unsigned voff0 = (unsigned)(sr * LDV + sc) * 2u, voff1 = voff0 + 32u * LDV * 2u, koff0 = (unsigned)(kr * LDK + kc) * 2u, koff1 = koff0 + 32u * LDK * 2u;
#define SLOAD(i, k0) do { const char* _vb = (const char*)Vh + (size_t)(k0) * (LDV * 2); const char* _kb = (const char*)Kh + (size_t)(k0) * (LDK * 2); \
    sr_[i].vs0 = *reinterpret_cast<const bf16x8*>(_vb + voff0); sr_[i].vs1 = *reinterpret_cast<const bf16x8*>(_vb + voff1); \
    sr_[i].ks0 = *reinterpret_cast<const bf16x8*>(_kb + koff0); if (NQ == 8) sr_[i].ks1 = *reinterpret_cast<const bf16x8*>(_kb + koff1); } while (0)
#define SWRITE(b, i) do { *(bf16x8*)(V_lds + (b) * SHM_V + vst0) = sr_[i].vs0; *(bf16x8*)(V_lds + (b) * SHM_V + vst1) = sr_[i].vs1; \
    *(bf16x8*)(K_lds + (b) * SHM_K + KSWZ(kr, kc * 2)) = sr_[i].ks0; if (NQ == 8) *(bf16x8*)(K_lds + (b) * SHM_K + KSWZ(32 + kr, kc * 2)) = sr_[i].ks1; } while (0)
#define SWAIT() do { if (NQ == 8) asm volatile("s_waitcnt vmcnt(4)" ::: "memory"); else asm volatile("s_waitcnt vmcnt(3)" ::: "memory"); } while (0)
#define RESC(a) do { if (__any((a) < 1.f)) { if (hi == 0) al_l[r32] = (a); asm volatile("s_waitcnt lgkmcnt(0)" ::: "memory"); \
    _Pragma("unroll") for (int d = 0; d < 4; ++d) _Pragma("unroll") for (int r = 0; r < 16; ++r) o[d][r] *= al_l[crow(r, hi)]; } } while (0)
    f32x16 pA0, pA1, pB0, pB1; float mnA, mnB, alA, alB; bf16x8 pa0, pa1, pa2, pa3; constexpr int NT = SKV / KVBLK;
    constexpr int SE = 0, SO = 1;
    SLOAD(SE, 0); asm volatile("s_waitcnt vmcnt(0)" ::: "memory"); SWRITE(0, SE); __syncthreads();
    qkt<NQ>(pA0, pA1, K_lds, qr, r32, hi); partialSM<NQ>(pA0, pA1, m_reg, mnA, alA);
    SLOAD(SO, KVBLK); SLOAD(SE, 2 * KVBLK);
    SWAIT(); SWRITE(1, SO); __syncthreads();
    for (int j = 1; j + 1 < NT; j += 2) {
        SBAR(); qkt<NQ>(pB0, pB1, K_lds + SHM_K, qr, r32, hi);
        finishSM(pA0, pA1, alA, l_reg, pa0, pa1, pa2, pa3); SBAR();
        SLOAD(SO, (j + 2) * KVBLK); SBAR();
        pv_d0(o, vb0, pa0, pa1, pa2, pa3); partialSM<NQ>(pB0, pB1, m_reg, mnB, alB);
        __syncthreads(); SWAIT(); SWRITE(0, SE);
        RESC(alB); __syncthreads();
        SBAR(); qkt<NQ>(pA0, pA1, K_lds, qr, r32, hi);
        finishSM(pB0, pB1, alB, l_reg, pa0, pa1, pa2, pa3); SBAR();
        if (j + 3 < NT) SLOAD(SE, (j + 3) * KVBLK); SBAR();
        pv_d0(o, vb0 + (int)SHM_V, pa0, pa1, pa2, pa3); partialSM<NQ>(pA0, pA1, m_reg, mnA, alA);
        __syncthreads(); SWAIT(); SWRITE(1, SO);
        RESC(alA); __syncthreads();
    }
    SBAR(); qkt<NQ>(pB0, pB1, K_lds + SHM_K, qr, r32, hi);
    finishSM(pA0, pA1, alA, l_reg, pa0, pa1, pa2, pa3); SBAR();
    pv_d0(o, vb0, pa0, pa1, pa2, pa3); partialSM<NQ>(pB0, pB1, m_reg, mnB, alB);
    __syncthreads(); RESC(alB);
    finishSM(pB0, pB1, alB, l_reg, pa0, pa1, pa2, pa3); SBAR();
    pv_d0(o, vb0 + (int)SHM_V, pa0, pa1, pa2, pa3);
    if (hi == 0) li_l[r32] = l_reg; asm volatile("s_waitcnt lgkmcnt(0)" ::: "memory");
    float rli[16];
#pragma unroll
    for (int r = 0; r < 16; ++r) rli[r] = __builtin_amdgcn_rcpf(li_l[crow(r, hi)]);
    if (EPI == 0) {
        bf16* Yw = Y + (size_t)(wid * QBLK) * 1024;
#pragma unroll
        for (int r = 0; r < 16; ++r) { const int orow = crow(r, hi);
#pragma unroll
            for (int d0 = 0; d0 < 4; ++d0) Yw[(size_t)orow * 1024 + d0 * 32 + r32] = (bf16)(pk2(o[d0][r] * rli[r], 0.f) & 0xffffu); }
    } else if (EPI == 1) {
#pragma unroll
        for (int r = 0; r < 16; ++r)
#pragma unroll
            for (int d0 = 0; d0 < 4; ++d0) scratch[((wid * 16 + r) * 4 + d0) * 64 + lane] = o[d0][r] * rli[r];
    } else {
        bf16* Yw = Y + (size_t)(wid * QBLK) * 1024; float gn[4];
#pragma unroll
        for (int d0 = 0; d0 < 4; ++d0) gn[d0] = dgain[d0 * 32 + r32] * (1.0f - LAM_INIT);
#pragma unroll
        for (int r = 0; r < 16; ++r) { float od[4]; float ss = 0.f;
#pragma unroll
            for (int d0 = 0; d0 < 4; ++d0) { od[d0] = scratch[((wid * 16 + r) * 4 + d0) * 64 + lane] - lam * (o[d0][r] * rli[r]); ss += od[d0] * od[d0]; }
#pragma unroll
            for (int of = 1; of < 32; of <<= 1) ss += __shfl_xor(ss, of);
            const float rstd = rsqrtf(ss * (1.0f / 128.0f) + NORM_EPS); const int orow = crow(r, hi);
#pragma unroll
            for (int d0 = 0; d0 < 4; ++d0) Yw[(size_t)orow * 1024 + d0 * 32 + r32] = (bf16)(pk2(od[d0] * rstd * gn[d0], 0.f) & 0xffffu); }
    }
#undef SLOAD
#undef SWRITE
#undef SWAIT
#undef RESC
}
}
__device__ __forceinline__ void phase_attn(const Params& P, Frame& F) {
    char* lds = (char*)(unsigned char*)F.lds;
    float lam; { const float* lp = P.in[I_DLAMBDA]; const float a = wave_sum(lp[F.lane] * lp[64 + F.lane]), b = wave_sum(lp[128 + F.lane] * lp[192 + F.lane]); lam = __expf(a) - __expf(b) + LAM_INIT; }
    const int u = F.vcu; const int b = u >> 5, h = (u >> 3) & 3, qb = u & 7;
    bf16* Y = WSP(bf16, WS_ABF) + (size_t)(b * 2048 + qb * 256) * 1024;
#ifndef ATTN_TEST
#define ATTN_TEST 7
#endif
    if (ATTN_TEST & 1) {
        const bf16* Q = WSP(bf16, WS_GQ) + ((size_t)(b * 4 + h) * 2048 + qb * 256) * 128;
        const bf16* K = WSP(bf16, WS_GK) + (size_t)(b * 2 + (h >> 1)) * 2304 * 128; const bf16* V = WSP(bf16, WS_GV) + (size_t)(b * 2 + (h >> 1)) * 2304 * 128;
        attn::attn_body<8, 0>(Q, K, V, Y + h * 128, nullptr, 0.f, nullptr, lds);
        __syncthreads();
    }
    {
        float* scr = WSP(float, WS_O0) + (size_t)F.bid * 32768;
        const bf16* V = WSP(bf16, WS_DV) + (size_t)(b * 4 + h) * 2304 * 128;
        const bf16* Q0 = WSP(bf16, WS_DQ) + ((size_t)(b * 8 + 2 * h) * 2048 + qb * 256) * 64; const bf16* K0 = WSP(bf16, WS_DK) + (size_t)(b * 8 + 2 * h) * 2304 * 64;
        if (ATTN_TEST & 2) attn::attn_body<4, 1>(Q0, K0, V, nullptr, scr, 0.f, nullptr, lds);
        __syncthreads();
        if (ATTN_TEST & 4) attn::attn_body<4, 2>(Q0 + (size_t)2048 * 64, K0 + (size_t)2304 * 64, V, Y + 512 + h * 128, scr, lam, P.in[I_DGAIN], lds);
        __syncthreads();
    }
}
#ifndef MK_N_LAUNCHES
#define MK_N_LAUNCHES 1
#endif
constexpr int N_PHASES = 20;
__global__ void __launch_bounds__(NTHR, 2) hybrid_fwd(Params P) {
    extern __shared__ __attribute__((aligned(16))) unsigned char lds_raw[];
    Frame F;
    F.lds = (LAS unsigned char*)lds_raw; F.ws = P.ws;
    F.tid = threadIdx.x; F.lane = F.tid & 63; F.wave = __builtin_amdgcn_readfirstlane(F.tid >> 6);
    F.bid = blockIdx.x; F.vcu = (F.bid & 7) * 32 + (F.bid >> 3);
    volatile LAS unsigned* MISC = (volatile LAS unsigned*)(F.lds + MISC_OFF);
    for (int u = F.tid; u < (LDS_BYTES - LDSCTL_OFF) / 4; u += NTHR) ((LAS unsigned*)(F.lds + LDSCTL_OFF))[u] = 0u;
    __syncthreads();
    XcdBarrier bar; bar.bar = (unsigned*)(P.ws + WS_CTL) + CW_BAR; bar.x = 0; bar.st = nullptr;
    const int lo = P.ph_lo, hi = P.ph_hi;
    if (hi - lo > 1) bar = xcd_barrier_post((unsigned*)(P.ws + WS_CTL) + CW_BAR, MISC + 8);
#ifndef PHASE_MASK
#define PHASE_MASK 0xFFFFF
#endif
#define IN(k) (((PHASE_MASK >> (k)) & 1) && lo <= (k) && (k) < hi)
#define SEAM(k) do { if (IN(k) && IN((k) + 1)) xcd_barrier(bar); } while (0)
    const float* mod = WSP(float, WS_MOD);
    if (IN(0)) { phase_pre(P, F); } SEAM(0);
    if (IN(1)) { phase_norm0(P, F); } SEAM(1);
    if (IN(2)) {
        pg8::DenseOrder S; S.init(WSP(bf16, WS_ABF), WSP(bf16, WS_WT_RECIN), NTOK, REC_IN, F.bid);
        pg8::EpiRecIn E{WSP(bf16, WS_PROJ), WSP(float, WS_FF), WSP(float, WS_LB), WSP(float, WS_ROPE64)};
        pg8::gemm_phase(F.lds, S, E);
    } SEAM(2);
    if (IN(3)) { phase_rec(P, F); } SEAM(3);
    if (IN(4)) { phase_merge(P, F); } SEAM(4);
    if (IN(5)) {
        pg8::DenseOrder S; S.init(WSP(bf16, WS_ABF), WSP(bf16, WS_WT_RECOUT), NTOK, DM, F.bid);
        pg8::EpiResidual E{P.in[I_X], P.in[I_CTX], WSP(float, WS_H1), mod + 2 * 1024};
        pg8::gemm_phase(F.lds, S, E);
    } SEAM(5);
    if (IN(6)) { phase_route<NTOK, 0>(P, F, WSP(float, WS_H1)); } SEAM(6);
    if (IN(7)) { phase_scatter<NTOK>(P, F); } SEAM(7);
    if (IN(8)) {
        pg8::MoeOrder<8, true> S{(const char*)WSP(bf16, WS_XS), (const char*)WSP(bf16, WS_WT_GU), WSP(int, WS_BLKE), 0, F.vcu};
        S.nrb = __builtin_amdgcn_readfirstlane(__hip_atomic_load(WSP(int, WS_BLKE) + MAXRB, RLX_AGENT));
        pg8::EpiSwiglu E{WSP(bf16, WS_H1S), P.in[I_B_GU]};
        pg8::gemm_phase(F.lds, S, E);
    } SEAM(8);
    if (IN(9)) {
        pg8::MoeOrder<4, false> S{(const char*)WSP(bf16, WS_H1S), (const char*)WSP(bf16, WS_WT_DN), WSP(int, WS_BLKE), 0, F.vcu};
        S.nrb = __builtin_amdgcn_readfirstlane(__hip_atomic_load(WSP(int, WS_BLKE) + MAXRB, RLX_AGENT));
        pg8::EpiMoeOut E{WSP(bf16, WS_YS), P.in[I_B_DOWN], WSP(int, WS_RTOK), WSP(float, WS_RGATE)};
        pg8::gemm_phase(F.lds, S, E);
    } SEAM(9);
    if (IN(10)) { phase_norm1(P, F); } SEAM(10);
    if (IN(11)) {
        pg8::DenseOrder S; S.init(WSP(bf16, WS_ABF), WSP(bf16, WS_WT_ATTIN), NTOK, ATT_IN, F.bid);
        pg8::EpiBf16 E{WSP(bf16, WS_PROJ), ATT_IN};
        pg8::gemm_phase(F.lds, S, E);
    } SEAM(11);
    if (IN(12)) { phase_qkv(P, F); } SEAM(12);
    if (IN(13)) { phase_attn(P, F); } SEAM(13);
    if (IN(14)) {
        pg8::DenseOrder S; S.init(WSP(bf16, WS_ABF), WSP(bf16, WS_WT_ATTOUT), NLAT, DM, F.bid);
        pg8::EpiResidual E{WSP(float, WS_H2), WSP(float, WS_H2) + (size_t)NLAT * 1024, WSP(float, WS_H3), mod + 9 * 6144 + 2 * 1024};
        pg8::gemm_phase(F.lds, S, E);
    } SEAM(14);
    if (IN(15)) { phase_route<NLAT, 1>(P, F, WSP(float, WS_H3)); } SEAM(15);
    if (IN(16)) { phase_scatter<NLAT>(P, F); } SEAM(16);
    if (IN(17)) {
        pg8::MoeOrder<8, true> S{(const char*)WSP(bf16, WS_XS), (const char*)(WSP(bf16, WS_WT_GU) + (size_t)32 * 2048 * 1024), WSP(int, WS_BLKE), 0, F.vcu};
        S.nrb = __builtin_amdgcn_readfirstlane(__hip_atomic_load(WSP(int, WS_BLKE) + MAXRB, RLX_AGENT));
        pg8::EpiSwiglu E{WSP(bf16, WS_H1S), P.in[I_B_GU] + 32 * 2048};
        pg8::gemm_phase(F.lds, S, E);
    } SEAM(17);
    if (IN(18)) {
        pg8::MoeOrder<4, false> S{(const char*)WSP(bf16, WS_H1S), (const char*)(WSP(bf16, WS_WT_DN) + (size_t)32 * 1024 * 1024), WSP(int, WS_BLKE), 0, F.vcu};
        S.nrb = __builtin_amdgcn_readfirstlane(__hip_atomic_load(WSP(int, WS_BLKE) + MAXRB, RLX_AGENT));
        pg8::EpiMoeOut E{WSP(bf16, WS_YS), P.in[I_B_DOWN] + 32 * 1024, WSP(int, WS_RTOK), WSP(float, WS_RGATE)};
        pg8::gemm_phase(F.lds, S, E);
    } SEAM(18);
    if (IN(19)) { phase_final(P, F); }
#undef IN
#undef SEAM
}

extern "C" void kernel_launch(void* const* d_in, const int* in_sizes, int n_in, void* d_out, int out_size, void* d_ws, size_t ws_size, hipStream_t stream) {
    static int grid = 0;
    if (grid == 0) {
        if (n_in != 27 || out_size != NLAT * DM || ws_size < WS_END) { fprintf(stderr, "kernel_launch: unexpected shapes: n_in %d out %d ws %zu (need >= %zu)\n", n_in, out_size, ws_size, (size_t)WS_END); grid = -1; return; }
        int dev = 0, cus = 0;
        if (hipGetDevice(&dev) != hipSuccess || hipDeviceGetAttribute(&cus, hipDeviceAttributeMultiprocessorCount, dev) != hipSuccess) { grid = -1; return; }
        if (hipFuncSetAttribute((const void*)hybrid_fwd, hipFuncAttributeMaxDynamicSharedMemorySize, LDS_BYTES) != hipSuccess) { fprintf(stderr, "kernel_launch: hipFuncSetAttribute failed\n"); grid = -1; return; }
        if (cus != 256) fprintf(stderr, "kernel_launch: %d CUs (built for 256)\n", cus);
        grid = 256;
    }
    if (grid < 0) return;
    if (hipMemsetAsync((char*)d_ws + WS_CTL, 0, CTL_ZERO_BYTES, stream) != hipSuccess) return;
    Params p{};
    for (int i = 0; i < 27; ++i) p.in[i] = (const float*)d_in[i];
    p.out = (float*)d_out; p.ws = (unsigned char*)d_ws;
#ifndef DBG_STAGE
#define DBG_STAGE 0
#endif
    const int n_ph = DBG_STAGE == 1 ? 6 : DBG_STAGE == 2 ? 11 : DBG_STAGE == 3 ? 15 : DBG_STAGE == 4 ? 3 : DBG_STAGE == 5 ? 3 : DBG_STAGE == 6 ? 4 : DBG_STAGE == 7 ? 2 : DBG_STAGE == 8 ? 1 : N_PHASES;
#if MK_N_LAUNCHES == 1
    p.ph_lo = 0; p.ph_hi = n_ph;
    hipLaunchKernelGGL(hybrid_fwd, dim3(grid), dim3(NTHR), LDS_BYTES, stream, p);
#else
    for (int k = 0; k < n_ph; ++k) { p.ph_lo = k; p.ph_hi = k + 1; hipLaunchKernelGGL(hybrid_fwd, dim3(grid), dim3(NTHR), LDS_BYTES, stream, p); }
#endif
    if (DBG_STAGE) { const size_t off = DBG_STAGE == 1 ? WS_H1 : DBG_STAGE == 2 ? WS_H2 : DBG_STAGE == 3 ? WS_H3 : DBG_STAGE == 4 ? WS_FF : DBG_STAGE == 5 ? WS_PROJ : DBG_STAGE == 6 ? WS_OREC : DBG_STAGE == 7 ? WS_ABF : WS_WT_GU; (void)hipMemcpyAsync(d_out, (char*)d_ws + off, DBG_STAGE == 7 ? (size_t)36 * MiB : (size_t)NLAT * DM * 4, hipMemcpyDeviceToDevice, stream); }
}
```

```cpp
#include <hip/hip_runtime.h>
#include <cstdio>
#include <cstdint>

#define GAS __attribute__((address_space(1)))
#define LAS __attribute__((address_space(3)))
typedef unsigned short bf16;
typedef float f32x2 __attribute__((ext_vector_type(2)));
typedef float f32x4 __attribute__((ext_vector_type(4)));
typedef float f32x16 __attribute__((ext_vector_type(16)));
typedef unsigned u32x2 __attribute__((ext_vector_type(2)));
typedef unsigned u32x4 __attribute__((ext_vector_type(4)));
typedef short bf16x8 __attribute__((ext_vector_type(8)));
typedef short s16x4 __attribute__((ext_vector_type(4)));

constexpr int BATCH = 8, SEQ = 2048, CTXL = 256, DM = 1024;
constexpr int NLAT = BATCH * SEQ, NCTX = BATCH * CTXL, NTOK = NLAT + NCTX;
constexpr int REC_IN = 4096, ATT_IN = 2560, NEXP = 32, MAXRB = 320;
constexpr float NORM_EPS = 1e-6f;
constexpr float LAM_INIT = 0.35550906759f;
constexpr int NWAVES = 8, NTHR = 512;

constexpr size_t MiB = 1u << 20;
constexpr size_t WS_CTL = 0, CTL_ZERO_BYTES = 1 * MiB;
constexpr size_t WS_MOD = 1 * MiB;
constexpr size_t WS_LB = 2 * MiB;
constexpr size_t WS_ROPE64 = 2 * MiB + 65536;
constexpr size_t WS_ROPE128 = 3 * MiB;
constexpr size_t WS_TOPE = 4 * MiB;
constexpr size_t WS_TOPG = WS_TOPE + 512 * 1024;
constexpr size_t WS_RANK = WS_TOPG + 512 * 1024;
constexpr size_t WS_BCNT = WS_RANK + 512 * 1024;
constexpr size_t WS_RTOK = WS_BCNT + 64 * 1024;
constexpr size_t WS_RGATE = WS_RTOK + 512 * 1024;
constexpr size_t WS_BLKE = WS_RGATE + 512 * 1024;
constexpr size_t WS_WT_RECIN = 8 * MiB, WS_WT_RECOUT = 16 * MiB, WS_WT_ATTIN = 18 * MiB, WS_WT_ATTOUT = 24 * MiB;
constexpr size_t WS_WT_GU = 32 * MiB, WS_WT_DN = 288 * MiB;
constexpr size_t WS_ABF = 416 * MiB, WS_PROJ = 452 * MiB, WS_FF = 596 * MiB, WS_OREC = 668 * MiB;
constexpr size_t WS_H1 = 740 * MiB, WS_H2 = 812 * MiB, WS_H3 = 884 * MiB;
constexpr size_t WS_XS = 948 * MiB, WS_H1S = 1108 * MiB, WS_YS = 1268 * MiB;
constexpr size_t WS_GQ = 1412 * MiB, WS_GK = 1428 * MiB, WS_GV = 1438 * MiB, WS_DQ = 1448 * MiB, WS_DK = 1464 * MiB, WS_DV = 1482 * MiB, WS_O0 = 1500 * MiB;
constexpr size_t WS_END = 1532 * MiB;
constexpr int CW_BAR = 4096;

constexpr int RING_BYTES = 131072;
constexpr int LDSCTL_OFF = RING_BYTES, MISC_OFF = LDSCTL_OFF + 320;
constexpr int LDS_BYTES = 147456;

#define RLX_AGENT __ATOMIC_RELAXED, __HIP_MEMORY_SCOPE_AGENT
#define LDS_WAIT() asm volatile("s_waitcnt lgkmcnt(0)" ::: "memory")
#define VM_WAIT() asm volatile("s_waitcnt vmcnt(0)" ::: "memory")

__device__ __forceinline__ float bf2f(unsigned u) { return __uint_as_float(u << 16); }
__device__ __forceinline__ float bflo(unsigned w) { return __uint_as_float(w << 16); }
__device__ __forceinline__ float bfhi(unsigned w) { return __uint_as_float(w & 0xffff0000u); }
typedef __bf16 bf16x2_t __attribute__((ext_vector_type(2)));
__device__ __forceinline__ unsigned pk2(float lo, float hi) { f32x2 v = {lo, hi}; bf16x2_t b = __builtin_convertvector(v, bf16x2_t); return __builtin_bit_cast(unsigned, b); }
__device__ __forceinline__ float wave_sum(float v) {
#pragma unroll
    for (int o = 1; o < 64; o <<= 1) v += __shfl_xor(v, o);
    return v;
}
__device__ __forceinline__ float fsigmoid(float x) { return 1.0f / (1.0f + __expf(-x)); }
__device__ __forceinline__ float fsilu(float x) { return x / (1.0f + __expf(-x)); }

#define XB_TMO      128
#define XB_XCNT(j)  (256  + 64 * (j))
#define XB_XSUB(j)  (1280 + 64 * (j))
#define XB_XGEN(j)  (2304 + 64 * (j))
#define XB_TOP      3328
#define XB_TOPGEN   3392
#define XCD_BAR_WORDS 3456
#define XB_SPIN_CAP (1u << 18)
__device__ __forceinline__ unsigned xb_ld(unsigned* p)              { return __hip_atomic_load(p, __ATOMIC_RELAXED, __HIP_MEMORY_SCOPE_AGENT); }
__device__ __forceinline__ unsigned xb_add(unsigned* p, unsigned v) { return __hip_atomic_fetch_add(p, v, __ATOMIC_RELAXED, __HIP_MEMORY_SCOPE_AGENT); }
__device__ __forceinline__ unsigned xb_xcc_id() { return (unsigned)__builtin_amdgcn_s_getreg((3 << 11) | 20) & 0xFu; }
#define XB_SPIN(cond, bar) do { unsigned _sp = 0; while (cond) { __builtin_amdgcn_s_sleep(1); \
    if ((++_sp & 255u) == 0u) { if (xb_ld(&(bar)[XB_TMO])) break; if (_sp > XB_SPIN_CAP) { atomicAdd(&(bar)[XB_TMO], 1u); break; } } } } while (0)
struct XcdBarrier { unsigned* bar; unsigned x; volatile LAS unsigned* st; };
__device__ __forceinline__ XcdBarrier xcd_barrier_post(unsigned* bar, volatile LAS unsigned* st) {
    XcdBarrier b; b.bar = bar; b.x = xb_xcc_id(); b.st = st;
    if (threadIdx.x == 0) (void)xb_add(&bar[XB_XCNT(b.x)], 1u);
    return b;
}
__device__ __forceinline__ void xcd_barrier_complete(unsigned* bar, unsigned x, unsigned& nloc, unsigned& nx) {
    const unsigned G = gridDim.x * gridDim.y * gridDim.z;
    unsigned sum, cnt, mine, sp = 0u;
    for (;;) {
        sum = 0u; cnt = 0u; mine = 0u;
#pragma unroll
        for (unsigned j = 0; j < 16; ++j) { const unsigned c = xb_ld(&bar[XB_XCNT(j)]); sum += c; cnt += (c > 0u) ? 1u : 0u; mine = (j == x) ? c : mine; }
        if (sum == G) break;
        __builtin_amdgcn_s_sleep(1);
        if ((++sp & 255u) == 0u) { if (xb_ld(&bar[XB_TMO])) break; if (sp > XB_SPIN_CAP) { atomicAdd(&bar[XB_TMO], 1u); break; } }
    }
    nloc = mine > 0u ? mine : 1u; nx = cnt > 0u ? cnt : 1u;
}
__device__ __forceinline__ void xcd_barrier(const XcdBarrier& b) {
    asm volatile("s_waitcnt vmcnt(0)" ::: "memory");
    __syncthreads();
    if (threadIdx.x == 0) {
        unsigned* bar = b.bar;
        __builtin_amdgcn_s_waitcnt(0);
        unsigned nloc = b.st[0], nx = b.st[1];
        if (nloc == 0u) { xcd_barrier_complete(bar, b.x, nloc, nx); b.st[0] = nloc; b.st[1] = nx; }
        const unsigned old = xb_add(&bar[XB_XSUB(b.x)], 1u);
        const unsigned gen = old / nloc;
        if (old + 1u == (gen + 1u) * nloc) {
            __builtin_amdgcn_fence(__ATOMIC_RELEASE, "agent");
            asm volatile("s_waitcnt vmcnt(0)" ::: "memory");
            const unsigned og = xb_add(&bar[XB_TOP], 1u);
            const unsigned tg = og / nx;
            if (og + 1u == (tg + 1u) * nx) xb_add(&bar[XB_TOPGEN], 1u);
            else XB_SPIN(xb_ld(&bar[XB_TOPGEN]) == tg, bar);
            __builtin_amdgcn_fence(__ATOMIC_ACQUIRE, "agent");
            xb_add(&bar[XB_XGEN(b.x)], 1u);
            asm volatile("s_waitcnt vmcnt(0)" ::: "memory");
        } else {
            XB_SPIN(xb_ld(&bar[XB_XGEN(b.x)]) == gen, bar);
            __builtin_amdgcn_fence(__ATOMIC_ACQUIRE, "agent");
            asm volatile("s_waitcnt vmcnt(0)" ::: "memory");
        }
    }
    __syncthreads();
}

struct Params { const float* in[27]; float* out; unsigned char* ws; int ph_lo, ph_hi; };
struct Frame {
    LAS unsigned char* lds;
    unsigned char* ws;
    int tid, lane, wave, bid, vcu;
};
enum { I_X = 0, I_C, I_CTX, I_CCTX, I_NORM_MIX, I_NORM_FFN, I_W_ADA, I_B_ADA, I_REC_W_IN, I_REC_LB, I_REC_W_OUT, I_HG_GAIN, I_RET_GAIN,
       I_ATT_W_IN, I_ATT_W_OUT, I_ATT_Q_GAIN, I_ATT_K_GAIN, I_DQ_GAIN, I_DK_GAIN, I_DLAMBDA, I_DGAIN, I_W_ROUTER, I_B_ROUTER, I_W_GU, I_B_GU, I_W_DOWN, I_B_DOWN };
#define WSP(T, off) ((T*)(F.ws + (off)))
__device__ __forceinline__ int mod_row(int r) { return r < NLAT ? (r >> 11) : 8; }
__device__ __forceinline__ void pre_modulation(const Params& P, Frame& F) {
    LAS float* s = (LAS float*)F.lds;
    LAS float* red = (LAS float*)(F.lds + 36864);
    const float* c = P.in[I_C]; const float* cctx = P.in[I_CCTX];
    for (int idx = F.tid; idx < 9 * 1024; idx += NTHR) { const int r = idx >> 10, k = idx & 1023; const float cv = r < 8 ? c[r * 1024 + k] : cctx[k]; s[idx] = fsilu(cv); }
    __syncthreads();
    const int l = F.bid / 96, col0 = (F.bid % 96) * 64;
    const float* W = P.in[I_W_ADA] + (size_t)l * 1024 * 6144 + col0 + F.lane;
    float acc[9];
#pragma unroll
    for (int r = 0; r < 9; ++r) acc[r] = 0.f;
    const int k0 = F.wave * 128;
#pragma unroll 2
    for (int kk = 0; kk < 128; kk += 4) {
        float wv[4];
#pragma unroll
        for (int i = 0; i < 4; ++i) wv[i] = W[(size_t)(k0 + kk + i) * 6144];
#pragma unroll
        for (int r = 0; r < 9; ++r) { const f32x4 sv = *(const LAS f32x4*)(s + r * 1024 + k0 + kk); acc[r] += sv.x * wv[0] + sv.y * wv[1] + sv.z * wv[2] + sv.w * wv[3]; }
    }
#pragma unroll
    for (int r = 0; r < 9; ++r) red[(F.wave * 9 + r) * 64 + F.lane] = acc[r];
    __syncthreads();
    float* mod = WSP(float, WS_MOD);
    for (int idx = F.tid; idx < 9 * 64; idx += NTHR) { const int r = idx >> 6, cl = idx & 63; float t = P.in[I_B_ADA][l * 6144 + col0 + cl];
#pragma unroll
        for (int w = 0; w < 8; ++w) t += red[(w * 9 + r) * 64 + cl];
        mod[(size_t)(l * 9 + r) * 6144 + col0 + cl] = t; }
    __syncthreads();
}
__device__ __forceinline__ void pre_tables(const Params& P, Frame& F) {
    const int gt = F.bid * NTHR + F.tid, GT = 256 * NTHR;
    if (gt < 1024) { const float* lg = P.in[I_REC_LB]; const float a = lg[gt], b = lg[1024 + gt], c = lg[2048 + gt]; const float m = fmaxf(a, fmaxf(b, c));
        const float ea = expf(a - m), eb = expf(b - m), ec = expf(c - m); WSP(float, WS_LB)[gt] = ea / (ea + eb + ec); }
    for (int idx = gt; idx < 2048 * 96; idx += GT) {
        const int t = idx / 96, p = idx % 96; const int row = t >> 6, col = t & 63;
        float* dst; int axis_dim, pp;
        if (p < 32) { dst = WSP(float, WS_ROPE64) + ((size_t)t * 32 + p) * 2; axis_dim = 32; pp = p; }
        else { dst = WSP(float, WS_ROPE128) + ((size_t)t * 64 + (p - 32)) * 2; axis_dim = 64; pp = p - 32; }
        const int nf = axis_dim / 2; const int fi = pp < nf ? pp : pp - nf; const float pos = pp < nf ? (float)row : (float)col;
        const float inv = powf(10000.0f, -(float)(2 * fi) / (float)axis_dim); const float ang = pos * inv;
        dst[0] = cosf(ang); dst[1] = sinf(ang);
    }
}
constexpr int TI_RECIN = 1024, TI_RECOUT = 256, TI_ATTIN = 640, TI_ATTOUT = 256, TI_GU = 64 * 512, TI_DN = 64 * 256;
constexpr int TI_TOTAL = TI_RECIN + TI_RECOUT + TI_ATTIN + TI_ATTOUT + TI_GU + TI_DN;
__device__ __forceinline__ void titem_decode(const Params& P, Frame& F, int it, const float*& src, bf16*& dst, int& N) {
    const float* m; bf16* d; int local;
    if (it < TI_RECIN) { N = 4096; m = P.in[I_REC_W_IN]; d = WSP(bf16, WS_WT_RECIN); local = it; }
    else if ((it -= TI_RECIN) < TI_RECOUT) { N = 1024; m = P.in[I_REC_W_OUT]; d = WSP(bf16, WS_WT_RECOUT); local = it; }
    else if ((it -= TI_RECOUT) < TI_ATTIN) { N = 2560; m = P.in[I_ATT_W_IN]; d = WSP(bf16, WS_WT_ATTIN); local = it; }
    else if ((it -= TI_ATTIN) < TI_ATTOUT) { N = 1024; m = P.in[I_ATT_W_OUT]; d = WSP(bf16, WS_WT_ATTOUT); local = it; }
    else if ((it -= TI_ATTOUT) < TI_GU) { N = 2048; const int mat = it >> 9; local = it & 511; m = P.in[I_W_GU] + (size_t)mat * 1024 * 2048; d = WSP(bf16, WS_WT_GU) + (size_t)mat * 2048 * 1024; }
    else { it -= TI_GU; N = 1024; const int mat = it >> 8; local = it & 255; m = P.in[I_W_DOWN] + (size_t)mat * 1024 * 1024; d = WSP(bf16, WS_WT_DN) + (size_t)mat * 1024 * 1024; }
    const int nblk = N >> 6, nb = local % nblk, kb = local / nblk;
    src = m + (size_t)(kb * 64) * N + nb * 64; dst = d + (size_t)(nb * 64) * 1024 + kb * 64;
}
__device__ __forceinline__ void pre_transposes(const Params& P, Frame& F) {
    LAS float* scr = (LAS float*)(F.lds + F.wave * 16384);
    const int gw = F.vcu * NWAVES + F.wave, NGW = 256 * NWAVES;
    const int lr = F.lane >> 4, lc = (F.lane & 15) * 4;
    f32x4 cur[16];
    const float* src; bf16* dst; int N;
    int it = gw;
    if (it < TI_TOTAL) { titem_decode(P, F, it, src, dst, N);
#pragma unroll
        for (int i = 0; i < 16; ++i) cur[i] = *(const f32x4*)(src + (size_t)(4 * i + lr) * N + lc); }
    while (it < TI_TOTAL) {
        const int itn = it + NGW; f32x4 nxt[16]; const float* srcn; bf16* dstn; int Nn;
        if (itn < TI_TOTAL) { titem_decode(P, F, itn, srcn, dstn, Nn);
#pragma unroll
            for (int i = 0; i < 16; ++i) nxt[i] = *(const f32x4*)(srcn + (size_t)(4 * i + lr) * Nn + lc); }
#pragma unroll
        for (int i = 0; i < 16; ++i) { const int k = 4 * i + lr; *(LAS f32x4*)(scr + k * 64 + (lc ^ (((k >> 3) & 7) << 2))) = cur[i]; }
        const int c = F.lane & 7;
#pragma unroll
        for (int j = 0; j < 8; ++j) { const int n = (F.lane >> 3) + 8 * j; const LAS float* sp = scr + (8 * c) * 64 + (n ^ (c << 2));
            u32x4 o; o.x = pk2(sp[0], sp[64]); o.y = pk2(sp[128], sp[192]); o.z = pk2(sp[256], sp[320]); o.w = pk2(sp[384], sp[448]);
            *(u32x4*)(dst + (size_t)n * 1024 + 8 * c) = o; }
        if (itn < TI_TOTAL) {
#pragma unroll
            for (int i = 0; i < 16; ++i) cur[i] = nxt[i];
            dst = dstn; }
        it = itn;
    }
}
__device__ __forceinline__ void phase_pre(const Params& P, Frame& F) {
    if (F.bid < 192) pre_modulation(P, F);
    pre_tables(P, F);
    pre_transposes(P, F);
}

__device__ __forceinline__ void norm_mod_store(const f32x4 (&v)[4], const float* gain, const float* sc, const float* sh, bf16* orow, int lane) {
    float ss = 0.f;
#pragma unroll
    for (int j = 0; j < 4; ++j) ss += (v[j].x * v[j].x + v[j].y * v[j].y) + (v[j].z * v[j].z + v[j].w * v[j].w);
    const float rstd = rsqrtf(wave_sum(ss) * (1.0f / 1024.0f) + NORM_EPS);
#pragma unroll
    for (int j = 0; j < 4; ++j) { const int c = 4 * lane + 256 * j; const f32x4 g = *(const f32x4*)(gain + c), s1 = *(const f32x4*)(sc + c), s0 = *(const f32x4*)(sh + c);
        const f32x4 a = v[j] * rstd * g * (s1 + 1.0f) + s0; u32x2 w; w.x = pk2(a.x, a.y); w.y = pk2(a.z, a.w); *(u32x2*)(orow + c) = w; }
}
__device__ __forceinline__ void phase_norm0(const Params& P, Frame& F) {
    const int gw = F.vcu * NWAVES + F.wave, NGW = 256 * NWAVES; const float* mod = WSP(float, WS_MOD);
    for (int r = gw; r < NTOK; r += NGW) {
        const float* src = r < NLAT ? P.in[I_X] + (size_t)r * 1024 : P.in[I_CTX] + (size_t)(r - NLAT) * 1024; f32x4 v[4];
#pragma unroll
        for (int j = 0; j < 4; ++j) v[j] = *(const f32x4*)(src + 4 * F.lane + 256 * j);
        const float* m = mod + (size_t)mod_row(r) * 6144;
        norm_mod_store(v, P.in[I_NORM_MIX], m + 1024, m, WSP(bf16, WS_ABF) + (size_t)r * 1024, F.lane);
    }
}
__device__ __forceinline__ void load_moe_sum(const float* h1row, const bf16* ysrow  , const float* g2, f32x4 (&v)[4], int lane) {
#pragma unroll
    for (int j = 0; j < 4; ++j) { const int c = 4 * lane + 256 * j; f32x4 s = {0.f, 0.f, 0.f, 0.f};
#pragma unroll
        for (int sl = 0; sl < 4; ++sl) { const u32x2 w = *(const u32x2*)(ysrow + sl * 1024 + c); s.x += bflo(w.x); s.y += bfhi(w.x); s.z += bflo(w.y); s.w += bfhi(w.y); }
        v[j] = *(const f32x4*)(h1row + c) + *(const f32x4*)(g2 + c) * s; }
}
__device__ __forceinline__ void phase_norm1(const Params& P, Frame& F) {
    const int gw = F.vcu * NWAVES + F.wave, NGW = 256 * NWAVES; const float* mod = WSP(float, WS_MOD);
    for (int r = gw; r < NTOK; r += NGW) {
        f32x4 v[4]; const int mr = mod_row(r);
        load_moe_sum(WSP(float, WS_H1) + (size_t)r * 1024, WSP(bf16, WS_YS) + (size_t)r * 4096, mod + (size_t)mr * 6144 + 5 * 1024, v, F.lane);
        float* h2 = WSP(float, WS_H2) + (size_t)r * 1024;
#pragma unroll
        for (int j = 0; j < 4; ++j) *(f32x4*)(h2 + 4 * F.lane + 256 * j) = v[j];
        const float* m = mod + (size_t)(9 + mr) * 6144;
        norm_mod_store(v, P.in[I_NORM_MIX] + 1024, m + 1024, m, WSP(bf16, WS_ABF) + (size_t)r * 1024, F.lane);
    }
}
__device__ __forceinline__ void phase_final(const Params& P, Frame& F) {
    const int gw = F.vcu * NWAVES + F.wave, NGW = 256 * NWAVES; const float* mod = WSP(float, WS_MOD);
    for (int r = gw; r < NLAT; r += NGW) {
        f32x4 v[4]; const int mr = mod_row(r);
        load_moe_sum(WSP(float, WS_H3) + (size_t)r * 1024, WSP(bf16, WS_YS) + (size_t)r * 4096, mod + (size_t)(9 + mr) * 6144 + 5 * 1024, v, F.lane);
        float* o = P.out + (size_t)r * 1024;
#pragma unroll
        for (int j = 0; j < 4; ++j) *(f32x4*)(o + 4 * F.lane + 256 * j) = v[j];
    }
}
namespace pg8 {
constexpr int BM = 256, BK = 64, HALF = 128, HTB = HALF * BK * 2, STAGE_BYTES = 8 * HTB, KD = 1024;
__device__ __forceinline__ int lds_byte(int r, int c) { const int st = (r >> 4) * 2 + (c >> 5), rr = r & 15, cc = c & 31, ob = rr * 64 + cc * 2; return st * 1024 + (ob ^ (((ob >> 9) & 1) << 5)); }
__device__ __forceinline__ void stage_rc(int b, int& R, int& C) { const int st = b / 1024, sb = b % 1024, swz = sb ^ (((sb >> 9) & 1) << 5); R = (st >> 1) * 16 + swz / 64; C = (st & 1) * 32 + (swz % 64) / 2; }
__device__ __forceinline__ int perm32(int rho) { const int n = rho >> 4, i = rho & 15; return 8 * (i >> 2) + 4 * n + (i & 3); }

struct Unit { const char *A0, *A1, *B0, *B1; int r0, c0, aux; };

template <class Epi, class Sched>
__device__ __forceinline__ void gemm_phase(LAS unsigned char* lds, const Sched& S, const Epi& E) {
    const int tid = threadIdx.x, wid = __builtin_amdgcn_readfirstlane(tid >> 6), lane = tid & 63, wr = wid >> 2, wc = wid & 3, fr = lane & 15, fq = lane >> 4;
    constexpr int K = KD, nt = K / BK;
    unsigned voffA[2], voffB[2];
#pragma unroll
    for (int i = 0; i < 2; ++i) { int R, C; stage_rc(tid * 16 + i * 8192, R, C); const int Rb = Epi::PERM ? ((R & ~31) + perm32(R & 31)) : R;
        voffA[i] = (unsigned)(R * K + C) * 2u; voffB[i] = (unsigned)(Rb * K + C) * 2u; }
    constexpr size_t kstep = (size_t)(BK * 2);
    const unsigned ldsw = (unsigned)wid * 1024u;
    const int aoff = lds_byte(wr * 64 + fr, fq * 8), boff = lds_byte(wc * 32 + fr, fq * 8);
#define PG8_SA(b, h) (((b) * 2 + (h)) * HTB)
#define PG8_SB(b, h) ((4 + (b) * 2 + (h)) * HTB)
#define PG8_STAGE(bufoff, gbase, voff) do { _Pragma("unroll") for (int _i = 0; _i < 2; ++_i) \
        __builtin_amdgcn_global_load_lds((const unsigned*)((const char*)(gbase) + (voff)[_i]), (LAS unsigned*)(lds + (bufoff) + ldsw + _i * 8192), 16, 0, 0); } while (0)
#define PG8_LDA(dst, b, h) do { _Pragma("unroll") for (int m = 0; m < 4; ++m) _Pragma("unroll") for (int k = 0; k < 2; ++k) dst[m][k] = *(const LAS bf16x8*)(lds + PG8_SA(b, h) + aoff + m * 2048 + k * 1024); } while (0)
#define PG8_LDB(dst, b, h) do { _Pragma("unroll") for (int n = 0; n < 2; ++n) _Pragma("unroll") for (int k = 0; k < 2; ++k) dst[n][k] = *(const LAS bf16x8*)(lds + PG8_SB(b, h) + boff + n * 2048 + k * 1024); } while (0)
#define PG8_MMA(ai, bj, At, Bt) do { __builtin_amdgcn_s_setprio(1); _Pragma("unroll") for (int m = 0; m < 4; ++m) _Pragma("unroll") for (int n = 0; n < 2; ++n) _Pragma("unroll") for (int k = 0; k < 2; ++k) \
        acc[ai][bj][m][n] = __builtin_amdgcn_mfma_f32_16x16x32_bf16(Bt[n][k], At[m][k], acc[ai][bj][m][n], 0, 0, 0); __builtin_amdgcn_s_setprio(0); } while (0)
#define PG8_WAIT_V(n) asm volatile("s_waitcnt vmcnt(" #n ")" ::: "memory")
#define PG8_WAIT_L(n) asm volatile("s_waitcnt lgkmcnt(" #n ")" ::: "memory")
#define PG8_BAR __builtin_amdgcn_s_barrier()
#define PG8_SCHED __builtin_amdgcn_sched_barrier(0)
    Unit cur, nxt; int ui = 0;
    if (!S.next(0, cur)) return;
    f32x4 acc[2][2][4][2];
#pragma unroll
    for (int a = 0; a < 2; ++a)
#pragma unroll
        for (int b = 0; b < 2; ++b)
#pragma unroll
            for (int m = 0; m < 4; ++m)
#pragma unroll
                for (int n = 0; n < 2; ++n) acc[a][b][m][n] = (f32x4){0.f, 0.f, 0.f, 0.f};
    bf16x8 At[4][2], B0[2][2], B1[2][2];
    PG8_STAGE(PG8_SB(0, 0), cur.B0, voffB); PG8_STAGE(PG8_SB(0, 1), cur.B1, voffB); PG8_STAGE(PG8_SA(0, 0), cur.A0, voffA); PG8_STAGE(PG8_SA(0, 1), cur.A1, voffA);
    if (wr == 1) PG8_BAR;
    PG8_WAIT_V(2); PG8_BAR;
    PG8_STAGE(PG8_SB(1, 0), cur.B0 + kstep, voffB); PG8_STAGE(PG8_SA(1, 0), cur.A0 + kstep, voffA); PG8_STAGE(PG8_SB(1, 1), cur.B1 + kstep, voffB);
    PG8_WAIT_V(6); PG8_BAR;
    for (;;) {
        const bool has_next = S.next(ui + 1, nxt);
        const char* nA0 = has_next ? nxt.A0 : cur.A0; const char* nA1 = has_next ? nxt.A1 : cur.A1;
        const char* nB0 = has_next ? nxt.B0 : cur.B0; const char* nB1 = has_next ? nxt.B1 : cur.B1;
        for (int t = 0; t < nt; t += 2) {
            const bool last = (t == nt - 2);
            const char* a1_1 = cur.A1 + (size_t)(t + 1) * kstep;
            const char* a2_0 = last ? nA0 : cur.A0 + (size_t)(t + 2) * kstep; const char* a2_1 = last ? nA1 : cur.A1 + (size_t)(t + 2) * kstep;
            const char* b2_0 = last ? nB0 : cur.B0 + (size_t)(t + 2) * kstep; const char* b2_1 = last ? nB1 : cur.B1 + (size_t)(t + 2) * kstep;
            const char* a3_0 = a2_0 + kstep; const char* b3_0 = b2_0 + kstep; const char* b3_1 = b2_1 + kstep;
            PG8_LDB(B0, 0, 0); PG8_LDB(B1, 0, 1); PG8_SCHED; PG8_LDA(At, 0, 0); PG8_STAGE(PG8_SA(1, 1), a1_1, voffA);
            PG8_WAIT_V(8); PG8_WAIT_L(0); PG8_BAR; PG8_MMA(0, 0, At, B0); PG8_MMA(0, 1, At, B1); PG8_BAR; PG8_SCHED;
            PG8_LDA(At, 0, 1); PG8_STAGE(PG8_SB(0, 0), b2_0, voffB); PG8_STAGE(PG8_SB(0, 1), b2_1, voffB); PG8_STAGE(PG8_SA(0, 0), a2_0, voffA);
            PG8_WAIT_V(8); PG8_WAIT_L(0); PG8_BAR; PG8_MMA(1, 0, At, B0); PG8_MMA(1, 1, At, B1); PG8_BAR; PG8_SCHED;
            PG8_LDB(B0, 1, 0); PG8_LDB(B1, 1, 1); PG8_SCHED; PG8_LDA(At, 1, 0); PG8_STAGE(PG8_SA(0, 1), a2_1, voffA);
            PG8_WAIT_V(8); PG8_WAIT_L(0); PG8_BAR; PG8_MMA(0, 0, At, B0); PG8_MMA(0, 1, At, B1); PG8_BAR; PG8_SCHED;
            PG8_LDA(At, 1, 1); PG8_STAGE(PG8_SB(1, 0), b3_0, voffB); PG8_STAGE(PG8_SB(1, 1), b3_1, voffB); PG8_STAGE(PG8_SA(1, 0), a3_0, voffA);
            PG8_WAIT_V(8); PG8_WAIT_L(0); PG8_BAR; PG8_MMA(1, 0, At, B0); PG8_MMA(1, 1, At, B1); PG8_BAR; PG8_SCHED;
        }
        if (wr == 0) PG8_BAR;
        E(acc, cur, wr, wc, fr, fq);
        if (!has_next) break;
#pragma unroll
        for (int a = 0; a < 2; ++a)
#pragma unroll
            for (int b = 0; b < 2; ++b)
#pragma unroll
                for (int m = 0; m < 4; ++m)
#pragma unroll
                    for (int n = 0; n < 2; ++n) acc[a][b][m][n] = (f32x4){0.f, 0.f, 0.f, 0.f};
        cur = nxt; ++ui;
        if (wr == 1) PG8_BAR;
    }
    PG8_WAIT_V(0);
    PG8_BAR;
#undef PG8_SA
#undef PG8_SB
#undef PG8_STAGE
#undef PG8_LDA
#undef PG8_LDB
#undef PG8_MMA
#undef PG8_WAIT_V
#undef PG8_WAIT_L
#undef PG8_BAR
#undef PG8_SCHED
}

struct DenseOrder {
    const char* A; const char* Bt; int nM, nN, nwg, c;
    __device__ __forceinline__ void init(const void* A_, const void* Bt_, int M, int N, int c_) { A = (const char*)A_; Bt = (const char*)Bt_; nM = M / BM; nN = N / BM; nwg = nM * nN; c = c_; }
    __device__ __forceinline__ bool next(int i, Unit& u) const {
        const int L = i * 256 + c; if (L >= nwg) return false;
        int wgid = L; { const int q = nwg / 8, r = nwg % 8, xcd = wgid % 8, off = wgid / 8; wgid = (xcd < r ? xcd * (q + 1) : r * (q + 1) + (xcd - r) * q) + off; }
        const int nig = 8 * nN, gid = wgid / nig, fm = gid * 8, gsz = (nM - fm) < 8 ? (nM - fm) : 8;
        const int pm = fm + ((wgid % nig) % gsz), pn = (wgid % nig) / gsz;
        u.A0 = A + (size_t)pm * (BM * 2048); u.A1 = u.A0 + (size_t)HALF * 2048; u.B0 = Bt + (size_t)pn * (BM * 2048); u.B1 = u.B0 + (size_t)HALF * 2048;
        u.r0 = pm * BM; u.c0 = pn * BM; u.aux = pn; return true;
    }
};
template <int NPN, bool GU>
struct MoeOrder {
    const char* A; const char* W; const int* blke; int nrb, vcu;
    __device__ __forceinline__ bool next(int i, Unit& u) const {
        const int L = i * 256 + vcu; const int rb = L / NPN, pn = L % NPN; if (rb >= nrb) return false;
        const int e = __builtin_amdgcn_readfirstlane(__hip_atomic_load(blke + rb, RLX_AGENT));
        u.A0 = A + (size_t)rb * (BM * 2048); u.A1 = u.A0 + (size_t)HALF * 2048;
        if (GU) { u.B0 = W + (size_t)e * (2048 * 2048) + (size_t)pn * (HALF * 2048); u.B1 = u.B0 + (size_t)1024 * 2048; u.c0 = pn * HALF; }
        else    { u.B0 = W + (size_t)e * (1024 * 2048) + (size_t)pn * (BM * 2048); u.B1 = u.B0 + (size_t)HALF * 2048; u.c0 = pn * BM; }
        u.r0 = rb * BM; u.aux = e; return true;
    }
};

#define EPI_ROWS_BEGIN _Pragma("unroll") for (int ai = 0; ai < 2; ++ai) _Pragma("unroll") for (int m = 0; m < 4; ++m) { const int row = u.r0 + ai * HALF + wr * 64 + m * 16 + fr;
#define EPI_ROWS_END }
struct EpiBf16 {
    static constexpr bool PERM = true;
    bf16* O; int ldc;
    __device__ __forceinline__ void operator()(const f32x4 (&acc)[2][2][4][2], const Unit& u, int wr, int wc, int fr, int fq) const {
        const int col0 = u.c0 + wc * 32 + 8 * fq;
        EPI_ROWS_BEGIN bf16* rowp = O + (size_t)row * ldc + col0;
#pragma unroll
            for (int bj = 0; bj < 2; ++bj) { const f32x4 v0 = acc[ai][bj][m][0], v1 = acc[ai][bj][m][1]; u32x4 w; w.x = pk2(v0[0], v0[1]); w.y = pk2(v0[2], v0[3]); w.z = pk2(v1[0], v1[1]); w.w = pk2(v1[2], v1[3]);
                *(u32x4*)(rowp + bj * HALF) = w; }
        EPI_ROWS_END
    }
};
struct EpiRecIn {
    static constexpr bool PERM = true;
    bf16* O; float* FFo; const float* lb; const float* rope;
    __device__ __forceinline__ void operator()(const f32x4 (&acc)[2][2][4][2], const Unit& u, int wr, int wc, int fr, int fq) const {
        const int pn = u.aux; const int col0 = u.c0 + wc * 32 + 8 * fq;
        if (pn >= 2 && pn < 6) {
            f32x4 lbv[2][2];
#pragma unroll
            for (int bj = 0; bj < 2; ++bj)
#pragma unroll
                for (int n = 0; n < 2; ++n) lbv[bj][n] = *(const f32x4*)(lb + col0 - 512 + bj * HALF + 4 * n);
            EPI_ROWS_BEGIN float* rowp = FFo + (size_t)row * 1024 + (col0 - 512);
#pragma unroll
                for (int bj = 0; bj < 2; ++bj)
#pragma unroll
                    for (int n = 0; n < 2; ++n) { const f32x4 z = acc[ai][bj][m][n]; f32x4 o;
#pragma unroll
                        for (int j = 0; j < 4; ++j) o[j] = lbv[bj][n][j] + (1.0f - lbv[bj][n][j]) * fsigmoid(z[j]);
                        *(f32x4*)(rowp + bj * HALF + 4 * n) = o; }
            EPI_ROWS_END
            return;
        }
        const int mode = (pn < 2) ? 1 : (pn == 8 || pn == 9 || pn >= 14) ? 2 : (pn == 10) ? 3 : (pn == 11) ? 4 : 0;
        EPI_ROWS_BEGIN bf16* rowp = O + (size_t)row * REC_IN + col0;
#pragma unroll
            for (int bj = 0; bj < 2; ++bj) { f32x4 v[2] = {acc[ai][bj][m][0], acc[ai][bj][m][1]};
                if (mode == 1) {
#pragma unroll
                    for (int n = 0; n < 2; ++n)
#pragma unroll
                        for (int j = 0; j < 4; ++j) v[n][j] = fsilu(v[n][j]) * 0.08838834764831845f;
                } else if (mode == 2) {
#pragma unroll
                    for (int n = 0; n < 2; ++n)
#pragma unroll
                        for (int j = 0; j < 4; ++j) v[n][j] = fsilu(v[n][j]);
                } else if (mode >= 3) {
                    const float sc = (mode == 4) ? 0.125f : 1.0f;
                    if (row < NLAT) { const int t = row & 2047; const int p0 = ((col0 + bj * HALF) & 63) >> 1;
                        const f32x4 cs0 = *(const f32x4*)(rope + ((size_t)t * 32 + p0) * 2), cs1 = *(const f32x4*)(rope + ((size_t)t * 32 + p0 + 2) * 2);
                        f32x4 a = v[0], b = v[1];
                        v[0][0] = (a[0] * cs0[0] - a[1] * cs0[1]) * sc; v[0][1] = (a[0] * cs0[1] + a[1] * cs0[0]) * sc;
                        v[0][2] = (a[2] * cs0[2] - a[3] * cs0[3]) * sc; v[0][3] = (a[2] * cs0[3] + a[3] * cs0[2]) * sc;
                        v[1][0] = (b[0] * cs1[0] - b[1] * cs1[1]) * sc; v[1][1] = (b[0] * cs1[1] + b[1] * cs1[0]) * sc;
                        v[1][2] = (b[2] * cs1[2] - b[3] * cs1[3]) * sc; v[1][3] = (b[2] * cs1[3] + b[3] * cs1[2]) * sc;
                    } else { v[0] = v[0] * sc; v[1] = v[1] * sc; }
                }
                u32x4 w; w.x = pk2(v[0][0], v[0][1]); w.y = pk2(v[0][2], v[0][3]); w.z = pk2(v[1][0], v[1][1]); w.w = pk2(v[1][2], v[1][3]);
                *(u32x4*)(rowp + bj * HALF) = w; }
        EPI_ROWS_END
    }
};
struct EpiResidual {
    static constexpr bool PERM = false;
    const float* baseLat; const float* baseCtx; float* out; const float* gate;
    __device__ __forceinline__ void operator()(const f32x4 (&acc)[2][2][4][2], const Unit& u, int wr, int wc, int fr, int fq) const {
        const int col0 = u.c0 + wc * 32 + 4 * fq; const float* g = gate + (size_t)mod_row(u.r0) * 6144 + col0;
        f32x4 gv[2][2];
#pragma unroll
        for (int bj = 0; bj < 2; ++bj)
#pragma unroll
            for (int n = 0; n < 2; ++n) gv[bj][n] = *(const f32x4*)(g + bj * HALF + n * 16);
        EPI_ROWS_BEGIN const float* bp = (row < NLAT ? baseLat + (size_t)row * 1024 : baseCtx + (size_t)(row - NLAT) * 1024) + col0; float* op = out + (size_t)row * 1024 + col0;
#pragma unroll
            for (int bj = 0; bj < 2; ++bj)
#pragma unroll
                for (int n = 0; n < 2; ++n) *(f32x4*)(op + bj * HALF + n * 16) = *(const f32x4*)(bp + bj * HALF + n * 16) + gv[bj][n] * acc[ai][bj][m][n];
        EPI_ROWS_END
    }
};
struct EpiSwiglu {
    static constexpr bool PERM = true;
    bf16* O; const float* bgu;
    __device__ __forceinline__ void operator()(const f32x4 (&acc)[2][2][4][2], const Unit& u, int wr, int wc, int fr, int fq) const {
        const int col0 = u.c0 + wc * 32 + 8 * fq; const float* bb = bgu + (size_t)u.aux * 2048 + col0;
        f32x4 bg[2], bu[2];
#pragma unroll
        for (int n = 0; n < 2; ++n) { bg[n] = *(const f32x4*)(bb + 4 * n); bu[n] = *(const f32x4*)(bb + 1024 + 4 * n); }
        EPI_ROWS_BEGIN f32x4 h[2];
#pragma unroll
            for (int n = 0; n < 2; ++n)
#pragma unroll
                for (int j = 0; j < 4; ++j) { const float g = fminf(acc[ai][0][m][n][j] + bg[n][j], 7.0f); const float up = fminf(fmaxf(acc[ai][1][m][n][j] + bu[n][j], -7.0f), 7.0f);
                    h[n][j] = (up + 1.0f) * g * fsigmoid(1.702f * g); }
            u32x4 w; w.x = pk2(h[0][0], h[0][1]); w.y = pk2(h[0][2], h[0][3]); w.z = pk2(h[1][0], h[1][1]); w.w = pk2(h[1][2], h[1][3]);
            *(u32x4*)(O + (size_t)row * 1024 + col0) = w;
        EPI_ROWS_END
    }
};
struct EpiMoeOut {
    static constexpr bool PERM = true;
    bf16* YS; const float* bdn; const int* rtok; const float* rgate;
    __device__ __forceinline__ void operator()(const f32x4 (&acc)[2][2][4][2], const Unit& u, int wr, int wc, int fr, int fq) const {
        const int col0 = u.c0 + wc * 32 + 8 * fq; const float* bb = bdn + (size_t)u.aux * 1024 + col0;
        f32x4 bv[2][2];
#pragma unroll
        for (int bj = 0; bj < 2; ++bj)
#pragma unroll
            for (int n = 0; n < 2; ++n) bv[bj][n] = *(const f32x4*)(bb + bj * HALF + 4 * n);
        EPI_ROWS_BEGIN const int tk = rtok[row]; const float gt = rgate[row];
            if (tk >= 0) { bf16* rowp = YS + (size_t)tk * 1024 + col0;
#pragma unroll
                for (int bj = 0; bj < 2; ++bj) { const f32x4 v0 = (acc[ai][bj][m][0] + bv[bj][0]) * gt, v1 = (acc[ai][bj][m][1] + bv[bj][1]) * gt;
                    u32x4 w; w.x = pk2(v0[0], v0[1]); w.y = pk2(v0[2], v0[3]); w.z = pk2(v1[0], v1[1]); w.w = pk2(v1[2], v1[3]); *(u32x4*)(rowp + bj * HALF) = w; } }
        EPI_ROWS_END
    }
};
}
namespace rec {
template <int DK> struct LL {
    static constexpr int SD = (DK + 8) * 2;
    static constexpr int QIN = 0, KIN = QIN + 64 * SD, ST = KIN + 64 * SD, KSTT = ST + 64 * SD, VT = KSTT + DK * 144, ATT = VT + 64 * 144, TOT = ATT + 64 * 144, DEC = TOT + 8 * 128 * 4, END = DEC + 128 * 4;
};
template <bool RET>
__device__ __forceinline__ void rec_unit(const Params& P, Frame& F, int b, int head, int dir, int vh) {
    constexpr int DK = RET ? 64 : 128, NT_ = RET ? 4 : 8, NVT = RET ? 2 : 4, KS = DK / 32;
    typedef LL<DK> L; constexpr int SD = L::SD;
    LAS unsigned char* lds = F.lds;
    const bf16* PROJ = WSP(bf16, WS_PROJ); const float* FFp = WSP(float, WS_FF); bf16* OR = WSP(bf16, WS_OREC) + (size_t)dir * NTOK * 1024;
    const int qcol = RET ? 2560 + head * 64 : head * 128, kcol = 2816 + head * 64, fcol = dir * 512 + head * 128;
    const int vcol = (RET ? 3072 : 1536) + head * 128 + vh * 64, ocol = (RET ? 512 : 0) + head * 128 + vh * 64;
    const float lg = RET ? __logf(1.0f - exp2f(-5.0f - (float)(dir ? 3 - head : head))) : 0.f;
    const int dp = RET ? (F.tid & 31) : F.lane, tg = RET ? (F.tid >> 5) : F.wave;
    const int vs = F.tid >> 3, vc = (F.tid & 7) * 8;
    const int fr = F.lane & 15, fq = F.lane >> 4;
    const int sdt = RET ? (F.wave >> 1) : F.wave, svt0 = RET ? 2 * (F.wave & 1) : 0;
    f32x4 sacc[NVT];
#pragma unroll
    for (int i = 0; i < NVT; ++i) sacc[i] = (f32x4){0.f, 0.f, 0.f, 0.f};
    for (int idx = F.tid; idx < 64 * SD / 4; idx += NTHR) ((LAS unsigned*)(lds + L::ST))[idx] = 0u;
    if (RET && F.tid < 64) ((LAS float*)(lds + L::DEC))[F.tid] = __expf(64.0f * lg);
    f32x2 fv[NT_]; unsigned qv[NT_], kv[NT_]; u32x4 vv;
#define REC_BASE(n) ((n) < 4 ? NLAT + b * 256 + (dir ? 3 - (n) : (n)) * 64 : b * 2048 + (dir ? 35 - (n) : (n) - 4) * 64)
#define REC_ROW(base, j) ((base) + (dir ? 63 - (j) : (j)))
#define REC_LOAD(n) do { const int _bs = REC_BASE(n); _Pragma("unroll") for (int i = 0; i < NT_; ++i) { const size_t _r = (size_t)REC_ROW(_bs, NT_ * tg + i); \
        qv[i] = *(const unsigned*)(PROJ + _r * REC_IN + qcol + 2 * dp); \
        if (RET) kv[i] = *(const unsigned*)(PROJ + _r * REC_IN + kcol + 2 * dp); else fv[i] = *(const f32x2*)(FFp + _r * 1024 + fcol + 2 * dp); } \
        vv = *(const u32x4*)(PROJ + (size_t)REC_ROW(_bs, vs) * REC_IN + vcol + vc); } while (0)
    REC_LOAD(0);
    for (int n = 0; n < 36; ++n) {
        const int base = REC_BASE(n);
        float kst0[NT_], kst1[NT_];
        if (!RET) {
            f32x2 cs[NT_]; f32x2 run = {0.f, 0.f};
#pragma unroll
            for (int i = 0; i < NT_; ++i) { run.x += __logf(fv[i].x); run.y += __logf(fv[i].y); cs[i] = run; }
            *(LAS f32x2*)(lds + L::TOT + (tg * 128 + 2 * dp) * 4) = run;
            __syncthreads();
            f32x2 pre = {0.f, 0.f}, all = {0.f, 0.f};
#pragma unroll
            for (int g = 0; g < 8; ++g) { const f32x2 t = *(const LAS f32x2*)(lds + L::TOT + (g * 128 + 2 * dp) * 4); all += t; if (g < tg) pre += t; }
#pragma unroll
            for (int i = 0; i < NT_; ++i) { const int j = NT_ * tg + i; const float bx = pre.x + cs[i].x, by = pre.y + cs[i].y;
                const float q0 = bflo(qv[i]), q1 = bfhi(qv[i]), k0 = 1.0f - fv[i].x, k1 = 1.0f - fv[i].y;
                *(LAS unsigned*)(lds + L::QIN + j * SD + 4 * dp) = pk2(q0 * __expf(bx), q1 * __expf(by));
                *(LAS unsigned*)(lds + L::KIN + j * SD + 4 * dp) = pk2(k0 * __expf(fminf(-bx, 80.f)), k1 * __expf(fminf(-by, 80.f)));
                kst0[i] = k0 * __expf(all.x - bx); kst1[i] = k1 * __expf(all.y - by); }
            if (tg == 0) *(LAS f32x2*)(lds + L::DEC + 8 * dp) = (f32x2){__expf(all.x), __expf(all.y)};
            u32x4 w0, w1; w0.x = pk2(kst0[0], kst0[1]); w0.y = pk2(kst0[2], kst0[3]); w0.z = pk2(kst0[4], kst0[5]); w0.w = pk2(kst0[6], kst0[7]);
            w1.x = pk2(kst1[0], kst1[1]); w1.y = pk2(kst1[2], kst1[3]); w1.z = pk2(kst1[4], kst1[5]); w1.w = pk2(kst1[6], kst1[7]);
            *(LAS u32x4*)(lds + L::KSTT + (2 * dp) * 144 + tg * 16) = w0; *(LAS u32x4*)(lds + L::KSTT + (2 * dp + 1) * 144 + tg * 16) = w1;
        } else {
#pragma unroll
            for (int i = 0; i < NT_; ++i) { const int j = NT_ * tg + i; const float eb = __expf((float)(j + 1) * lg), enb = __expf(-(float)(j + 1) * lg), est = __expf((float)(63 - j) * lg);
                const float q0 = bflo(qv[i]), q1 = bfhi(qv[i]), k0 = bflo(kv[i]), k1 = bfhi(kv[i]);
                *(LAS unsigned*)(lds + L::QIN + j * SD + 4 * dp) = pk2(q0 * eb, q1 * eb);
                *(LAS unsigned*)(lds + L::KIN + j * SD + 4 * dp) = pk2(k0 * enb, k1 * enb);
                kst0[i] = k0 * est; kst1[i] = k1 * est; }
            u32x2 w0, w1; w0.x = pk2(kst0[0], kst0[1]); w0.y = pk2(kst0[2], kst0[3]); w1.x = pk2(kst1[0], kst1[1]); w1.y = pk2(kst1[2], kst1[3]);
            *(LAS u32x2*)(lds + L::KSTT + (2 * dp) * 144 + tg * 8) = w0; *(LAS u32x2*)(lds + L::KSTT + (2 * dp + 1) * 144 + tg * 8) = w1;
        }
#pragma unroll
        for (int i = 0; i < 8; ++i) *(LAS bf16*)(lds + L::VT + (vc + i) * 144 + vs * 2) = (bf16)(vv[i >> 1] >> (16 * (i & 1)));
        if (n + 1 < 36) REC_LOAD(n + 1);
        __syncthreads();
        {
            const int ti = F.wave >> 1;
#pragma unroll
            for (int q = 0; q < 2; ++q) { const int si = 2 * (F.wave & 1) + q; f32x4 a4 = {0.f, 0.f, 0.f, 0.f};
                if (si <= ti) {
#pragma unroll
                    for (int kk = 0; kk < KS; ++kk) { const bf16x8 a = *(const LAS bf16x8*)(lds + L::KIN + (si * 16 + fr) * SD + (kk * 32 + fq * 8) * 2);
                        const bf16x8 bb = *(const LAS bf16x8*)(lds + L::QIN + (ti * 16 + fr) * SD + (kk * 32 + fq * 8) * 2);
                        a4 = __builtin_amdgcn_mfma_f32_16x16x32_bf16(a, bb, a4, 0, 0, 0); }
                }
                const int t = ti * 16 + fr, s0 = si * 16 + 4 * fq;
#pragma unroll
                for (int j = 0; j < 4; ++j) if (s0 + j > t) a4[j] = 0.f;
                u32x2 w; w.x = pk2(a4[0], a4[1]); w.y = pk2(a4[2], a4[3]);
                *(LAS u32x2*)(lds + L::ATT + t * 144 + s0 * 2) = w; }
        }
        __syncthreads();
        {
            const int ti = F.wave >> 1; const int t = ti * 16 + fr; bf16* orow = OR + (size_t)REC_ROW(base, t) * 1024 + ocol;
#pragma unroll
            for (int q = 0; q < 2; ++q) { const int vi = 2 * (F.wave & 1) + q; f32x4 a4 = {0.f, 0.f, 0.f, 0.f};
#pragma unroll
                for (int kk = 0; kk < 2; ++kk) { const bf16x8 a = *(const LAS bf16x8*)(lds + L::VT + (vi * 16 + fr) * 144 + (kk * 32 + fq * 8) * 2);
                    const bf16x8 bb = *(const LAS bf16x8*)(lds + L::ATT + t * 144 + (kk * 32 + fq * 8) * 2);
                    a4 = __builtin_amdgcn_mfma_f32_16x16x32_bf16(a, bb, a4, 0, 0, 0); }
#pragma unroll
                for (int kk = 0; kk < KS; ++kk) { const bf16x8 a = *(const LAS bf16x8*)(lds + L::ST + (vi * 16 + fr) * SD + (kk * 32 + fq * 8) * 2);
                    const bf16x8 bb = *(const LAS bf16x8*)(lds + L::QIN + t * SD + (kk * 32 + fq * 8) * 2);
                    a4 = __builtin_amdgcn_mfma_f32_16x16x32_bf16(a, bb, a4, 0, 0, 0); }
                u32x2 w; w.x = pk2(a4[0], a4[1]); w.y = pk2(a4[2], a4[3]);
                *(u32x2*)(orow + vi * 16 + 4 * fq) = w; }
        }
        {
            const f32x4 dec4 = *(const LAS f32x4*)(lds + L::DEC + (sdt * 16 + 4 * fq) * 4);
#pragma unroll
            for (int vt = 0; vt < NVT; ++vt) { f32x4 a4 = sacc[vt] * dec4;
#pragma unroll
                for (int kk = 0; kk < 2; ++kk) { const bf16x8 a = *(const LAS bf16x8*)(lds + L::KSTT + (sdt * 16 + fr) * 144 + (kk * 32 + fq * 8) * 2);
                    const bf16x8 bb = *(const LAS bf16x8*)(lds + L::VT + ((svt0 + vt) * 16 + fr) * 144 + (kk * 32 + fq * 8) * 2);
                    a4 = __builtin_amdgcn_mfma_f32_16x16x32_bf16(a, bb, a4, 0, 0, 0); }
                sacc[vt] = a4; }
        }
        __syncthreads();
#pragma unroll
        for (int vt = 0; vt < NVT; ++vt) { u32x2 w; w.x = pk2(sacc[vt][0], sacc[vt][1]); w.y = pk2(sacc[vt][2], sacc[vt][3]);
            *(LAS u32x2*)(lds + L::ST + ((svt0 + vt) * 16 + fr) * SD + (sdt * 16 + 4 * fq) * 2) = w; }
    }
#undef REC_BASE
#undef REC_ROW
#undef REC_LOAD
    __syncthreads();
}
}
__device__ __forceinline__ void phase_rec(const Params& P, Frame& F) {
    const int u = F.bid; const int vh = u & 1, dir = (u >> 1) & 1, head = (u >> 2) & 3, type = (u >> 4) & 1, b = u >> 5;
    if (type) rec::rec_unit<true>(P, F, b, head, dir, vh); else rec::rec_unit<false>(P, F, b, head, dir, vh);
}
__device__ __forceinline__ void phase_merge(const Params& P, Frame& F) {
    const int gw = F.vcu * NWAVES + F.wave, NGW = 256 * NWAVES; const int c0 = 16 * F.lane; const bool isret = F.lane >= 32;
    const float* gain = (isret ? P.in[I_RET_GAIN] : P.in[I_HG_GAIN]) + (c0 & 127);
    float gn[16];
#pragma unroll
    for (int i = 0; i < 16; ++i) gn[i] = gain[i];
    for (int r = gw; r < NTOK; r += NGW) {
        const bf16* o0 = WSP(bf16, WS_OREC) + (size_t)r * 1024 + c0; const bf16* o1 = o0 + (size_t)NTOK * 1024;
        const bf16* gp = WSP(bf16, WS_PROJ) + (size_t)r * REC_IN + c0 + (isret ? 3072 : 2048);
        u32x4 a[2] = {*(const u32x4*)o0, *(const u32x4*)(o0 + 8)}, bq[2] = {*(const u32x4*)o1, *(const u32x4*)(o1 + 8)}, g[2] = {*(const u32x4*)gp, *(const u32x4*)(gp + 8)};
        float o[16], gt[16]; float s1 = 0.f;
#pragma unroll
        for (int i = 0; i < 8; ++i) { const unsigned wa = a[i >> 2][i & 3], wb = bq[i >> 2][i & 3], wg = g[i >> 2][i & 3];
            o[2 * i] = bflo(wa) + bflo(wb); o[2 * i + 1] = bfhi(wa) + bfhi(wb); gt[2 * i] = bflo(wg); gt[2 * i + 1] = bfhi(wg); s1 += o[2 * i] + o[2 * i + 1]; }
        s1 += __shfl_xor(s1, 1); s1 += __shfl_xor(s1, 2); s1 += __shfl_xor(s1, 4);
        const float mean = isret ? s1 * (1.0f / 128.0f) : 0.f; float s2 = 0.f;
#pragma unroll
        for (int i = 0; i < 16; ++i) { o[i] -= mean; s2 += o[i] * o[i]; }
        s2 += __shfl_xor(s2, 1); s2 += __shfl_xor(s2, 2); s2 += __shfl_xor(s2, 4);
        const float rstd = rsqrtf(s2 * (1.0f / 128.0f) + NORM_EPS);
        u32x4 w[2];
#pragma unroll
        for (int i = 0; i < 8; ++i) w[i >> 2][i & 3] = pk2(o[2 * i] * rstd * gn[2 * i] * gt[2 * i], o[2 * i + 1] * rstd * gn[2 * i + 1] * gt[2 * i + 1]);
        bf16* y = WSP(bf16, WS_ABF) + (size_t)r * 1024 + c0; *(u32x4*)y = w[0]; *(u32x4*)(y + 8) = w[1];
    }
}
template <int NROWS, int LAYER>
__device__ __forceinline__ void phase_route(const Params& P, Frame& F, const float* H) {
    constexpr int RPB = NROWS / 256, RPW = RPB / 8;
    LAS float* tile = (LAS float*)(F.lds + F.wave * 16384);
    LAS int* hist = (LAS int*)(F.lds + 131072);
    if (F.tid < 32) hist[F.tid] = 0;
    __syncthreads();
    const float* mod = WSP(float, WS_MOD); const float* wr = P.in[I_W_ROUTER] + (size_t)LAYER * 1024 * 32; const float* br = P.in[I_B_ROUTER] + LAYER * 32;
    const float* gain = P.in[I_NORM_FFN] + LAYER * 1024;
    int* tope = WSP(int, WS_TOPE); float* topg = WSP(float, WS_TOPG); int* rank = WSP(int, WS_RANK);
    const int e = F.lane & 31, kh = F.lane >> 5;
    const float bias = br[e];
    const int row_w0 = F.bid * RPB + F.wave * RPW;
    for (int g0 = 0; g0 < RPW; g0 += 4) {
        const int nr = (RPW - g0) < 4 ? (RPW - g0) : 4;
        for (int rr = 0; rr < nr; ++rr) {
            const int r = row_w0 + g0 + rr; const float* src = H + (size_t)r * 1024; f32x4 v[4];
#pragma unroll
            for (int j = 0; j < 4; ++j) v[j] = *(const f32x4*)(src + 4 * F.lane + 256 * j);
            float ss = 0.f;
#pragma unroll
            for (int j = 0; j < 4; ++j) ss += (v[j].x * v[j].x + v[j].y * v[j].y) + (v[j].z * v[j].z + v[j].w * v[j].w);
            const float rstd = rsqrtf(wave_sum(ss) * (1.0f / 1024.0f) + NORM_EPS);
            const float* m = mod + (size_t)(LAYER * 9 + mod_row(r)) * 6144;
            bf16* orow = WSP(bf16, WS_ABF) + (size_t)r * 1024;
#pragma unroll
            for (int j = 0; j < 4; ++j) { const int c = 4 * F.lane + 256 * j; const f32x4 gg = *(const f32x4*)(gain + c), s1 = *(const f32x4*)(m + 4096 + c), s0 = *(const f32x4*)(m + 3072 + c);
                const f32x4 a = v[j] * rstd * gg * (s1 + 1.0f) + s0; *(LAS f32x4*)(tile + rr * 1024 + c) = a;
                u32x2 w; w.x = pk2(a.x, a.y); w.y = pk2(a.z, a.w); *(u32x2*)(orow + c) = w; }
        }
        float acc[4] = {0.f, 0.f, 0.f, 0.f};
        const float* wp = wr + (size_t)(kh * 512) * 32 + e; const LAS float* tp = tile + kh * 512;
#pragma unroll 4
        for (int s = 0; s < 512; s += 4) {
            const float w0 = wp[(s + 0) * 32], w1 = wp[(s + 1) * 32], w2 = wp[(s + 2) * 32], w3 = wp[(s + 3) * 32];
#pragma unroll
            for (int rr = 0; rr < 4; ++rr) { const f32x4 fvv = *(const LAS f32x4*)(tp + rr * 1024 + s); acc[rr] += fvv.x * w0 + fvv.y * w1 + fvv.z * w2 + fvv.w * w3; }
        }
#pragma unroll
        for (int rr = 0; rr < 4; ++rr) { acc[rr] += __shfl_xor(acc[rr], 32); acc[rr] += bias; }
        for (int rr = 0; rr < nr; ++rr) {
            const int r = row_w0 + g0 + rr; float val = acc[rr]; float tv[4]; int ti[4];
#pragma unroll
            for (int k = 0; k < 4; ++k) { float mx = val;
#pragma unroll
                for (int o = 1; o < 32; o <<= 1) mx = fmaxf(mx, __shfl_xor(mx, o));
                const unsigned long long bal = __ballot(val == mx); const int idx = __ffsll((long long)bal) - 1;
                tv[k] = mx; ti[k] = idx & 31; if (e == (idx & 31)) val = -3.0e38f; }
            const float e1 = __expf(tv[1] - tv[0]), e2 = __expf(tv[2] - tv[0]), e3 = __expf(tv[3] - tv[0]); const float inv = 1.0f / (1.0f + e1 + e2 + e3);
            if (F.lane < 4) { const int k = F.lane; const int ex = k == 0 ? ti[0] : k == 1 ? ti[1] : k == 2 ? ti[2] : ti[3]; const float gv = (k == 0 ? 1.0f : k == 1 ? e1 : k == 2 ? e2 : e3) * inv;
                const int rk = atomicAdd((int*)(hist + ex), 1);
                tope[r * 4 + k] = ex; topg[r * 4 + k] = gv; rank[r * 4 + k] = rk; }
        }
    }
    __syncthreads();
    if (F.tid < 32) WSP(int, WS_BCNT)[F.bid * 32 + F.tid] = hist[F.tid];
    __syncthreads();
}
template <int NROWS>
__device__ __forceinline__ void phase_scatter(const Params& P, Frame& F) {
    constexpr int RPB = NROWS / 256;
    LAS int* part_tot = (LAS int*)F.lds;
    LAS int* part_pre = part_tot + 512;
    LAS int* baseL = part_pre + 512;
    LAS int* padS = baseL + 32;
    LAS int* totL = padS + 40;
    const int* bcnt = WSP(int, WS_BCNT);
    { const int e = F.tid & 31, part = F.tid >> 5; int t = 0, pr = 0;
        for (int bb = part * 16; bb < part * 16 + 16; ++bb) { const int c = bcnt[bb * 32 + e]; t += c; if (bb < F.bid) pr += c; }
        part_tot[part * 32 + e] = t; part_pre[part * 32 + e] = pr; }
    __syncthreads();
    if (F.tid < 32) { int t = 0, pr = 0;
        for (int p = 0; p < 16; ++p) { t += part_tot[p * 32 + F.tid]; pr += part_pre[p * 32 + F.tid]; }
        totL[F.tid] = t; baseL[F.tid] = pr; }
    __syncthreads();
    if (F.tid == 0) { int run = 0; for (int e = 0; e < 32; ++e) { padS[e] = run; run += (totL[e] + 255) & ~255; } padS[32] = run; }
    __syncthreads();
    if (F.tid < 32) baseL[F.tid] += padS[F.tid];
    __syncthreads();
    const int* tope = WSP(int, WS_TOPE); const float* topg = WSP(float, WS_TOPG); const int* rank = WSP(int, WS_RANK);
    int* rtok = WSP(int, WS_RTOK); float* rgate = WSP(float, WS_RGATE);
    for (int a = F.wave; a < RPB * 4; a += NWAVES) {
        const int r = F.bid * RPB + (a >> 2), k = a & 3; const int ex = tope[r * 4 + k]; const int dest = baseL[ex] + rank[r * 4 + k];
        const u32x4* src = (const u32x4*)(WSP(bf16, WS_ABF) + (size_t)r * 1024); u32x4* dst = (u32x4*)(WSP(bf16, WS_XS) + (size_t)dest * 1024);
        const u32x4 v0 = src[F.lane], v1 = src[64 + F.lane]; dst[F.lane] = v0; dst[64 + F.lane] = v1;
        if (F.lane == 0) { rtok[dest] = r * 4 + k; rgate[dest] = topg[r * 4 + k]; }
    }
    if (F.bid < 32) { const int e = F.bid; const int s = padS[e] + totL[e], en = padS[e + 1]; for (int i = s + F.tid; i < en; i += NTHR) { rtok[i] = -1; rgate[i] = 0.f; } }
    if (F.bid == 32) { int* blke = WSP(int, WS_BLKE); const int nrb = padS[32] >> 8;
        for (int rb = F.tid; rb < MAXRB; rb += NTHR) { int ex = -1; if (rb < nrb) { const int row = rb << 8; ex = 0; for (int e = 1; e < 32; ++e) if (row >= padS[e]) ex = e; } blke[rb] = ex; }
        if (F.tid == 0) blke[MAXRB] = nrb; }
    __syncthreads();
}
__device__ __forceinline__ void load8(const bf16* p, float (&x)[8]) { const u32x4 w = *(const u32x4*)p;
#pragma unroll
    for (int i = 0; i < 4; ++i) { x[2 * i] = bflo(w[i]); x[2 * i + 1] = bfhi(w[i]); } }
__device__ __forceinline__ void store8(bf16* p, const float (&x)[8]) { u32x4 w;
#pragma unroll
    for (int i = 0; i < 4; ++i) w[i] = pk2(x[2 * i], x[2 * i + 1]);
    *(u32x4*)p = w; }
__device__ __forceinline__ void rope8(float (&x)[8], const float* cs  ) {
    const f32x4 c0 = *(const f32x4*)cs, c1 = *(const f32x4*)(cs + 4); float y[8];
    y[0] = x[0] * c0[0] - x[1] * c0[1]; y[1] = x[0] * c0[1] + x[1] * c0[0]; y[2] = x[2] * c0[2] - x[3] * c0[3]; y[3] = x[2] * c0[3] + x[3] * c0[2];
    y[4] = x[4] * c1[0] - x[5] * c1[1]; y[5] = x[4] * c1[1] + x[5] * c1[0]; y[6] = x[6] * c1[2] - x[7] * c1[3]; y[7] = x[6] * c1[3] + x[7] * c1[2];
#pragma unroll
    for (int i = 0; i < 8; ++i) x[i] = y[i];
}
template <int GL>
__device__ __forceinline__ void headnorm8(float (&x)[8], const float* gain8) {
    float ss = 0.f;
#pragma unroll
    for (int i = 0; i < 8; ++i) ss += x[i] * x[i];
#pragma unroll
    for (int o = 1; o < GL; o <<= 1) ss += __shfl_xor(ss, o);
    const float rstd = rsqrtf(ss * (1.0f / (8.0f * GL)) + NORM_EPS);
#pragma unroll
    for (int i = 0; i < 8; ++i) x[i] = x[i] * rstd * gain8[i];
}
__device__ __forceinline__ void phase_qkv(const Params& P, Frame& F) {
    const int gw = F.vcu * NWAVES + F.wave, NGW = 256 * NWAVES; const int l = F.lane;
    const bf16* PR = WSP(bf16, WS_PROJ); const float* r64 = WSP(float, WS_ROPE64); const float* r128 = WSP(float, WS_ROPE128);
    float gq[8], gk[8], gdq[8], gdk[8];
#pragma unroll
    for (int i = 0; i < 8; ++i) { gq[i] = P.in[I_ATT_Q_GAIN][(8 * l) % 128 + i]; gk[i] = P.in[I_ATT_K_GAIN][(8 * l) % 128 + i]; gdq[i] = P.in[I_DQ_GAIN][(8 * l) % 64 + i]; gdk[i] = P.in[I_DK_GAIN][(8 * l) % 64 + i]; }
    for (int r = gw; r < NTOK; r += NGW) {
        const bool lat = r < NLAT; const int rc = r - NLAT; const int b = lat ? (r >> 11) : (rc >> 8); const int t = r & 2047; const int pos = lat ? 256 + t : (rc & 255);
        const bf16* row = PR + (size_t)r * ATT_IN; float x[8];
        const int c128 = (8 * l) % 128, c64 = (8 * l) % 64;
        if (lat) {
            load8(row + 8 * l, x); headnorm8<16>(x, gq); rope8(x, r128 + ((size_t)t * 64 + c128 / 2) * 2);
            store8(WSP(bf16, WS_GQ) + ((size_t)(b * 4 + (l >> 4)) * 2048 + t) * 128 + c128, x);
        }
        {
            load8(row + 512 + 8 * l, x); float xn[8];
#pragma unroll
            for (int i = 0; i < 8; ++i) xn[i] = x[i];
            headnorm8<16>(xn, gk); if (lat) rope8(xn, r128 + ((size_t)t * 64 + c128 / 2) * 2);
            const int kvh = (l >> 4) & 1; const size_t off = ((size_t)(b * 2 + kvh) * 2304 + pos) * 128 + c128;
            if (l < 32) store8(WSP(bf16, WS_GK) + off, xn); else store8(WSP(bf16, WS_GV) + off, x);
        }
        if (lat) {
            load8(row + 1024 + 8 * l, x); headnorm8<8>(x, gdq); rope8(x, r64 + ((size_t)t * 32 + c64 / 2) * 2);
            store8(WSP(bf16, WS_DQ) + ((size_t)(b * 8 + (l >> 3)) * 2048 + t) * 64 + c64, x);
        }
        {
            load8(row + 1536 + 8 * l, x); headnorm8<8>(x, gdk); if (lat) rope8(x, r64 + ((size_t)t * 32 + c64 / 2) * 2);
            store8(WSP(bf16, WS_DK) + ((size_t)(b * 8 + (l >> 3)) * 2304 + pos) * 64 + c64, x);
        }
        {
            load8(row + 2048 + 8 * l, x);
            store8(WSP(bf16, WS_DV) + ((size_t)(b * 4 + (l >> 4)) * 2304 + pos) * 128 + c128, x);
        }
    }
}

namespace attn {
constexpr int DV = 128, NW = 8, QBLK = 32, KVBLK = 64, SKV = 2304;
constexpr float THR = 8.f;
constexpr int SHM_V = KVBLK * DV * 2, SHM_K = KVBLK * 128 * 2;
#define KSWZ(row, colB) ((row) * 256 + ((colB) ^ (((row) & 7) << 4)))
#define SBAR() __builtin_amdgcn_sched_barrier(0)
__device__ __forceinline__ int crow(int r, int hi) { return (r & 3) + 8 * (r >> 2) + 4 * hi; }
__device__ __forceinline__ unsigned cvtpk(float lo, float hi) { return pk2(lo, hi); }
template <int NQ> struct Cst { static constexpr float SCALE = NQ == 8 ? 0.088388347648318440f : 0.125f; };
template <int NQ>
__device__ __forceinline__ void partialSM(f32x16& p0, f32x16& p1, float& m_reg, float& mn, float& alpha) {
    constexpr float SCALE = Cst<NQ>::SCALE; constexpr float C = SCALE * 1.4426950408889634f;
    float pmax = p0[0];
#pragma unroll
    for (int r = 1; r < 16; ++r) pmax = fmaxf(pmax, p0[r]);
#pragma unroll
    for (int r = 0; r < 16; ++r) pmax = fmaxf(pmax, p1[r]);
    { auto rr = __builtin_amdgcn_permlane32_swap(__float_as_uint(pmax), __float_as_uint(pmax), false, false);
      pmax = fmaxf(__uint_as_float(rr[0]), __uint_as_float(rr[1])); }
    if (__builtin_expect(__all(pmax - m_reg <= THR / SCALE), 1)) { mn = m_reg; alpha = 1.f; }
    else { mn = fmaxf(m_reg, pmax); alpha = __builtin_amdgcn_exp2f((m_reg - mn) * C); m_reg = mn; }
    const float mnC = -mn * C;
#pragma unroll
    for (int r = 0; r < 16; ++r) p0[r] = fmaf(p0[r], C, mnC);
#pragma unroll
    for (int r = 0; r < 16; ++r) p1[r] = fmaf(p1[r], C, mnC);
#pragma unroll
    for (int r = 0; r < 16; ++r) p0[r] = __builtin_amdgcn_exp2f(p0[r]);
}
__device__ __forceinline__ void finishSM(f32x16& p0, f32x16& p1, float alpha, float& l_reg, bf16x8& pa0, bf16x8& pa1, bf16x8& pa2, bf16x8& pa3) {
#pragma unroll
    for (int r = 0; r < 16; ++r) p1[r] = __builtin_amdgcn_exp2f(p1[r]);
    float ps = 0;
#pragma unroll
    for (int r = 0; r < 16; ++r) ps += p0[r];
#pragma unroll
    for (int r = 0; r < 16; ++r) ps += p1[r];
    { auto rr = __builtin_amdgcn_permlane32_swap(__float_as_uint(ps), __float_as_uint(ps), false, false);
      ps = __uint_as_float(rr[0]) + __uint_as_float(rr[1]); }
    l_reg = l_reg * alpha + ps;
#define PK4(PP, BASE, OUT) do { unsigned a0 = cvtpk(PP[BASE + 0], PP[BASE + 1]), a1 = cvtpk(PP[BASE + 2], PP[BASE + 3]);   \
    unsigned b0 = cvtpk(PP[BASE + 4], PP[BASE + 5]), b1 = cvtpk(PP[BASE + 6], PP[BASE + 7]);                              \
    auto r0 = __builtin_amdgcn_permlane32_swap(a0, b0, false, false); auto r1 = __builtin_amdgcn_permlane32_swap(a1, b1, false, false); \
    u32x4 w = {r0[0], r1[0], r0[1], r1[1]}; OUT = *reinterpret_cast<bf16x8*>(&w); } while (0)
    PK4(p0, 0, pa0); PK4(p0, 8, pa1); PK4(p1, 0, pa2); PK4(p1, 8, pa3);
#undef PK4
}
template <int NQ>
__device__ __forceinline__ void qkt(f32x16& p0, f32x16& p1, const char* Ks, const bf16x8* qr, int r32, int hi) {
    p0 = f32x16{}; p1 = f32x16{};
#pragma unroll
    for (int d0 = 0; d0 < NQ; ++d0) { const int cb = (d0 * 16 + hi * 8) * 2;
        const bf16x8 b0 = *reinterpret_cast<const bf16x8*>(Ks + KSWZ(r32, cb));
        const bf16x8 b1 = *reinterpret_cast<const bf16x8*>(Ks + KSWZ(32 + r32, cb));
        p0 = __builtin_amdgcn_mfma_f32_32x32x16_bf16(b0, qr[d0], p0, 0, 0, 0);
        p1 = __builtin_amdgcn_mfma_f32_32x32x16_bf16(b1, qr[d0], p1, 0, 0, 0); }
}
__device__ __forceinline__ int v_st(int k, int c) { const int kk = (k & ~0xC) | ((k & 4) << 1) | ((k & 8) >> 1); return ((kk >> 3) * 4 + (c >> 5)) * 512 + ((kk & 7) * 32 + (c & 31)) * 2; }
__device__ __forceinline__ int v_rd_base(int lane) { return ((lane & 3) << 3) | (((lane >> 2) & 3) << 6) | (((lane >> 4) & 1) << 5) | (((lane >> 5) & 1) << 8); }
constexpr int v_rd_off(int d0, int ks, int half) { return d0 * 512 + ks * 4096 + half * 2048; }
template <int OFF> __device__ __forceinline__ s16x4 tr_read(int vb) {
    s16x4 r; asm volatile("ds_read_b64_tr_b16 %0, %1 offset:%2" : "=&v"(r) : "v"(vb), "i"(OFF) : "memory"); return r;
}
template <int D0> __device__ __forceinline__ void pv_one(f32x16& od, int vb, bf16x8 pa0, bf16x8 pa1, bf16x8 pa2, bf16x8 pa3) {
    const s16x4 l0 = tr_read<v_rd_off(D0, 0, 0)>(vb), h0 = tr_read<v_rd_off(D0, 0, 1)>(vb), l1 = tr_read<v_rd_off(D0, 1, 0)>(vb), h1 = tr_read<v_rd_off(D0, 1, 1)>(vb);
    const s16x4 l2 = tr_read<v_rd_off(D0, 2, 0)>(vb), h2 = tr_read<v_rd_off(D0, 2, 1)>(vb), l3 = tr_read<v_rd_off(D0, 3, 0)>(vb), h3 = tr_read<v_rd_off(D0, 3, 1)>(vb);
    asm volatile("s_waitcnt lgkmcnt(0)" ::: "memory"); SBAR();
#define PKV(L, H) (bf16x8){L[0], L[1], L[2], L[3], H[0], H[1], H[2], H[3]}
    od = __builtin_amdgcn_mfma_f32_32x32x16_bf16(pa0, PKV(l0, h0), od, 0, 0, 0);
    od = __builtin_amdgcn_mfma_f32_32x32x16_bf16(pa1, PKV(l1, h1), od, 0, 0, 0);
    od = __builtin_amdgcn_mfma_f32_32x32x16_bf16(pa2, PKV(l2, h2), od, 0, 0, 0);
    od = __builtin_amdgcn_mfma_f32_32x32x16_bf16(pa3, PKV(l3, h3), od, 0, 0, 0);
#undef PKV
}
__device__ __forceinline__ void pv_d0(f32x16* o, int vb, bf16x8 pa0, bf16x8 pa1, bf16x8 pa2, bf16x8 pa3) {
    pv_one<0>(o[0], vb, pa0, pa1, pa2, pa3); pv_one<1>(o[1], vb, pa0, pa1, pa2, pa3); pv_one<2>(o[2], vb, pa0, pa1, pa2, pa3); pv_one<3>(o[3], vb, pa0, pa1, pa2, pa3);
}
template <int NQ, int EPI>
__device__ __forceinline__ void attn_body(const bf16* __restrict__ Qb, const bf16* __restrict__ Kh, const bf16* __restrict__ Vh, bf16* __restrict__ Y, float* scratch, float lam, const float* dgain, char* lds) {
    constexpr int LDQ = NQ * 16, LDK = NQ * 16, LDV = DV;
    const int tid = threadIdx.x, wid = __builtin_amdgcn_readfirstlane(tid >> 6), lane = tid & 63, r32 = lane & 31, hi = lane >> 5;
    char* V_lds = lds; char* K_lds = lds + 2 * SHM_V;
    float* wsf = (float*)(lds + 2 * SHM_V + 2 * SHM_K) + wid * 64; float* li_l = wsf; float* al_l = wsf + 32;
    float m_reg = -1e30f, l_reg = 0; f32x16 o[4] = {}; bf16x8 qr[NQ];
    const bf16* Qw = Qb + (size_t)(wid * QBLK + r32) * LDQ + hi * 8;
#pragma unroll
    for (int d0 = 0; d0 < NQ; ++d0) qr[d0] = *reinterpret_cast<const bf16x8*>(Qw + d0 * 16);
    const int sr = tid >> 4, sc = (tid & 15) * 8, vst0 = v_st(sr, sc), vst1 = v_st(32 + sr, sc);
    const int kr = NQ == 8 ? sr : (tid >> 3), kc = NQ == 8 ? sc : (tid & 7) * 8;
    const int vb0 = (int)(uintptr_t)V_lds + v_rd_base(lane);
    struct { bf16x8 vs0, vs1, ks0, ks1; } sr_[2];
    const unsigned voff0 = (unsigned)(sr * LDV + sc) * 2u, voff1 = voff0 + 32u * LDV * 2u, koff0 = (unsigned)(kr * LDK + kc) * 2u, koff1 = koff0 + 32u * LDK * 2u;
#define SLOAD(i, k0) do { const char* _vb = (const char*)Vh + (size_t)(k0) * (LDV * 2); const char* _kb = (const char*)Kh + (size_t)(k0) * (LDK * 2); \
    sr_[i].vs0 = *reinterpret_cast<const bf16x8*>(_vb + voff0); sr_[i].vs1 = *reinterpret_cast<const bf16x8*>(_vb + voff1); \
    sr_[i].ks0 = *reinterpret_cast<const bf16x8*>(_kb + koff0); if (NQ == 8) sr_[i].ks1 = *reinterpret_cast<const bf16x8*>(_kb + koff1); } while (0)
#define SWRITE(b, i) do { *(bf16x8*)(V_lds + (b) * SHM_V + vst0) = sr_[i].vs0; *(bf16x8*)(V_lds + (b) * SHM_V + vst1) = sr_[i].vs1; \
    *(bf16x8*)(K_lds + (b) * SHM_K + KSWZ(kr, kc * 2)) = sr_[i].ks0; if (NQ == 8) *(bf16x8*)(K_lds + (b) * SHM_K + KSWZ(32 + kr, kc * 2)) = sr_[i].ks1; } while (0)
#define SWAIT() do { if (NQ == 8) asm volatile("s_waitcnt vmcnt(4)" ::: "memory"); else asm volatile("s_waitcnt vmcnt(3)" ::: "memory"); } while (0)
#define RESC(a) do { if (__any((a) < 1.f)) { if (hi == 0) al_l[r32] = (a); asm volatile("s_waitcnt lgkmcnt(0)" ::: "memory"); \
    _Pragma("unroll") for (int d = 0; d < 4; ++d) _Pragma("unroll") for (int r = 0; r < 16; ++r) o[d][r] *= al_l[crow(r, hi)]; } } while (0)
    f32x16 pA0, pA1, pB0, pB1; float mnA, mnB, alA, alB; bf16x8 pa0, pa1, pa2, pa3; constexpr int NT = SKV / KVBLK;
    constexpr int SE = 0, SO = 1;
    SLOAD(SE, 0); asm volatile("s_waitcnt vmcnt(0)" ::: "memory"); SWRITE(0, SE); __syncthreads();
    qkt<NQ>(pA0, pA1, K_lds, qr, r32, hi); partialSM<NQ>(pA0, pA1, m_reg, mnA, alA);
    SLOAD(SO, KVBLK); SLOAD(SE, 2 * KVBLK);
    SWAIT(); SWRITE(1, SO); __syncthreads();
    for (int j = 1; j + 1 < NT; j += 2) {
        SBAR(); qkt<NQ>(pB0, pB1, K_lds + SHM_K, qr, r32, hi);
        finishSM(pA0, pA1, alA, l_reg, pa0, pa1, pa2, pa3); SBAR();
        SLOAD(SO, (j + 2) * KVBLK); SBAR();
        pv_d0(o, vb0, pa0, pa1, pa2, pa3); partialSM<NQ>(pB0, pB1, m_reg, mnB, alB);
        __syncthreads(); SWAIT(); SWRITE(0, SE);
        RESC(alB); __syncthreads();
        SBAR(); qkt<NQ>(pA0, pA1, K_lds, qr, r32, hi);
        finishSM(pB0, pB1, alB, l_reg, pa0, pa1, pa2, pa3); SBAR();
        if (j + 3 < NT) SLOAD(SE, (j + 3) * KVBLK); SBAR();
        pv_d0(o, vb0 + (int)SHM_V, pa0, pa1, pa2, pa3); partialSM<NQ>(pA0, pA1, m_reg, mnA, alA);
        __syncthreads(); SWAIT(); SWRITE(1, SO);
        RESC(alA); __syncthreads();
    }
    SBAR(); qkt<NQ>(pB0, pB1, K_lds + SHM_K, qr, r32, hi);
    finishSM(pA0, pA1, alA, l_reg, pa0, pa1, pa2, pa3); SBAR();
    pv_d0(o, vb0, pa0, pa1, pa2, pa3); partialSM<NQ>(pB0, pB1, m_reg, mnB, alB);
    __syncthreads(); RESC(alB);
    finishSM(pB0, pB1, alB, l_reg, pa0, pa1, pa2, pa3); SBAR();
    pv_d0(o, vb0 + (int)SHM_V, pa0, pa1, pa2, pa3);
    if (hi == 0) li_l[r32] = l_reg; asm volatile("s_waitcnt lgkmcnt(0)" ::: "memory");
    float rli[16];
#pragma unroll
    for (int r = 0; r < 16; ++r) rli[r] = __builtin_amdgcn_rcpf(li_l[crow(r, hi)]);
    if (EPI == 0) {
        bf16* Yw = Y + (size_t)(wid * QBLK) * 1024;
#pragma unroll
        for (int r = 0; r < 16; ++r) { const int orow = crow(r, hi);
#pragma unroll
            for (int d0 = 0; d0 < 4; ++d0) Yw[(size_t)orow * 1024 + d0 * 32 + r32] = (bf16)(pk2(o[d0][r] * rli[r], 0.f) & 0xffffu); }
    } else if (EPI == 1) {
#pragma unroll
        for (int r = 0; r < 16; ++r)
#pragma unroll
            for (int d0 = 0; d0 < 4; ++d0) scratch[((wid * 16 + r) * 4 + d0) * 64 + lane] = o[d0][r] * rli[r];
    } else {
        bf16* Yw = Y + (size_t)(wid * QBLK) * 1024; float gn[4];
#pragma unroll
        for (int d0 = 0; d0 < 4; ++d0) gn[d0] = dgain[d0 * 32 + r32] * (1.0f - LAM_INIT);
#pragma unroll
        for (int r = 0; r < 16; ++r) { float od[4]; float ss = 0.f;
#pragma unroll
            for (int d0 = 0; d0 < 4; ++d0) { od[d0] = scratch[((wid * 16 + r) * 4 + d0) * 64 + lane] - lam * (o[d0][r] * rli[r]); ss += od[d0] * od[d0]; }
#pragma unroll
            for (int of = 1; of < 32; of <<= 1) ss += __shfl_xor(ss, of);
            const float rstd = rsqrtf(ss * (1.0f / 128.0f) + NORM_EPS); const int orow = crow(r, hi);
#pragma unroll
            for (int d0 = 0; d0 < 4; ++d0) Yw[(size_t)orow * 1024 + d0 * 32 + r32] = (bf16)(pk2(od[d0] * rstd * gn[d0], 0.f) & 0xffffu); }
    }
#undef SLOAD
#undef SWRITE
#undef SWAIT
#undef RESC
}
}
__device__ __forceinline__ void phase_attn(const Params& P, Frame& F) {
    char* lds = (char*)(unsigned char*)F.lds;
    float lam; { const float* lp = P.in[I_DLAMBDA]; const float a = wave_sum(lp[F.lane] * lp[64 + F.lane]), b = wave_sum(lp[128 + F.lane] * lp[192 + F.lane]); lam = __expf(a) - __expf(b) + LAM_INIT; }
    const int u = F.vcu; const int b = u >> 5, h = (u >> 3) & 3, qb = u & 7;
    bf16* Y = WSP(bf16, WS_ABF) + (size_t)(b * 2048 + qb * 256) * 1024;
#ifndef ATTN_TEST
#define ATTN_TEST 7
#endif
    if (ATTN_TEST & 1) {
        const bf16* Q = WSP(bf16, WS_GQ) + ((size_t)(b * 4 + h) * 2048 + qb * 256) * 128;
        const bf16* K = WSP(bf16, WS_GK) + (size_t)(b * 2 + (h >> 1)) * 2304 * 128; const bf16* V = WSP(bf16, WS_GV) + (size_t)(b * 2 + (h >> 1)) * 2304 * 128;
        attn::attn_body<8, 0>(Q, K, V, Y + h * 128, nullptr, 0.f, nullptr, lds);
        __syncthreads();
    }
    {
        float* scr = WSP(float, WS_O0) + (size_t)F.bid * 32768;
        const bf16* V = WSP(bf16, WS_DV) + (size_t)(b * 4 + h) * 2304 * 128;
        const bf16* Q0 = WSP(bf16, WS_DQ) + ((size_t)(b * 8 + 2 * h) * 2048 + qb * 256) * 64; const bf16* K0 = WSP(bf16, WS_DK) + (size_t)(b * 8 + 2 * h) * 2304 * 64;
        if (ATTN_TEST & 2) attn::attn_body<4, 1>(Q0, K0, V, nullptr, scr, 0.f, nullptr, lds);
        __syncthreads();
        if (ATTN_TEST & 4) attn::attn_body<4, 2>(Q0 + (size_t)2048 * 64, K0 + (size_t)2304 * 64, V, Y + 512 + h * 128, scr, lam, P.in[I_DGAIN], lds);
        __syncthreads();
    }
}
#ifndef MK_N_LAUNCHES
#define MK_N_LAUNCHES 1
#endif
constexpr int N_PHASES = 20;
__global__ void __launch_bounds__(NTHR, 2) hybrid_fwd(Params P) {
    extern __shared__ __attribute__((aligned(16))) unsigned char lds_raw[];
    Frame F;
    F.lds = (LAS unsigned char*)lds_raw; F.ws = P.ws;
    F.tid = threadIdx.x; F.lane = F.tid & 63; F.wave = __builtin_amdgcn_readfirstlane(F.tid >> 6);
    F.bid = blockIdx.x; F.vcu = (F.bid & 7) * 32 + (F.bid >> 3);
    volatile LAS unsigned* MISC = (volatile LAS unsigned*)(F.lds + MISC_OFF);
    for (int u = F.tid; u < (LDS_BYTES - LDSCTL_OFF) / 4; u += NTHR) ((LAS unsigned*)(F.lds + LDSCTL_OFF))[u] = 0u;
    __syncthreads();
    XcdBarrier bar; bar.bar = (unsigned*)(P.ws + WS_CTL) + CW_BAR; bar.x = 0; bar.st = nullptr;
    const int lo = P.ph_lo, hi = P.ph_hi;
    if (hi - lo > 1) bar = xcd_barrier_post((unsigned*)(P.ws + WS_CTL) + CW_BAR, MISC + 8);
#ifndef PHASE_MASK
#define PHASE_MASK 0xFFFFF
#endif
#define IN(k) (((PHASE_MASK >> (k)) & 1) && lo <= (k) && (k) < hi)
#define SEAM(k) do { if (IN(k) && IN((k) + 1)) xcd_barrier(bar); } while (0)
    const float* mod = WSP(float, WS_MOD);
    if (IN(0)) { phase_pre(P, F); } SEAM(0);
    if (IN(1)) { phase_norm0(P, F); } SEAM(1);
    if (IN(2)) {
        pg8::DenseOrder S; S.init(WSP(bf16, WS_ABF), WSP(bf16, WS_WT_RECIN), NTOK, REC_IN, F.bid);
        pg8::EpiRecIn E{WSP(bf16, WS_PROJ), WSP(float, WS_FF), WSP(float, WS_LB), WSP(float, WS_ROPE64)};
        pg8::gemm_phase(F.lds, S, E);
    } SEAM(2);
    if (IN(3)) { phase_rec(P, F); } SEAM(3);
    if (IN(4)) { phase_merge(P, F); } SEAM(4);
    if (IN(5)) {
        pg8::DenseOrder S; S.init(WSP(bf16, WS_ABF), WSP(bf16, WS_WT_RECOUT), NTOK, DM, F.bid);
        pg8::EpiResidual E{P.in[I_X], P.in[I_CTX], WSP(float, WS_H1), mod + 2 * 1024};
        pg8::gemm_phase(F.lds, S, E);
    } SEAM(5);
    if (IN(6)) { phase_route<NTOK, 0>(P, F, WSP(float, WS_H1)); } SEAM(6);
    if (IN(7)) { phase_scatter<NTOK>(P, F); } SEAM(7);
    if (IN(8)) {
        pg8::MoeOrder<8, true> S{(const char*)WSP(bf16, WS_XS), (const char*)WSP(bf16, WS_WT_GU), WSP(int, WS_BLKE), 0, F.vcu};
        S.nrb = __builtin_amdgcn_readfirstlane(__hip_atomic_load(WSP(int, WS_BLKE) + MAXRB, RLX_AGENT));
        pg8::EpiSwiglu E{WSP(bf16, WS_H1S), P.in[I_B_GU]};
        pg8::gemm_phase(F.lds, S, E);
    } SEAM(8);
    if (IN(9)) {
        pg8::MoeOrder<4, false> S{(const char*)WSP(bf16, WS_H1S), (const char*)WSP(bf16, WS_WT_DN), WSP(int, WS_BLKE), 0, F.vcu};
        S.nrb = __builtin_amdgcn_readfirstlane(__hip_atomic_load(WSP(int, WS_BLKE) + MAXRB, RLX_AGENT));
        pg8::EpiMoeOut E{WSP(bf16, WS_YS), P.in[I_B_DOWN], WSP(int, WS_RTOK), WSP(float, WS_RGATE)};
        pg8::gemm_phase(F.lds, S, E);
    } SEAM(9);
    if (IN(10)) { phase_norm1(P, F); } SEAM(10);
    if (IN(11)) {
        pg8::DenseOrder S; S.init(WSP(bf16, WS_ABF), WSP(bf16, WS_WT_ATTIN), NTOK, ATT_IN, F.bid);
        pg8::EpiBf16 E{WSP(bf16, WS_PROJ), ATT_IN};
        pg8::gemm_phase(F.lds, S, E);
    } SEAM(11);
    if (IN(12)) { phase_qkv(P, F); } SEAM(12);
    if (IN(13)) { phase_attn(P, F); } SEAM(13);
    if (IN(14)) {
        pg8::DenseOrder S; S.init(WSP(bf16, WS_ABF), WSP(bf16, WS_WT_ATTOUT), NLAT, DM, F.bid);
        pg8::EpiResidual E{WSP(float, WS_H2), WSP(float, WS_H2) + (size_t)NLAT * 1024, WSP(float, WS_H3), mod + 9 * 6144 + 2 * 1024};
        pg8::gemm_phase(F.lds, S, E);
    } SEAM(14);
    if (IN(15)) { phase_route<NLAT, 1>(P, F, WSP(float, WS_H3)); } SEAM(15);
    if (IN(16)) { phase_scatter<NLAT>(P, F); } SEAM(16);
    if (IN(17)) {
        pg8::MoeOrder<8, true> S{(const char*)WSP(bf16, WS_XS), (const char*)(WSP(bf16, WS_WT_GU) + (size_t)32 * 2048 * 1024), WSP(int, WS_BLKE), 0, F.vcu};
        S.nrb = __builtin_amdgcn_readfirstlane(__hip_atomic_load(WSP(int, WS_BLKE) + MAXRB, RLX_AGENT));
        pg8::EpiSwiglu E{WSP(bf16, WS_H1S), P.in[I_B_GU] + 32 * 2048};
        pg8::gemm_phase(F.lds, S, E);
    } SEAM(17);
    if (IN(18)) {
        pg8::MoeOrder<4, false> S{(const char*)WSP(bf16, WS_H1S), (const char*)(WSP(bf16, WS_WT_DN) + (size_t)32 * 1024 * 1024), WSP(int, WS_BLKE), 0, F.vcu};
        S.nrb = __builtin_amdgcn_readfirstlane(__hip_atomic_load(WSP(int, WS_BLKE) + MAXRB, RLX_AGENT));
        pg8::EpiMoeOut E{WSP(bf16, WS_YS), P.in[I_B_DOWN] + 32 * 1024, WSP(int, WS_RTOK), WSP(float, WS_RGATE)};
        pg8::gemm_phase(F.lds, S, E);
    } SEAM(18);
    if (IN(19)) { phase_final(P, F); }
#undef IN
#undef SEAM
}

extern "C" void kernel_launch(void* const* d_in, const int* in_sizes, int n_in, void* d_out, int out_size, void* d_ws, size_t ws_size, hipStream_t stream) {
    static int grid = 0;
    if (grid == 0) {
        if (n_in != 27 || out_size != NLAT * DM || ws_size < WS_END) { fprintf(stderr, "kernel_launch: unexpected shapes: n_in %d out %d ws %zu (need >= %zu)\n", n_in, out_size, ws_size, (size_t)WS_END); grid = -1; return; }
        int dev = 0, cus = 0;
        if (hipGetDevice(&dev) != hipSuccess || hipDeviceGetAttribute(&cus, hipDeviceAttributeMultiprocessorCount, dev) != hipSuccess) { grid = -1; return; }
        if (hipFuncSetAttribute((const void*)hybrid_fwd, hipFuncAttributeMaxDynamicSharedMemorySize, LDS_BYTES) != hipSuccess) { fprintf(stderr, "kernel_launch: hipFuncSetAttribute failed\n"); grid = -1; return; }
        if (cus != 256) fprintf(stderr, "kernel_launch: %d CUs (built for 256)\n", cus);
        grid = 256;
    }
    if (grid < 0) return;
    if (hipMemsetAsync((char*)d_ws + WS_CTL, 0, CTL_ZERO_BYTES, stream) != hipSuccess) return;
    Params p{};
    for (int i = 0; i < 27; ++i) p.in[i] = (const float*)d_in[i];
    p.out = (float*)d_out; p.ws = (unsigned char*)d_ws;
#ifndef DBG_STAGE
#define DBG_STAGE 0
#endif
    const int n_ph = DBG_STAGE == 1 ? 6 : DBG_STAGE == 2 ? 11 : DBG_STAGE == 3 ? 15 : DBG_STAGE == 4 ? 3 : DBG_STAGE == 5 ? 3 : DBG_STAGE == 6 ? 4 : DBG_STAGE == 7 ? 2 : DBG_STAGE == 8 ? 1 : N_PHASES;
#if MK_N_LAUNCHES == 1
    p.ph_lo = 0; p.ph_hi = n_ph;
    hipLaunchKernelGGL(hybrid_fwd, dim3(grid), dim3(NTHR), LDS_BYTES, stream, p);
#else
    for (int k = 0; k < n_ph; ++k) { p.ph_lo = k; p.ph_hi = k + 1; hipLaunchKernelGGL(hybrid_fwd, dim3(grid), dim3(NTHR), LDS_BYTES, stream, p); }
#endif
    if (DBG_STAGE) { const size_t off = DBG_STAGE == 1 ? WS_H1 : DBG_STAGE == 2 ? WS_H2 : DBG_STAGE == 3 ? WS_H3 : DBG_STAGE == 4 ? WS_FF : DBG_STAGE == 5 ? WS_PROJ : DBG_STAGE == 6 ? WS_OREC : DBG_STAGE == 7 ? WS_ABF : WS_WT_GU; (void)hipMemcpyAsync(d_out, (char*)d_ws + off, DBG_STAGE == 7 ? (size_t)36 * MiB : (size_t)NLAT * DM * 4, hipMemcpyDeviceToDevice, stream); }
}
```

```cpp
#include <hip/hip_runtime.h>
#include <cstdio>
#include <cstdint>

#define GAS __attribute__((address_space(1)))
#define LAS __attribute__((address_space(3)))
typedef unsigned short bf16;
typedef float f32x2 __attribute__((ext_vector_type(2)));
typedef float f32x4 __attribute__((ext_vector_type(4)));
typedef float f32x16 __attribute__((ext_vector_type(16)));
typedef unsigned u32x2 __attribute__((ext_vector_type(2)));
typedef unsigned u32x4 __attribute__((ext_vector_type(4)));
typedef short bf16x8 __attribute__((ext_vector_type(8)));
typedef short s16x4 __attribute__((ext_vector_type(4)));

constexpr int BATCH = 8, SEQ = 2048, CTXL = 256, DM = 1024;
constexpr int NLAT = BATCH * SEQ, NCTX = BATCH * CTXL, NTOK = NLAT + NCTX;
constexpr int REC_IN = 4096, ATT_IN = 2560, NEXP = 32, MAXRB = 320;
constexpr float NORM_EPS = 1e-6f;
constexpr float LAM_INIT = 0.35550906759f;
constexpr int NWAVES = 8, NTHR = 512;

constexpr size_t MiB = 1u << 20;
constexpr size_t WS_CTL = 0, CTL_ZERO_BYTES = 1 * MiB;
constexpr size_t WS_MOD = 1 * MiB;
constexpr size_t WS_LB = 2 * MiB;
constexpr size_t WS_ROPE64 = 2 * MiB + 65536;
constexpr size_t WS_ROPE128 = 3 * MiB;
constexpr size_t WS_TOPE = 4 * MiB;
constexpr size_t WS_TOPG = WS_TOPE + 512 * 1024;
constexpr size_t WS_RANK = WS_TOPG + 512 * 1024;
constexpr size_t WS_BCNT = WS_RANK + 512 * 1024;
constexpr size_t WS_RTOK = WS_BCNT + 64 * 1024;
constexpr size_t WS_RGATE = WS_RTOK + 512 * 1024;
constexpr size_t WS_BLKE = WS_RGATE + 512 * 1024;
constexpr size_t WS_SGU = 7 * MiB;
constexpr size_t WS_FSC = 7 * MiB + 512 * 1024;
constexpr size_t WS_RSC = 7 * MiB + 640 * 1024;
constexpr size_t WS_WT_RECIN = 8 * MiB, WS_WT_RECOUT = 16 * MiB, WS_WT_ATTIN = 18 * MiB, WS_WT_ATTOUT = 24 * MiB;
constexpr size_t WS_WT_GU = 32 * MiB, WS_WT_DN = 288 * MiB;
constexpr size_t WS_ABF = 416 * MiB, WS_PROJ = 452 * MiB, WS_FF = 596 * MiB, WS_OREC = 668 * MiB;
constexpr size_t WS_H1 = 740 * MiB, WS_H2 = 812 * MiB, WS_H3 = 884 * MiB;
constexpr size_t WS_XS = 948 * MiB, WS_H1S = 1108 * MiB, WS_YS = 1268 * MiB;
constexpr size_t WS_F8 = WS_XS + 80 * MiB;
constexpr size_t WS_GQ = 1412 * MiB, WS_GK = 1428 * MiB, WS_GV = 1438 * MiB, WS_DQ = 1448 * MiB, WS_DK = 1464 * MiB, WS_DV = 1482 * MiB, WS_O0 = 1500 * MiB;
constexpr size_t WS_END = 1532 * MiB;
constexpr int CW_BAR = 4096;

constexpr int RING_BYTES = 131072;
constexpr int LDSCTL_OFF = RING_BYTES, MISC_OFF = LDSCTL_OFF + 320;
constexpr int LDS_BYTES = 147456;

#define RLX_AGENT __ATOMIC_RELAXED, __HIP_MEMORY_SCOPE_AGENT
#define LDS_WAIT() asm volatile("s_waitcnt lgkmcnt(0)" ::: "memory")
#define VM_WAIT() asm volatile("s_waitcnt vmcnt(0)" ::: "memory")

__device__ __forceinline__ float bf2f(unsigned u) { return __uint_as_float(u << 16); }
__device__ __forceinline__ float bflo(unsigned w) { return __uint_as_float(w << 16); }
__device__ __forceinline__ float bfhi(unsigned w) { return __uint_as_float(w & 0xffff0000u); }
typedef __bf16 bf16x2_t __attribute__((ext_vector_type(2)));
__device__ __forceinline__ unsigned pk2(float lo, float hi) { f32x2 v = {lo, hi}; bf16x2_t b = __builtin_convertvector(v, bf16x2_t); return __builtin_bit_cast(unsigned, b); }
__device__ __forceinline__ float wave_sum(float v) {
#pragma unroll
    for (int o = 1; o < 64; o <<= 1) v += __shfl_xor(v, o);
    return v;
}
__device__ __forceinline__ float fsigmoid(float x) { return 1.0f / (1.0f + __expf(-x)); }
__device__ __forceinline__ float fsilu(float x) { return x / (1.0f + __expf(-x)); }

#define XB_TMO      128
#define XB_XCNT(j)  (256  + 64 * (j))
#define XB_XSUB(j)  (1280 + 64 * (j))
#define XB_XGEN(j)  (2304 + 64 * (j))
#define XB_TOP      3328
#define XB_TOPGEN   3392
#define XCD_BAR_WORDS 3456
#define XB_SPIN_CAP (1u << 18)
__device__ __forceinline__ unsigned xb_ld(unsigned* p)              { return __hip_atomic_load(p, __ATOMIC_RELAXED, __HIP_MEMORY_SCOPE_AGENT); }
__device__ __forceinline__ unsigned xb_add(unsigned* p, unsigned v) { return __hip_atomic_fetch_add(p, v, __ATOMIC_RELAXED, __HIP_MEMORY_SCOPE_AGENT); }
__device__ __forceinline__ unsigned xb_xcc_id() { return (unsigned)__builtin_amdgcn_s_getreg((3 << 11) | 20) & 0xFu; }
#define XB_SPIN(cond, bar) do { unsigned _sp = 0; while (cond) { __builtin_amdgcn_s_sleep(1); \
    if ((++_sp & 255u) == 0u) { if (xb_ld(&(bar)[XB_TMO])) break; if (_sp > XB_SPIN_CAP) { atomicAdd(&(bar)[XB_TMO], 1u); break; } } } } while (0)
struct XcdBarrier { unsigned* bar; unsigned x; volatile LAS unsigned* st; };
__device__ __forceinline__ XcdBarrier xcd_barrier_post(unsigned* bar, volatile LAS unsigned* st) {
    XcdBarrier b; b.bar = bar; b.x = xb_xcc_id(); b.st = st;
    if (threadIdx.x == 0) (void)xb_add(&bar[XB_XCNT(b.x)], 1u);
    return b;
}
__device__ __forceinline__ void xcd_barrier_complete(unsigned* bar, unsigned x, unsigned& nloc, unsigned& nx) {
    const unsigned G = gridDim.x * gridDim.y * gridDim.z;
    unsigned sum, cnt, mine, sp = 0u;
    for (;;) {
        sum = 0u; cnt = 0u; mine = 0u;
#pragma unroll
        for (unsigned j = 0; j < 16; ++j) { const unsigned c = xb_ld(&bar[XB_XCNT(j)]); sum += c; cnt += (c > 0u) ? 1u : 0u; mine = (j == x) ? c : mine; }
        if (sum == G) break;
        __builtin_amdgcn_s_sleep(1);
        if ((++sp & 255u) == 0u) { if (xb_ld(&bar[XB_TMO])) break; if (sp > XB_SPIN_CAP) { atomicAdd(&bar[XB_TMO], 1u); break; } }
    }
    nloc = mine > 0u ? mine : 1u; nx = cnt > 0u ? cnt : 1u;
}
__device__ __forceinline__ void xcd_barrier(const XcdBarrier& b) {
    asm volatile("s_waitcnt vmcnt(0)" ::: "memory");
    __syncthreads();
    if (threadIdx.x == 0) {
        unsigned* bar = b.bar;
        __builtin_amdgcn_s_waitcnt(0);
        unsigned nloc = b.st[0], nx = b.st[1];
        if (nloc == 0u) { xcd_barrier_complete(bar, b.x, nloc, nx); b.st[0] = nloc; b.st[1] = nx; }
        const unsigned old = xb_add(&bar[XB_XSUB(b.x)], 1u);
        const unsigned gen = old / nloc;
        if (old + 1u == (gen + 1u) * nloc) {
            __builtin_amdgcn_fence(__ATOMIC_RELEASE, "agent");
            asm volatile("s_waitcnt vmcnt(0)" ::: "memory");
            const unsigned og = xb_add(&bar[XB_TOP], 1u);
            const unsigned tg = og / nx;
            if (og + 1u == (tg + 1u) * nx) xb_add(&bar[XB_TOPGEN], 1u);
            else XB_SPIN(xb_ld(&bar[XB_TOPGEN]) == tg, bar);
            __builtin_amdgcn_fence(__ATOMIC_ACQUIRE, "agent");
            xb_add(&bar[XB_XGEN(b.x)], 1u);
            asm volatile("s_waitcnt vmcnt(0)" ::: "memory");
        } else {
            XB_SPIN(xb_ld(&bar[XB_XGEN(b.x)]) == gen, bar);
            __builtin_amdgcn_fence(__ATOMIC_ACQUIRE, "agent");
            asm volatile("s_waitcnt vmcnt(0)" ::: "memory");
        }
    }
    __syncthreads();
}

struct Params { const float* in[27]; float* out; unsigned char* ws; int ph_lo, ph_hi; };
struct Frame {
    LAS unsigned char* lds;
    unsigned char* ws;
    int tid, lane, wave, bid, vcu;
};
enum { I_X = 0, I_C, I_CTX, I_CCTX, I_NORM_MIX, I_NORM_FFN, I_W_ADA, I_B_ADA, I_REC_W_IN, I_REC_LB, I_REC_W_OUT, I_HG_GAIN, I_RET_GAIN,
       I_ATT_W_IN, I_ATT_W_OUT, I_ATT_Q_GAIN, I_ATT_K_GAIN, I_DQ_GAIN, I_DK_GAIN, I_DLAMBDA, I_DGAIN, I_W_ROUTER, I_B_ROUTER, I_W_GU, I_B_GU, I_W_DOWN, I_B_DOWN };
#define WSP(T, off) ((T*)(F.ws + (off)))
__device__ __forceinline__ int mod_row(int r) { return r < NLAT ? (r >> 11) : 8; }
__device__ __forceinline__ void pre_modulation(const Params& P, Frame& F) {
    LAS float* s = (LAS float*)F.lds;
    LAS float* red = (LAS float*)(F.lds + 36864);
    const float* c = P.in[I_C]; const float* cctx = P.in[I_CCTX];
    for (int idx = F.tid; idx < 9 * 1024; idx += NTHR) { const int r = idx >> 10, k = idx & 1023; const float cv = r < 8 ? c[r * 1024 + k] : cctx[k]; s[idx] = fsilu(cv); }
    __syncthreads();
    const int l = F.bid / 96, col0 = (F.bid % 96) * 64;
    const float* W = P.in[I_W_ADA] + (size_t)l * 1024 * 6144 + col0 + F.lane;
    float acc[9];
#pragma unroll
    for (int r = 0; r < 9; ++r) acc[r] = 0.f;
    const int k0 = F.wave * 128;
#pragma unroll 2
    for (int kk = 0; kk < 128; kk += 4) {
        float wv[4];
#pragma unroll
        for (int i = 0; i < 4; ++i) wv[i] = W[(size_t)(k0 + kk + i) * 6144];
#pragma unroll
        for (int r = 0; r < 9; ++r) { const f32x4 sv = *(const LAS f32x4*)(s + r * 1024 + k0 + kk); acc[r] += sv.x * wv[0] + sv.y * wv[1] + sv.z * wv[2] + sv.w * wv[3]; }
    }
#pragma unroll
    for (int r = 0; r < 9; ++r) red[(F.wave * 9 + r) * 64 + F.lane] = acc[r];
    __syncthreads();
    float* mod = WSP(float, WS_MOD);
    for (int idx = F.tid; idx < 9 * 64; idx += NTHR) { const int r = idx >> 6, cl = idx & 63; float t = P.in[I_B_ADA][l * 6144 + col0 + cl];
#pragma unroll
        for (int w = 0; w < 8; ++w) t += red[(w * 9 + r) * 64 + cl];
        mod[(size_t)(l * 9 + r) * 6144 + col0 + cl] = t; }
    __syncthreads();
}
__device__ __forceinline__ void pre_tables(const Params& P, Frame& F) {
    const int gt = F.bid * NTHR + F.tid, GT = 256 * NTHR;
    if (gt < 1024) { const float* lg = P.in[I_REC_LB]; const float a = lg[gt], b = lg[1024 + gt], c = lg[2048 + gt]; const float m = fmaxf(a, fmaxf(b, c));
        const float ea = expf(a - m), eb = expf(b - m), ec = expf(c - m); WSP(float, WS_LB)[gt] = ea / (ea + eb + ec); }
    for (int idx = gt; idx < 2048 * 96; idx += GT) {
        const int t = idx / 96, p = idx % 96; const int row = t >> 6, col = t & 63;
        float* dst; int axis_dim, pp;
        if (p < 32) { dst = WSP(float, WS_ROPE64) + ((size_t)t * 32 + p) * 2; axis_dim = 32; pp = p; }
        else { dst = WSP(float, WS_ROPE128) + ((size_t)t * 64 + (p - 32)) * 2; axis_dim = 64; pp = p - 32; }
        const int nf = axis_dim / 2; const int fi = pp < nf ? pp : pp - nf; const float pos = pp < nf ? (float)row : (float)col;
        const float inv = powf(10000.0f, -(float)(2 * fi) / (float)axis_dim); const float ang = pos * inv;
        dst[0] = cosf(ang); dst[1] = sinf(ang);
    }
}
constexpr int TI_RECIN = 1024, TI_RECOUT = 256, TI_ATTIN = 640, TI_ATTOUT = 256, TI_DN = 64 * 256;
constexpr int TI_TOTAL = TI_RECIN + TI_RECOUT + TI_ATTIN + TI_ATTOUT + TI_DN;
__device__ __forceinline__ void titem_decode(const Params& P, Frame& F, int it, const float*& src, bf16*& dst, int& N) {
    const float* m; bf16* d; int local;
    if (it < TI_RECIN) { N = 4096; m = P.in[I_REC_W_IN]; d = WSP(bf16, WS_WT_RECIN); local = it; }
    else if ((it -= TI_RECIN) < TI_RECOUT) { N = 1024; m = P.in[I_REC_W_OUT]; d = WSP(bf16, WS_WT_RECOUT); local = it; }
    else if ((it -= TI_RECOUT) < TI_ATTIN) { N = 2560; m = P.in[I_ATT_W_IN]; d = WSP(bf16, WS_WT_ATTIN); local = it; }
    else if ((it -= TI_ATTIN) < TI_ATTOUT) { N = 1024; m = P.in[I_ATT_W_OUT]; d = WSP(bf16, WS_WT_ATTOUT); local = it; }
    else { it -= TI_ATTOUT; N = 1024; const int mat = it >> 8; local = it & 255; m = P.in[I_W_DOWN] + (size_t)mat * 1024 * 1024; d = WSP(bf16, WS_WT_DN) + (size_t)mat * 1024 * 1024; }
    const int nblk = N >> 6, nb = local % nblk, kb = local / nblk;
    src = m + (size_t)(kb * 64) * N + nb * 64; dst = d + (size_t)(nb * 64) * 1024 + kb * 64;
}
__device__ __forceinline__ void pre_transposes(const Params& P, Frame& F) {
    LAS float* scr = (LAS float*)(F.lds + F.wave * 16384);
    const int gw = F.vcu * NWAVES + F.wave, NGW = 256 * NWAVES;
    const int lr = F.lane >> 4, lc = (F.lane & 15) * 4;
    f32x4 cur[16];
    const float* src; bf16* dst; int N;
    int it = gw;
    if (it < TI_TOTAL) { titem_decode(P, F, it, src, dst, N);
#pragma unroll
        for (int i = 0; i < 16; ++i) cur[i] = *(const f32x4*)(src + (size_t)(4 * i + lr) * N + lc); }
    while (it < TI_TOTAL) {
        const int itn = it + NGW; f32x4 nxt[16]; const float* srcn; bf16* dstn; int Nn;
        if (itn < TI_TOTAL) { titem_decode(P, F, itn, srcn, dstn, Nn);
#pragma unroll
            for (int i = 0; i < 16; ++i) nxt[i] = *(const f32x4*)(srcn + (size_t)(4 * i + lr) * Nn + lc); }
#pragma unroll
        for (int i = 0; i < 16; ++i) { const int k = 4 * i + lr; *(LAS f32x4*)(scr + k * 64 + (lc ^ (((k >> 3) & 7) << 2))) = cur[i]; }
        const int c = F.lane & 7;
#pragma unroll
        for (int j = 0; j < 8; ++j) { const int n = (F.lane >> 3) + 8 * j; const LAS float* sp = scr + (8 * c) * 64 + (n ^ (c << 2));
            u32x4 o; o.x = pk2(sp[0], sp[64]); o.y = pk2(sp[128], sp[192]); o.z = pk2(sp[256], sp[320]); o.w = pk2(sp[384], sp[448]);
            *(u32x4*)(dst + (size_t)n * 1024 + 8 * c) = o; }
        if (itn < TI_TOTAL) {
#pragma unroll
            for (int i = 0; i < 16; ++i) cur[i] = nxt[i];
            dst = dstn; }
        it = itn;
    }
}
__device__ __forceinline__ void strip_src(const Params& P, Frame& F, int s, const float*& src, signed char*& dst, float*& sc) {
    const int mat = s >> 5, nb = s & 31;
    src = P.in[I_W_GU] + (size_t)mat * 1024 * 2048 + nb * 64; dst = WSP(signed char, WS_WT_GU) + ((size_t)mat * 2048 + nb * 64) * 1024; sc = WSP(float, WS_SGU) + mat * 2048 + nb * 64;
}
__device__ __forceinline__ void pre_strips(const Params& P, Frame& F) {
    constexpr int NSTRIP = 64 * 32, N = 2048;
    LAS unsigned char* tile = F.lds; LAS float* wmax = (LAS float*)(F.lds + 133120); LAS float* scl = (LAS float*)(F.lds + 135168);
    const int w = F.wave, l = F.lane, lr = l >> 4, nq = (l & 15) * 4;
    f32x4 regs[32]; const float* src; signed char* dst; float* sc;
    int s = F.vcu;
    if (s < NSTRIP) { strip_src(P, F, s, src, dst, sc);
#pragma unroll
        for (int i = 0; i < 32; ++i) regs[i] = *(const f32x4*)(src + (size_t)(i * 32 + w * 4 + lr) * N + nq); }
    while (s < NSTRIP) {
        f32x4 pm = {0.f, 0.f, 0.f, 0.f};
#pragma unroll
        for (int i = 0; i < 32; ++i) { const int kr = i * 32 + w * 4 + lr; const f32x4 v = regs[i];
            pm.x = fmaxf(pm.x, fabsf(v.x)); pm.y = fmaxf(pm.y, fabsf(v.y)); pm.z = fmaxf(pm.z, fabsf(v.z)); pm.w = fmaxf(pm.w, fabsf(v.w));
            u32x2 pw; pw.x = pk2(v.x, v.y); pw.y = pk2(v.z, v.w);
            *(LAS u32x2*)(tile + kr * 128 + ((nq ^ (((kr >> 4) & 7) * 8)) * 2)) = pw; }
#pragma unroll
        for (int j = 0; j < 4; ++j) { float t = pm[j]; t = fmaxf(t, __shfl_xor(t, 16)); t = fmaxf(t, __shfl_xor(t, 32)); pm[j] = t; }
        if (l < 16) *(LAS f32x4*)(wmax + w * 64 + nq) = pm;
        __syncthreads();
        if (F.tid < 64) { float m = 0.f;
#pragma unroll
            for (int ww = 0; ww < 8; ++ww) m = fmaxf(m, wmax[ww * 64 + F.tid]);
            const float scv = m > 0.f ? m * (1.0f / 127.0f) : 1.0f; scl[F.tid] = scv; sc[F.tid] = scv; }
        signed char* dcur = dst;
        const int sn = s + 256;
        if (sn < NSTRIP) { strip_src(P, F, sn, src, dst, sc);
#pragma unroll
            for (int i = 0; i < 32; ++i) regs[i] = *(const f32x4*)(src + (size_t)(i * 32 + w * 4 + lr) * N + nq); }
        __syncthreads();
        { const int n = (l >> 3) + 8 * w, c = l & 7; const float inv = 1.0f / scl[n]; const int nsw = (n ^ (c * 8)) * 2;
#pragma unroll 1
            for (int kb = 0; kb < 8; ++kb) { const int k0 = kb * 128 + c * 16; u32x4 o;
#pragma unroll
                for (int d = 0; d < 4; ++d) { unsigned wd = 0;
#pragma unroll
                    for (int b = 0; b < 4; ++b) { const float v = bf2f(*(const LAS bf16*)(tile + (k0 + 4 * d + b) * 128 + nsw)); int q = (int)rintf(v * inv); q = q > 127 ? 127 : (q < -127 ? -127 : q); wd |= (unsigned)(q & 255) << (8 * b); }
                    o[d] = wd; }
                *(u32x4*)(dcur + (size_t)n * 1024 + k0) = o; } }
        __syncthreads();
        s = sn;
    }
}
__device__ __forceinline__ void phase_pre(const Params& P, Frame& F) {
    if (F.bid < 192) pre_modulation(P, F);
    pre_tables(P, F);
    pre_strips(P, F);
    pre_transposes(P, F);
}

__device__ __forceinline__ void norm_mod_store(const f32x4 (&v)[4], const float* gain, const float* sc, const float* sh, bf16* orow, int lane) {
    float ss = 0.f;
#pragma unroll
    for (int j = 0; j < 4; ++j) ss += (v[j].x * v[j].x + v[j].y * v[j].y) + (v[j].z * v[j].z + v[j].w * v[j].w);
    const float rstd = rsqrtf(wave_sum(ss) * (1.0f / 1024.0f) + NORM_EPS);
#pragma unroll
    for (int j = 0; j < 4; ++j) { const int c = 4 * lane + 256 * j; const f32x4 g = *(const f32x4*)(gain + c), s1 = *(const f32x4*)(sc + c), s0 = *(const f32x4*)(sh + c);
        const f32x4 a = v[j] * rstd * g * (s1 + 1.0f) + s0; u32x2 w; w.x = pk2(a.x, a.y); w.y = pk2(a.z, a.w); *(u32x2*)(orow + c) = w; }
}
__device__ __forceinline__ void phase_norm0(const Params& P, Frame& F) {
    const int gw = F.vcu * NWAVES + F.wave, NGW = 256 * NWAVES; const float* mod = WSP(float, WS_MOD);
    for (int r = gw; r < NTOK; r += NGW) {
        const float* src = r < NLAT ? P.in[I_X] + (size_t)r * 1024 : P.in[I_CTX] + (size_t)(r - NLAT) * 1024; f32x4 v[4];
#pragma unroll
        for (int j = 0; j < 4; ++j) v[j] = *(const f32x4*)(src + 4 * F.lane + 256 * j);
        const float* m = mod + (size_t)mod_row(r) * 6144;
        norm_mod_store(v, P.in[I_NORM_MIX], m + 1024, m, WSP(bf16, WS_ABF) + (size_t)r * 1024, F.lane);
    }
}
__device__ __forceinline__ void load_moe_sum(const float* h1row, const bf16* ysrow  , const float* g2, f32x4 (&v)[4], int lane) {
#pragma unroll
    for (int j = 0; j < 4; ++j) { const int c = 4 * lane + 256 * j; f32x4 s = {0.f, 0.f, 0.f, 0.f};
#pragma unroll
        for (int sl = 0; sl < 4; ++sl) { const u32x2 w = *(const u32x2*)(ysrow + sl * 1024 + c); s.x += bflo(w.x); s.y += bfhi(w.x); s.z += bflo(w.y); s.w += bfhi(w.y); }
        v[j] = *(const f32x4*)(h1row + c) + *(const f32x4*)(g2 + c) * s; }
}
__device__ __forceinline__ void phase_norm1(const Params& P, Frame& F) {
    const int gw = F.vcu * NWAVES + F.wave, NGW = 256 * NWAVES; const float* mod = WSP(float, WS_MOD);
    for (int r = gw; r < NTOK; r += NGW) {
        f32x4 v[4]; const int mr = mod_row(r);
        load_moe_sum(WSP(float, WS_H1) + (size_t)r * 1024, WSP(bf16, WS_YS) + (size_t)r * 4096, mod + (size_t)mr * 6144 + 5 * 1024, v, F.lane);
        float* h2 = WSP(float, WS_H2) + (size_t)r * 1024;
#pragma unroll
        for (int j = 0; j < 4; ++j) *(f32x4*)(h2 + 4 * F.lane + 256 * j) = v[j];
        const float* m = mod + (size_t)(9 + mr) * 6144;
        norm_mod_store(v, P.in[I_NORM_MIX] + 1024, m + 1024, m, WSP(bf16, WS_ABF) + (size_t)r * 1024, F.lane);
    }
}
__device__ __forceinline__ void phase_final(const Params& P, Frame& F) {
    const int gw = F.vcu * NWAVES + F.wave, NGW = 256 * NWAVES; const float* mod = WSP(float, WS_MOD);
    for (int r = gw; r < NLAT; r += NGW) {
        f32x4 v[4]; const int mr = mod_row(r);
        load_moe_sum(WSP(float, WS_H3) + (size_t)r * 1024, WSP(bf16, WS_YS) + (size_t)r * 4096, mod + (size_t)(9 + mr) * 6144 + 5 * 1024, v, F.lane);
        float* o = P.out + (size_t)r * 1024;
#pragma unroll
        for (int j = 0; j < 4; ++j) *(f32x4*)(o + 4 * F.lane + 256 * j) = v[j];
    }
}
namespace pg8 {
constexpr int BM = 256, BK = 64, HALF = 128, HTB = HALF * BK * 2, STAGE_BYTES = 8 * HTB, KD = 1024;
__device__ __forceinline__ int lds_byte(int r, int c) { const int st = (r >> 4) * 2 + (c >> 5), rr = r & 15, cc = c & 31, ob = rr * 64 + cc * 2; return st * 1024 + (ob ^ (((ob >> 9) & 1) << 5)); }
__device__ __forceinline__ void stage_rc(int b, int& R, int& C) { const int st = b / 1024, sb = b % 1024, swz = sb ^ (((sb >> 9) & 1) << 5); R = (st >> 1) * 16 + swz / 64; C = (st & 1) * 32 + (swz % 64) / 2; }
__device__ __forceinline__ int perm32(int rho) { const int n = rho >> 4, i = rho & 15; return 8 * (i >> 2) + 4 * n + (i & 3); }

struct Unit { const char *A0, *A1, *B0, *B1; int r0, c0, aux; };

typedef int i32x4 __attribute__((ext_vector_type(4)));
template <bool I8> struct AccT { typedef f32x4 T; };
template <> struct AccT<true> { typedef i32x4 T; };
template <bool I8> __device__ __forceinline__ typename AccT<I8>::T mma1(bf16x8 b, bf16x8 a, typename AccT<I8>::T c);
template <> __device__ __forceinline__ f32x4 mma1<false>(bf16x8 b, bf16x8 a, f32x4 c) { return __builtin_amdgcn_mfma_f32_16x16x32_bf16(b, a, c, 0, 0, 0); }
template <> __device__ __forceinline__ i32x4 mma1<true>(bf16x8 b, bf16x8 a, i32x4 c) { return __builtin_amdgcn_mfma_i32_16x16x64_i8(__builtin_bit_cast(i32x4, b), __builtin_bit_cast(i32x4, a), c, 0, 0, 0); }
template <class Epi, class Sched>
__device__ __forceinline__ void gemm_phase(LAS unsigned char* lds, const Sched& S, const Epi& E) {
    const int tid = threadIdx.x, wid = __builtin_amdgcn_readfirstlane(tid >> 6), lane = tid & 63, wr = wid >> 2, wc = wid & 3, fr = lane & 15, fq = lane >> 4;
    constexpr bool I8 = Epi::I8; typedef typename AccT<I8>::T acc_t;
    constexpr int K = I8 ? KD / 2 : KD  , nt = I8 ? KD / 128 : KD / BK;
    unsigned voffA[2], voffB[2];
#pragma unroll
    for (int i = 0; i < 2; ++i) { int R, C; stage_rc(tid * 16 + i * 8192, R, C); const int Rb = Epi::PERM ? ((R & ~31) + perm32(R & 31)) : R;
        voffA[i] = (unsigned)(R * K + C) * 2u; voffB[i] = (unsigned)(Rb * K + C) * 2u; }
    constexpr size_t kstep = (size_t)(BK * 2);
    const unsigned ldsw = (unsigned)wid * 1024u;
    const int aoff = lds_byte(wr * 64 + fr, fq * 8), boff = lds_byte(wc * 32 + fr, fq * 8);
#define PG8_SA(b, h) (((b) * 2 + (h)) * HTB)
#define PG8_SB(b, h) ((4 + (b) * 2 + (h)) * HTB)
#define PG8_STAGE(bufoff, gbase, voff) do { _Pragma("unroll") for (int _i = 0; _i < 2; ++_i) \
        __builtin_amdgcn_global_load_lds((const unsigned*)((const char*)(gbase) + (voff)[_i]), (LAS unsigned*)(lds + (bufoff) + ldsw + _i * 8192), 16, 0, 0); } while (0)
#define PG8_LDA(dst, b, h) do { _Pragma("unroll") for (int m = 0; m < 4; ++m) _Pragma("unroll") for (int k = 0; k < 2; ++k) dst[m][k] = *(const LAS bf16x8*)(lds + PG8_SA(b, h) + aoff + m * 2048 + k * 1024); } while (0)
#define PG8_LDB(dst, b, h) do { _Pragma("unroll") for (int n = 0; n < 2; ++n) _Pragma("unroll") for (int k = 0; k < 2; ++k) dst[n][k] = *(const LAS bf16x8*)(lds + PG8_SB(b, h) + boff + n * 2048 + k * 1024); } while (0)
#define PG8_MMA(ai, bj, At, Bt) do { __builtin_amdgcn_s_setprio(1); _Pragma("unroll") for (int m = 0; m < 4; ++m) _Pragma("unroll") for (int n = 0; n < 2; ++n) _Pragma("unroll") for (int k = 0; k < 2; ++k) \
        acc[ai][bj][m][n] = mma1<I8>(Bt[n][k], At[m][k], acc[ai][bj][m][n]); __builtin_amdgcn_s_setprio(0); } while (0)
#define PG8_WAIT_V(n) asm volatile("s_waitcnt vmcnt(" #n ")" ::: "memory")
#define PG8_WAIT_L(n) asm volatile("s_waitcnt lgkmcnt(" #n ")" ::: "memory")
#define PG8_BAR __builtin_amdgcn_s_barrier()
#define PG8_SCHED __builtin_amdgcn_sched_barrier(0)
    Unit cur, nxt; int ui = 0;
    if (!S.next(0, cur)) return;
    acc_t acc[2][2][4][2];
#pragma unroll
    for (int a = 0; a < 2; ++a)
#pragma unroll
        for (int b = 0; b < 2; ++b)
#pragma unroll
            for (int m = 0; m < 4; ++m)
#pragma unroll
                for (int n = 0; n < 2; ++n) acc[a][b][m][n] = (acc_t){0, 0, 0, 0};
    bf16x8 At[4][2], B0[2][2], B1[2][2];
    PG8_STAGE(PG8_SB(0, 0), cur.B0, voffB); PG8_STAGE(PG8_SB(0, 1), cur.B1, voffB); PG8_STAGE(PG8_SA(0, 0), cur.A0, voffA); PG8_STAGE(PG8_SA(0, 1), cur.A1, voffA);
    if (wr == 1) PG8_BAR;
    PG8_WAIT_V(2); PG8_BAR;
    PG8_STAGE(PG8_SB(1, 0), cur.B0 + kstep, voffB); PG8_STAGE(PG8_SA(1, 0), cur.A0 + kstep, voffA); PG8_STAGE(PG8_SB(1, 1), cur.B1 + kstep, voffB);
    PG8_WAIT_V(6); PG8_BAR;
    for (;;) {
        const bool has_next = S.next(ui + 1, nxt);
        const char* nA0 = has_next ? nxt.A0 : cur.A0; const char* nA1 = has_next ? nxt.A1 : cur.A1;
        const char* nB0 = has_next ? nxt.B0 : cur.B0; const char* nB1 = has_next ? nxt.B1 : cur.B1;
        for (int t = 0; t < nt; t += 2) {
            const bool last = (t == nt - 2);
            const char* a1_1 = cur.A1 + (size_t)(t + 1) * kstep;
            const char* a2_0 = last ? nA0 : cur.A0 + (size_t)(t + 2) * kstep; const char* a2_1 = last ? nA1 : cur.A1 + (size_t)(t + 2) * kstep;
            const char* b2_0 = last ? nB0 : cur.B0 + (size_t)(t + 2) * kstep; const char* b2_1 = last ? nB1 : cur.B1 + (size_t)(t + 2) * kstep;
            const char* a3_0 = a2_0 + kstep; const char* b3_0 = b2_0 + kstep; const char* b3_1 = b2_1 + kstep;
            PG8_LDB(B0, 0, 0); PG8_LDB(B1, 0, 1); PG8_SCHED; PG8_LDA(At, 0, 0); PG8_STAGE(PG8_SA(1, 1), a1_1, voffA);
            PG8_WAIT_V(8); PG8_WAIT_L(0); PG8_BAR; PG8_MMA(0, 0, At, B0); PG8_MMA(0, 1, At, B1); PG8_BAR; PG8_SCHED;
            PG8_LDA(At, 0, 1); PG8_STAGE(PG8_SB(0, 0), b2_0, voffB); PG8_STAGE(PG8_SB(0, 1), b2_1, voffB); PG8_STAGE(PG8_SA(0, 0), a2_0, voffA);
            PG8_WAIT_V(8); PG8_WAIT_L(0); PG8_BAR; PG8_MMA(1, 0, At, B0); PG8_MMA(1, 1, At, B1); PG8_BAR; PG8_SCHED;
            PG8_LDB(B0, 1, 0); PG8_LDB(B1, 1, 1); PG8_SCHED; PG8_LDA(At, 1, 0); PG8_STAGE(PG8_SA(0, 1), a2_1, voffA);
            PG8_WAIT_V(8); PG8_WAIT_L(0); PG8_BAR; PG8_MMA(0, 0, At, B0); PG8_MMA(0, 1, At, B1); PG8_BAR; PG8_SCHED;
            PG8_LDA(At, 1, 1); PG8_STAGE(PG8_SB(1, 0), b3_0, voffB); PG8_STAGE(PG8_SB(1, 1), b3_1, voffB); PG8_STAGE(PG8_SA(1, 0), a3_0, voffA);
            PG8_WAIT_V(8); PG8_WAIT_L(0); PG8_BAR; PG8_MMA(1, 0, At, B0); PG8_MMA(1, 1, At, B1); PG8_BAR; PG8_SCHED;
        }
        if (wr == 0) PG8_BAR;
        E(acc, cur, wr, wc, fr, fq);
        if (!has_next) break;
#pragma unroll
        for (int a = 0; a < 2; ++a)
#pragma unroll
            for (int b = 0; b < 2; ++b)
#pragma unroll
                for (int m = 0; m < 4; ++m)
#pragma unroll
                    for (int n = 0; n < 2; ++n) acc[a][b][m][n] = (acc_t){0, 0, 0, 0};
        cur = nxt; ++ui;
        if (wr == 1) PG8_BAR;
    }
    PG8_WAIT_V(0);
    PG8_BAR;
#undef PG8_SA
#undef PG8_SB
#undef PG8_STAGE
#undef PG8_LDA
#undef PG8_LDB
#undef PG8_MMA
#undef PG8_WAIT_V
#undef PG8_WAIT_L
#undef PG8_BAR
#undef PG8_SCHED
}

struct DenseOrder {
    const char* A; const char* Bt; int nM, nN, nwg, c;
    __device__ __forceinline__ void init(const void* A_, const void* Bt_, int M, int N, int c_) { A = (const char*)A_; Bt = (const char*)Bt_; nM = M / BM; nN = N / BM; nwg = nM * nN; c = c_; }
    __device__ __forceinline__ bool next(int i, Unit& u) const {
        const int L = i * 256 + c; if (L >= nwg) return false;
        int wgid = L; { const int q = nwg / 8, r = nwg % 8, xcd = wgid % 8, off = wgid / 8; wgid = (xcd < r ? xcd * (q + 1) : r * (q + 1) + (xcd - r) * q) + off; }
        const int nig = 8 * nN, gid = wgid / nig, fm = gid * 8, gsz = (nM - fm) < 8 ? (nM - fm) : 8;
        const int pm = fm + ((wgid % nig) % gsz), pn = (wgid % nig) / gsz;
        u.A0 = A + (size_t)pm * (BM * 2048); u.A1 = u.A0 + (size_t)HALF * 2048; u.B0 = Bt + (size_t)pn * (BM * 2048); u.B1 = u.B0 + (size_t)HALF * 2048;
        u.r0 = pm * BM; u.c0 = pn * BM; u.aux = pn; return true;
    }
};
template <int NPN, bool GU, int RP  >
struct MoeOrder {
    const char* A; const char* W; const int* blke; int nrb, vcu;
    __device__ __forceinline__ bool next(int i, Unit& u) const {
        const int L = i * 256 + vcu; const int rb = L / NPN, pn = L % NPN; if (rb >= nrb) return false;
        const int e = __builtin_amdgcn_readfirstlane(__hip_atomic_load(blke + rb, RLX_AGENT));
        u.A0 = A + (size_t)rb * (BM * RP); u.A1 = u.A0 + (size_t)HALF * RP;
        if (GU) { u.B0 = W + (size_t)e * (2048 * RP) + (size_t)pn * (HALF * RP); u.B1 = u.B0 + (size_t)1024 * RP; u.c0 = pn * HALF; }
        else    { u.B0 = W + (size_t)e * (1024 * RP) + (size_t)pn * (BM * RP); u.B1 = u.B0 + (size_t)HALF * RP; u.c0 = pn * BM; }
        u.r0 = rb * BM; u.aux = e; return true;
    }
};

#define EPI_ROWS_BEGIN _Pragma("unroll") for (int ai = 0; ai < 2; ++ai) _Pragma("unroll") for (int m = 0; m < 4; ++m) { const int row = u.r0 + ai * HALF + wr * 64 + m * 16 + fr;
#define EPI_ROWS_END }
struct EpiBf16 {
    static constexpr bool PERM = true, I8 = false;
    bf16* O; int ldc;
    __device__ __forceinline__ void operator()(const f32x4 (&acc)[2][2][4][2], const Unit& u, int wr, int wc, int fr, int fq) const {
        const int col0 = u.c0 + wc * 32 + 8 * fq;
        EPI_ROWS_BEGIN bf16* rowp = O + (size_t)row * ldc + col0;
#pragma unroll
            for (int bj = 0; bj < 2; ++bj) { const f32x4 v0 = acc[ai][bj][m][0], v1 = acc[ai][bj][m][1]; u32x4 w; w.x = pk2(v0[0], v0[1]); w.y = pk2(v0[2], v0[3]); w.z = pk2(v1[0], v1[1]); w.w = pk2(v1[2], v1[3]);
                *(u32x4*)(rowp + bj * HALF) = w; }
        EPI_ROWS_END
    }
};
struct EpiRecIn {
    static constexpr bool PERM = true, I8 = false;
    bf16* O; float* FFo; const float* lb; const float* rope;
    __device__ __forceinline__ void operator()(const f32x4 (&acc)[2][2][4][2], const Unit& u, int wr, int wc, int fr, int fq) const {
        const int pn = u.aux; const int col0 = u.c0 + wc * 32 + 8 * fq;
        if (pn >= 2 && pn < 6) {
            f32x4 lbv[2][2];
#pragma unroll
            for (int bj = 0; bj < 2; ++bj)
#pragma unroll
                for (int n = 0; n < 2; ++n) lbv[bj][n] = *(const f32x4*)(lb + col0 - 512 + bj * HALF + 4 * n);
            EPI_ROWS_BEGIN float* rowp = FFo + (size_t)row * 1024 + (col0 - 512);
#pragma unroll
                for (int bj = 0; bj < 2; ++bj)
#pragma unroll
                    for (int n = 0; n < 2; ++n) { const f32x4 z = acc[ai][bj][m][n]; f32x4 o;
#pragma unroll
                        for (int j = 0; j < 4; ++j) o[j] = lbv[bj][n][j] + (1.0f - lbv[bj][n][j]) * fsigmoid(z[j]);
                        *(f32x4*)(rowp + bj * HALF + 4 * n) = o; }
            EPI_ROWS_END
            return;
        }
        const int mode = (pn < 2) ? 1 : (pn == 8 || pn == 9 || pn >= 14) ? 2 : (pn == 10) ? 3 : (pn == 11) ? 4 : 0;
        EPI_ROWS_BEGIN bf16* rowp = O + (size_t)row * REC_IN + col0;
#pragma unroll
            for (int bj = 0; bj < 2; ++bj) { f32x4 v[2] = {acc[ai][bj][m][0], acc[ai][bj][m][1]};
                if (mode == 1) {
#pragma unroll
                    for (int n = 0; n < 2; ++n)
#pragma unroll
                        for (int j = 0; j < 4; ++j) v[n][j] = fsilu(v[n][j]) * 0.08838834764831845f;
                } else if (mode == 2) {
#pragma unroll
                    for (int n = 0; n < 2; ++n)
#pragma unroll
                        for (int j = 0; j < 4; ++j) v[n][j] = fsilu(v[n][j]);
                } else if (mode >= 3) {
                    const float sc = (mode == 4) ? 0.125f : 1.0f;
                    if (row < NLAT) { const int t = row & 2047; const int p0 = ((col0 + bj * HALF) & 63) >> 1;
                        const f32x4 cs0 = *(const f32x4*)(rope + ((size_t)t * 32 + p0) * 2), cs1 = *(const f32x4*)(rope + ((size_t)t * 32 + p0 + 2) * 2);
                        f32x4 a = v[0], b = v[1];
                        v[0][0] = (a[0] * cs0[0] - a[1] * cs0[1]) * sc; v[0][1] = (a[0] * cs0[1] + a[1] * cs0[0]) * sc;
                        v[0][2] = (a[2] * cs0[2] - a[3] * cs0[3]) * sc; v[0][3] = (a[2] * cs0[3] + a[3] * cs0[2]) * sc;
                        v[1][0] = (b[0] * cs1[0] - b[1] * cs1[1]) * sc; v[1][1] = (b[0] * cs1[1] + b[1] * cs1[0]) * sc;
                        v[1][2] = (b[2] * cs1[2] - b[3] * cs1[3]) * sc; v[1][3] = (b[2] * cs1[3] + b[3] * cs1[2]) * sc;
                    } else { v[0] = v[0] * sc; v[1] = v[1] * sc; }
                }
                u32x4 w; w.x = pk2(v[0][0], v[0][1]); w.y = pk2(v[0][2], v[0][3]); w.z = pk2(v[1][0], v[1][1]); w.w = pk2(v[1][2], v[1][3]);
                *(u32x4*)(rowp + bj * HALF) = w; }
        EPI_ROWS_END
    }
};
struct EpiResidual {
    static constexpr bool PERM = false, I8 = false;
    const float* baseLat; const float* baseCtx; float* out; const float* gate;
    __device__ __forceinline__ void operator()(const f32x4 (&acc)[2][2][4][2], const Unit& u, int wr, int wc, int fr, int fq) const {
        const int col0 = u.c0 + wc * 32 + 4 * fq; const float* g = gate + (size_t)mod_row(u.r0) * 6144 + col0;
        f32x4 gv[2][2];
#pragma unroll
        for (int bj = 0; bj < 2; ++bj)
#pragma unroll
            for (int n = 0; n < 2; ++n) gv[bj][n] = *(const f32x4*)(g + bj * HALF + n * 16);
        EPI_ROWS_BEGIN const float* bp = (row < NLAT ? baseLat + (size_t)row * 1024 : baseCtx + (size_t)(row - NLAT) * 1024) + col0; float* op = out + (size_t)row * 1024 + col0;
#pragma unroll
            for (int bj = 0; bj < 2; ++bj)
#pragma unroll
                for (int n = 0; n < 2; ++n) *(f32x4*)(op + bj * HALF + n * 16) = *(const f32x4*)(bp + bj * HALF + n * 16) + gv[bj][n] * acc[ai][bj][m][n];
        EPI_ROWS_END
    }
};
struct EpiSwiglu {
    static constexpr bool PERM = true, I8 = false;
    bf16* O; const float* bgu;
    __device__ __forceinline__ void operator()(const f32x4 (&acc)[2][2][4][2], const Unit& u, int wr, int wc, int fr, int fq) const {
        const int col0 = u.c0 + wc * 32 + 8 * fq; const float* bb = bgu + (size_t)u.aux * 2048 + col0;
        f32x4 bg[2], bu[2];
#pragma unroll
        for (int n = 0; n < 2; ++n) { bg[n] = *(const f32x4*)(bb + 4 * n); bu[n] = *(const f32x4*)(bb + 1024 + 4 * n); }
        EPI_ROWS_BEGIN f32x4 h[2];
#pragma unroll
            for (int n = 0; n < 2; ++n)
#pragma unroll
                for (int j = 0; j < 4; ++j) { const float g = fminf(acc[ai][0][m][n][j] + bg[n][j], 7.0f); const float up = fminf(fmaxf(acc[ai][1][m][n][j] + bu[n][j], -7.0f), 7.0f);
                    h[n][j] = (up + 1.0f) * g * fsigmoid(1.702f * g); }
            u32x4 w; w.x = pk2(h[0][0], h[0][1]); w.y = pk2(h[0][2], h[0][3]); w.z = pk2(h[1][0], h[1][1]); w.w = pk2(h[1][2], h[1][3]);
            *(u32x4*)(O + (size_t)row * 1024 + col0) = w;
        EPI_ROWS_END
    }
};
struct EpiSwigluI8 {
    static constexpr bool PERM = true, I8 = true;
    bf16* O; const float* bgu; const float* sa; const float* sb;
    __device__ __forceinline__ void operator()(const i32x4 (&acc)[2][2][4][2], const Unit& u, int wr, int wc, int fr, int fq) const {
        const int col0 = u.c0 + wc * 32 + 8 * fq; const float* bb = bgu + (size_t)u.aux * 2048 + col0; const float* ss = sb + (size_t)u.aux * 2048 + col0;
        f32x4 bg[2], bu[2], sg[2], su[2];
#pragma unroll
        for (int n = 0; n < 2; ++n) { bg[n] = *(const f32x4*)(bb + 4 * n); bu[n] = *(const f32x4*)(bb + 1024 + 4 * n); sg[n] = *(const f32x4*)(ss + 4 * n); su[n] = *(const f32x4*)(ss + 1024 + 4 * n); }
        EPI_ROWS_BEGIN const float sr = sa[row]; f32x4 h[2];
#pragma unroll
            for (int n = 0; n < 2; ++n)
#pragma unroll
                for (int j = 0; j < 4; ++j) { const float g = fminf((float)acc[ai][0][m][n][j] * (sr * sg[n][j]) + bg[n][j], 7.0f); const float up = fminf(fmaxf((float)acc[ai][1][m][n][j] * (sr * su[n][j]) + bu[n][j], -7.0f), 7.0f);
                    h[n][j] = (up + 1.0f) * g * fsigmoid(1.702f * g); }
            u32x4 w; w.x = pk2(h[0][0], h[0][1]); w.y = pk2(h[0][2], h[0][3]); w.z = pk2(h[1][0], h[1][1]); w.w = pk2(h[1][2], h[1][3]);
            *(u32x4*)(O + (size_t)row * 1024 + col0) = w;
        EPI_ROWS_END
    }
};
struct EpiMoeOut {
    static constexpr bool PERM = true, I8 = false;
    bf16* YS; const float* bdn; const int* rtok; const float* rgate;
    __device__ __forceinline__ void operator()(const f32x4 (&acc)[2][2][4][2], const Unit& u, int wr, int wc, int fr, int fq) const {
        const int col0 = u.c0 + wc * 32 + 8 * fq; const float* bb = bdn + (size_t)u.aux * 1024 + col0;
        f32x4 bv[2][2];
#pragma unroll
        for (int bj = 0; bj < 2; ++bj)
#pragma unroll
            for (int n = 0; n < 2; ++n) bv[bj][n] = *(const f32x4*)(bb + bj * HALF + 4 * n);
        EPI_ROWS_BEGIN const int tk = rtok[row]; const float gt = rgate[row];
            if (tk >= 0) { bf16* rowp = YS + (size_t)tk * 1024 + col0;
#pragma unroll
                for (int bj = 0; bj < 2; ++bj) { const f32x4 v0 = (acc[ai][bj][m][0] + bv[bj][0]) * gt, v1 = (acc[ai][bj][m][1] + bv[bj][1]) * gt;
                    u32x4 w; w.x = pk2(v0[0], v0[1]); w.y = pk2(v0[2], v0[3]); w.z = pk2(v1[0], v1[1]); w.w = pk2(v1[2], v1[3]); *(u32x4*)(rowp + bj * HALF) = w; } }
        EPI_ROWS_END
    }
};
}
namespace rec {
template <int DK> struct LL {
    static constexpr int SD = (DK + 8) * 2;
    static constexpr int QIN = 0, KIN = QIN + 64 * SD, ST = KIN + 64 * SD, KSTT = ST + 64 * SD, VT = KSTT + DK * 144, ATT = VT + 64 * 144, TOT = ATT + 64 * 144, DEC = TOT + 8 * 128 * 4, END = DEC + 128 * 4;
};
template <bool RET>
__device__ __forceinline__ void rec_unit(const Params& P, Frame& F, int b, int head, int dir, int vh) {
    constexpr int DK = RET ? 64 : 128, NT_ = RET ? 4 : 8, NVT = RET ? 2 : 4, KS = DK / 32;
    typedef LL<DK> L; constexpr int SD = L::SD;
    LAS unsigned char* lds = F.lds;
    const bf16* PROJ = WSP(bf16, WS_PROJ); const float* FFp = WSP(float, WS_FF); bf16* OR = WSP(bf16, WS_OREC) + (size_t)dir * NTOK * 1024;
    const int qcol = RET ? 2560 + head * 64 : head * 128, kcol = 2816 + head * 64, fcol = dir * 512 + head * 128;
    const int vcol = (RET ? 3072 : 1536) + head * 128 + vh * 64, ocol = (RET ? 512 : 0) + head * 128 + vh * 64;
    const float lg = RET ? __logf(1.0f - exp2f(-5.0f - (float)(dir ? 3 - head : head))) : 0.f;
    const int dp = RET ? (F.tid & 31) : F.lane, tg = RET ? (F.tid >> 5) : F.wave;
    const int vs = F.tid >> 3, vc = (F.tid & 7) * 8;
    const int fr = F.lane & 15, fq = F.lane >> 4;
    const int sdt = RET ? (F.wave >> 1) : F.wave, svt0 = RET ? 2 * (F.wave & 1) : 0;
    f32x4 sacc[NVT];
#pragma unroll
    for (int i = 0; i < NVT; ++i) sacc[i] = (f32x4){0.f, 0.f, 0.f, 0.f};
    for (int idx = F.tid; idx < 64 * SD / 4; idx += NTHR) ((LAS unsigned*)(lds + L::ST))[idx] = 0u;
    if (RET && F.tid < 64) ((LAS float*)(lds + L::DEC))[F.tid] = __expf(64.0f * lg);
    f32x2 fv[NT_]; unsigned qv[NT_], kv[NT_]; u32x4 vv;
#define REC_BASE(n) ((n) < 4 ? NLAT + b * 256 + (dir ? 3 - (n) : (n)) * 64 : b * 2048 + (dir ? 35 - (n) : (n) - 4) * 64)
#define REC_ROW(base, j) ((base) + (dir ? 63 - (j) : (j)))
#define REC_LOAD(n) do { const int _bs = REC_BASE(n); _Pragma("unroll") for (int i = 0; i < NT_; ++i) { const size_t _r = (size_t)REC_ROW(_bs, NT_ * tg + i); \
        qv[i] = *(const unsigned*)(PROJ + _r * REC_IN + qcol + 2 * dp); \
        if (RET) kv[i] = *(const unsigned*)(PROJ + _r * REC_IN + kcol + 2 * dp); else fv[i] = *(const f32x2*)(FFp + _r * 1024 + fcol + 2 * dp); } \
        vv = *(const u32x4*)(PROJ + (size_t)REC_ROW(_bs, vs) * REC_IN + vcol + vc); } while (0)
    REC_LOAD(0);
    for (int n = 0; n < 36; ++n) {
        const int base = REC_BASE(n);
        float kst0[NT_], kst1[NT_];
        if (!RET) {
            f32x2 cs[NT_]; f32x2 run = {0.f, 0.f};
#pragma unroll
            for (int i = 0; i < NT_; ++i) { run.x += __logf(fv[i].x); run.y += __logf(fv[i].y); cs[i] = run; }
            *(LAS f32x2*)(lds + L::TOT + (tg * 128 + 2 * dp) * 4) = run;
            __syncthreads();
            f32x2 pre = {0.f, 0.f}, all = {0.f, 0.f};
#pragma unroll
            for (int g = 0; g < 8; ++g) { const f32x2 t = *(const LAS f32x2*)(lds + L::TOT + (g * 128 + 2 * dp) * 4); all += t; if (g < tg) pre += t; }
#pragma unroll
            for (int i = 0; i < NT_; ++i) { const int j = NT_ * tg + i; const float bx = pre.x + cs[i].x, by = pre.y + cs[i].y;
                const float q0 = bflo(qv[i]), q1 = bfhi(qv[i]), k0 = 1.0f - fv[i].x, k1 = 1.0f - fv[i].y;
                *(LAS unsigned*)(lds + L::QIN + j * SD + 4 * dp) = pk2(q0 * __expf(bx), q1 * __expf(by));
                *(LAS unsigned*)(lds + L::KIN + j * SD + 4 * dp) = pk2(k0 * __expf(fminf(-bx, 80.f)), k1 * __expf(fminf(-by, 80.f)));
                kst0[i] = k0 * __expf(all.x - bx); kst1[i] = k1 * __expf(all.y - by); }
            if (tg == 0) *(LAS f32x2*)(lds + L::DEC + 8 * dp) = (f32x2){__expf(all.x), __expf(all.y)};
            u32x4 w0, w1; w0.x = pk2(kst0[0], kst0[1]); w0.y = pk2(kst0[2], kst0[3]); w0.z = pk2(kst0[4], kst0[5]); w0.w = pk2(kst0[6], kst0[7]);
            w1.x = pk2(kst1[0], kst1[1]); w1.y = pk2(kst1[2], kst1[3]); w1.z = pk2(kst1[4], kst1[5]); w1.w = pk2(kst1[6], kst1[7]);
            *(LAS u32x4*)(lds + L::KSTT + (2 * dp) * 144 + tg * 16) = w0; *(LAS u32x4*)(lds + L::KSTT + (2 * dp + 1) * 144 + tg * 16) = w1;
        } else {
#pragma unroll
            for (int i = 0; i < NT_; ++i) { const int j = NT_ * tg + i; const float eb = __expf((float)(j + 1) * lg), enb = __expf(-(float)(j + 1) * lg), est = __expf((float)(63 - j) * lg);
                const float q0 = bflo(qv[i]), q1 = bfhi(qv[i]), k0 = bflo(kv[i]), k1 = bfhi(kv[i]);
                *(LAS unsigned*)(lds + L::QIN + j * SD + 4 * dp) = pk2(q0 * eb, q1 * eb);
                *(LAS unsigned*)(lds + L::KIN + j * SD + 4 * dp) = pk2(k0 * enb, k1 * enb);
                kst0[i] = k0 * est; kst1[i] = k1 * est; }
            u32x2 w0, w1; w0.x = pk2(kst0[0], kst0[1]); w0.y = pk2(kst0[2], kst0[3]); w1.x = pk2(kst1[0], kst1[1]); w1.y = pk2(kst1[2], kst1[3]);
            *(LAS u32x2*)(lds + L::KSTT + (2 * dp) * 144 + tg * 8) = w0; *(LAS u32x2*)(lds + L::KSTT + (2 * dp + 1) * 144 + tg * 8) = w1;
        }
#pragma unroll
        for (int i = 0; i < 8; ++i) *(LAS bf16*)(lds + L::VT + (vc + i) * 144 + vs * 2) = (bf16)(vv[i >> 1] >> (16 * (i & 1)));
        if (n + 1 < 36) REC_LOAD(n + 1);
        __syncthreads();
        {
            const int ti = F.wave >> 1;
#pragma unroll
            for (int q = 0; q < 2; ++q) { const int si = 2 * (F.wave & 1) + q; f32x4 a4 = {0.f, 0.f, 0.f, 0.f};
                if (si <= ti) {
#pragma unroll
                    for (int kk = 0; kk < KS; ++kk) { const bf16x8 a = *(const LAS bf16x8*)(lds + L::KIN + (si * 16 + fr) * SD + (kk * 32 + fq * 8) * 2);
                        const bf16x8 bb = *(const LAS bf16x8*)(lds + L::QIN + (ti * 16 + fr) * SD + (kk * 32 + fq * 8) * 2);
                        a4 = __builtin_amdgcn_mfma_f32_16x16x32_bf16(a, bb, a4, 0, 0, 0); }
                }
                const int t = ti * 16 + fr, s0 = si * 16 + 4 * fq;
#pragma unroll
                for (int j = 0; j < 4; ++j) if (s0 + j > t) a4[j] = 0.f;
                u32x2 w; w.x = pk2(a4[0], a4[1]); w.y = pk2(a4[2], a4[3]);
                *(LAS u32x2*)(lds + L::ATT + t * 144 + s0 * 2) = w; }
        }
        __syncthreads();
        {
            const int ti = F.wave >> 1; const int t = ti * 16 + fr; bf16* orow = OR + (size_t)REC_ROW(base, t) * 1024 + ocol;
#pragma unroll
            for (int q = 0; q < 2; ++q) { const int vi = 2 * (F.wave & 1) + q; f32x4 a4 = {0.f, 0.f, 0.f, 0.f};
#pragma unroll
                for (int kk = 0; kk < 2; ++kk) { const bf16x8 a = *(const LAS bf16x8*)(lds + L::VT + (vi * 16 + fr) * 144 + (kk * 32 + fq * 8) * 2);
                    const bf16x8 bb = *(const LAS bf16x8*)(lds + L::ATT + t * 144 + (kk * 32 + fq * 8) * 2);
                    a4 = __builtin_amdgcn_mfma_f32_16x16x32_bf16(a, bb, a4, 0, 0, 0); }
#pragma unroll
                for (int kk = 0; kk < KS; ++kk) { const bf16x8 a = *(const LAS bf16x8*)(lds + L::ST + (vi * 16 + fr) * SD + (kk * 32 + fq * 8) * 2);
                    const bf16x8 bb = *(const LAS bf16x8*)(lds + L::QIN + t * SD + (kk * 32 + fq * 8) * 2);
                    a4 = __builtin_amdgcn_mfma_f32_16x16x32_bf16(a, bb, a4, 0, 0, 0); }
                u32x2 w; w.x = pk2(a4[0], a4[1]); w.y = pk2(a4[2], a4[3]);
                *(u32x2*)(orow + vi * 16 + 4 * fq) = w; }
        }
        {
            const f32x4 dec4 = *(const LAS f32x4*)(lds + L::DEC + (sdt * 16 + 4 * fq) * 4);
#pragma unroll
            for (int vt = 0; vt < NVT; ++vt) { f32x4 a4 = sacc[vt] * dec4;
#pragma unroll
                for (int kk = 0; kk < 2; ++kk) { const bf16x8 a = *(const LAS bf16x8*)(lds + L::KSTT + (sdt * 16 + fr) * 144 + (kk * 32 + fq * 8) * 2);
                    const bf16x8 bb = *(const LAS bf16x8*)(lds + L::VT + ((svt0 + vt) * 16 + fr) * 144 + (kk * 32 + fq * 8) * 2);
                    a4 = __builtin_amdgcn_mfma_f32_16x16x32_bf16(a, bb, a4, 0, 0, 0); }
                sacc[vt] = a4; }
        }
        __syncthreads();
#pragma unroll
        for (int vt = 0; vt < NVT; ++vt) { u32x2 w; w.x = pk2(sacc[vt][0], sacc[vt][1]); w.y = pk2(sacc[vt][2], sacc[vt][3]);
            *(LAS u32x2*)(lds + L::ST + ((svt0 + vt) * 16 + fr) * SD + (sdt * 16 + 4 * fq) * 2) = w; }
    }
#undef REC_BASE
#undef REC_ROW
#undef REC_LOAD
    __syncthreads();
}
}
__device__ __forceinline__ void phase_rec(const Params& P, Frame& F) {
    const int u = F.bid; const int vh = u & 1, dir = (u >> 1) & 1, head = (u >> 2) & 3, type = (u >> 4) & 1, b = u >> 5;
    if (type) rec::rec_unit<true>(P, F, b, head, dir, vh); else rec::rec_unit<false>(P, F, b, head, dir, vh);
}
__device__ __forceinline__ void phase_merge(const Params& P, Frame& F) {
    const int gw = F.vcu * NWAVES + F.wave, NGW = 256 * NWAVES; const int c0 = 16 * F.lane; const bool isret = F.lane >= 32;
    const float* gain = (isret ? P.in[I_RET_GAIN] : P.in[I_HG_GAIN]) + (c0 & 127);
    float gn[16];
#pragma unroll
    for (int i = 0; i < 16; ++i) gn[i] = gain[i];
    for (int r = gw; r < NTOK; r += NGW) {
        const bf16* o0 = WSP(bf16, WS_OREC) + (size_t)r * 1024 + c0; const bf16* o1 = o0 + (size_t)NTOK * 1024;
        const bf16* gp = WSP(bf16, WS_PROJ) + (size_t)r * REC_IN + c0 + (isret ? 3072 : 2048);
        u32x4 a[2] = {*(const u32x4*)o0, *(const u32x4*)(o0 + 8)}, bq[2] = {*(const u32x4*)o1, *(const u32x4*)(o1 + 8)}, g[2] = {*(const u32x4*)gp, *(const u32x4*)(gp + 8)};
        float o[16], gt[16]; float s1 = 0.f;
#pragma unroll
        for (int i = 0; i < 8; ++i) { const unsigned wa = a[i >> 2][i & 3], wb = bq[i >> 2][i & 3], wg = g[i >> 2][i & 3];
            o[2 * i] = bflo(wa) + bflo(wb); o[2 * i + 1] = bfhi(wa) + bfhi(wb); gt[2 * i] = bflo(wg); gt[2 * i + 1] = bfhi(wg); s1 += o[2 * i] + o[2 * i + 1]; }
        s1 += __shfl_xor(s1, 1); s1 += __shfl_xor(s1, 2); s1 += __shfl_xor(s1, 4);
        const float mean = isret ? s1 * (1.0f / 128.0f) : 0.f; float s2 = 0.f;
#pragma unroll
        for (int i = 0; i < 16; ++i) { o[i] -= mean; s2 += o[i] * o[i]; }
        s2 += __shfl_xor(s2, 1); s2 += __shfl_xor(s2, 2); s2 += __shfl_xor(s2, 4);
        const float rstd = rsqrtf(s2 * (1.0f / 128.0f) + NORM_EPS);
        u32x4 w[2];
#pragma unroll
        for (int i = 0; i < 8; ++i) w[i >> 2][i & 3] = pk2(o[2 * i] * rstd * gn[2 * i] * gt[2 * i], o[2 * i + 1] * rstd * gn[2 * i + 1] * gt[2 * i + 1]);
        bf16* y = WSP(bf16, WS_ABF) + (size_t)r * 1024 + c0; *(u32x4*)y = w[0]; *(u32x4*)(y + 8) = w[1];
    }
}
template <int NROWS, int LAYER>
__device__ __forceinline__ void phase_route(const Params& P, Frame& F, const float* H) {
    constexpr int RPB = NROWS / 256, RPW = RPB / 8;
    LAS float* tile = (LAS float*)(F.lds + F.wave * 16384);
    LAS int* hist = (LAS int*)(F.lds + 131072);
    if (F.tid < 32) hist[F.tid] = 0;
    __syncthreads();
    const float* mod = WSP(float, WS_MOD); const float* wr = P.in[I_W_ROUTER] + (size_t)LAYER * 1024 * 32; const float* br = P.in[I_B_ROUTER] + LAYER * 32;
    const float* gain = P.in[I_NORM_FFN] + LAYER * 1024;
    int* tope = WSP(int, WS_TOPE); float* topg = WSP(float, WS_TOPG); int* rank = WSP(int, WS_RANK);
    const int e = F.lane & 31, kh = F.lane >> 5;
    const float bias = br[e];
    const int row_w0 = F.bid * RPB + F.wave * RPW;
    for (int g0 = 0; g0 < RPW; g0 += 4) {
        const int nr = (RPW - g0) < 4 ? (RPW - g0) : 4;
        for (int rr = 0; rr < nr; ++rr) {
            const int r = row_w0 + g0 + rr; const float* src = H + (size_t)r * 1024; f32x4 v[4];
#pragma unroll
            for (int j = 0; j < 4; ++j) v[j] = *(const f32x4*)(src + 4 * F.lane + 256 * j);
            float ss = 0.f;
#pragma unroll
            for (int j = 0; j < 4; ++j) ss += (v[j].x * v[j].x + v[j].y * v[j].y) + (v[j].z * v[j].z + v[j].w * v[j].w);
            const float rstd = rsqrtf(wave_sum(ss) * (1.0f / 1024.0f) + NORM_EPS);
            const float* m = mod + (size_t)(LAYER * 9 + mod_row(r)) * 6144;
            signed char* orow = WSP(signed char, WS_F8) + (size_t)r * 1024; float amax = 0.f;
#pragma unroll
            for (int j = 0; j < 4; ++j) { const int c = 4 * F.lane + 256 * j; const f32x4 gg = *(const f32x4*)(gain + c), s1 = *(const f32x4*)(m + 4096 + c), s0 = *(const f32x4*)(m + 3072 + c);
                const f32x4 a = v[j] * rstd * gg * (s1 + 1.0f) + s0; *(LAS f32x4*)(tile + rr * 1024 + c) = a; v[j] = a;
                amax = fmaxf(amax, fmaxf(fmaxf(fabsf(a.x), fabsf(a.y)), fmaxf(fabsf(a.z), fabsf(a.w)))); }
#pragma unroll
            for (int o = 1; o < 64; o <<= 1) amax = fmaxf(amax, __shfl_xor(amax, o));
            const float qs = amax > 0.f ? amax * (1.0f / 127.0f) : 1.0f, qi = 1.0f / qs;
            if (F.lane == 0) WSP(float, WS_FSC)[r] = qs;
#pragma unroll
            for (int j = 0; j < 4; ++j) { const int c = 4 * F.lane + 256 * j; unsigned wd = 0;
#pragma unroll
                for (int b = 0; b < 4; ++b) { int q = (int)rintf(v[j][b] * qi); q = q > 127 ? 127 : (q < -127 ? -127 : q); wd |= (unsigned)(q & 255) << (8 * b); }
                *(unsigned*)(orow + c) = wd; }
        }
        float acc[4] = {0.f, 0.f, 0.f, 0.f};
        const float* wp = wr + (size_t)(kh * 512) * 32 + e; const LAS float* tp = tile + kh * 512;
#pragma unroll 4
        for (int s = 0; s < 512; s += 4) {
            const float w0 = wp[(s + 0) * 32], w1 = wp[(s + 1) * 32], w2 = wp[(s + 2) * 32], w3 = wp[(s + 3) * 32];
#pragma unroll
            for (int rr = 0; rr < 4; ++rr) { const f32x4 fvv = *(const LAS f32x4*)(tp + rr * 1024 + s); acc[rr] += fvv.x * w0 + fvv.y * w1 + fvv.z * w2 + fvv.w * w3; }
        }
#pragma unroll
        for (int rr = 0; rr < 4; ++rr) { acc[rr] += __shfl_xor(acc[rr], 32); acc[rr] += bias; }
        for (int rr = 0; rr < nr; ++rr) {
            const int r = row_w0 + g0 + rr; float val = acc[rr]; float tv[4]; int ti[4];
#pragma unroll
            for (int k = 0; k < 4; ++k) { float mx = val;
#pragma unroll
                for (int o = 1; o < 32; o <<= 1) mx = fmaxf(mx, __shfl_xor(mx, o));
                const unsigned long long bal = __ballot(val == mx); const int idx = __ffsll((long long)bal) - 1;
                tv[k] = mx; ti[k] = idx & 31; if (e == (idx & 31)) val = -3.0e38f; }
            const float e1 = __expf(tv[1] - tv[0]), e2 = __expf(tv[2] - tv[0]), e3 = __expf(tv[3] - tv[0]); const float inv = 1.0f / (1.0f + e1 + e2 + e3);
            if (F.lane < 4) { const int k = F.lane; const int ex = k == 0 ? ti[0] : k == 1 ? ti[1] : k == 2 ? ti[2] : ti[3]; const float gv = (k == 0 ? 1.0f : k == 1 ? e1 : k == 2 ? e2 : e3) * inv;
                const int rk = atomicAdd((int*)(hist + ex), 1);
                tope[r * 4 + k] = ex; topg[r * 4 + k] = gv; rank[r * 4 + k] = rk; }
        }
    }
    __syncthreads();
    if (F.tid < 32) WSP(int, WS_BCNT)[F.bid * 32 + F.tid] = hist[F.tid];
    __syncthreads();
}
template <int NROWS>
__device__ __forceinline__ void phase_scatter(const Params& P, Frame& F) {
    constexpr int RPB = NROWS / 256;
    LAS int* part_tot = (LAS int*)F.lds;
    LAS int* part_pre = part_tot + 512;
    LAS int* baseL = part_pre + 512;
    LAS int* padS = baseL + 32;
    LAS int* totL = padS + 40;
    const int* bcnt = WSP(int, WS_BCNT);
    { const int e = F.tid & 31, part = F.tid >> 5; int t = 0, pr = 0;
        for (int bb = part * 16; bb < part * 16 + 16; ++bb) { const int c = bcnt[bb * 32 + e]; t += c; if (bb < F.bid) pr += c; }
        part_tot[part * 32 + e] = t; part_pre[part * 32 + e] = pr; }
    __syncthreads();
    if (F.tid < 32) { int t = 0, pr = 0;
        for (int p = 0; p < 16; ++p) { t += part_tot[p * 32 + F.tid]; pr += part_pre[p * 32 + F.tid]; }
        totL[F.tid] = t; baseL[F.tid] = pr; }
    __syncthreads();
    if (F.tid == 0) { int run = 0; for (int e = 0; e < 32; ++e) { padS[e] = run; run += (totL[e] + 255) & ~255; } padS[32] = run; }
    __syncthreads();
    if (F.tid < 32) baseL[F.tid] += padS[F.tid];
    __syncthreads();
    const int* tope = WSP(int, WS_TOPE); const float* topg = WSP(float, WS_TOPG); const int* rank = WSP(int, WS_RANK);
    int* rtok = WSP(int, WS_RTOK); float* rgate = WSP(float, WS_RGATE);
    for (int a = F.wave; a < RPB * 4; a += NWAVES) {
        const int r = F.bid * RPB + (a >> 2), k = a & 3; const int ex = tope[r * 4 + k]; const int dest = baseL[ex] + rank[r * 4 + k];
        const u32x4* src = (const u32x4*)(WSP(signed char, WS_F8) + (size_t)r * 1024); u32x4* dst = (u32x4*)(WSP(signed char, WS_XS) + (size_t)dest * 1024);
        dst[F.lane] = src[F.lane];
        if (F.lane == 0) { rtok[dest] = r * 4 + k; rgate[dest] = topg[r * 4 + k]; WSP(float, WS_RSC)[dest] = WSP(float, WS_FSC)[r]; }
    }
    if (F.bid < 32) { const int e = F.bid; const int s = padS[e] + totL[e], en = padS[e + 1]; for (int i = s + F.tid; i < en; i += NTHR) { rtok[i] = -1; rgate[i] = 0.f; WSP(float, WS_RSC)[i] = 0.f; } }
    if (F.bid == 32) { int* blke = WSP(int, WS_BLKE); const int nrb = padS[32] >> 8;
        for (int rb = F.tid; rb < MAXRB; rb += NTHR) { int ex = -1; if (rb < nrb) { const int row = rb << 8; ex = 0; for (int e = 1; e < 32; ++e) if (row >= padS[e]) ex = e; } blke[rb] = ex; }
        if (F.tid == 0) blke[MAXRB] = nrb; }
    __syncthreads();
}
__device__ __forceinline__ void load8(const bf16* p, float (&x)[8]) { const u32x4 w = *(const u32x4*)p;
#pragma unroll
    for (int i = 0; i < 4; ++i) { x[2 * i] = bflo(w[i]); x[2 * i + 1] = bfhi(w[i]); } }
__device__ __forceinline__ void store8(bf16* p, const float (&x)[8]) { u32x4 w;
#pragma unroll
    for (int i = 0; i < 4; ++i) w[i] = pk2(x[2 * i], x[2 * i + 1]);
    *(u32x4*)p = w; }
__device__ __forceinline__ void rope8(float (&x)[8], const float* cs  ) {
    const f32x4 c0 = *(const f32x4*)cs, c1 = *(const f32x4*)(cs + 4); float y[8];
    y[0] = x[0] * c0[0] - x[1] * c0[1]; y[1] = x[0] * c0[1] + x[1] * c0[0]; y[2] = x[2] * c0[2] - x[3] * c0[3]; y[3] = x[2] * c0[3] + x[3] * c0[2];
    y[4] = x[4] * c1[0] - x[5] * c1[1]; y[5] = x[4] * c1[1] + x[5] * c1[0]; y[6] = x[6] * c1[2] - x[7] * c1[3]; y[7] = x[6] * c1[3] + x[7] * c1[2];
#pragma unroll
    for (int i = 0; i < 8; ++i) x[i] = y[i];
}
template <int GL>
__device__ __forceinline__ void headnorm8(float (&x)[8], const float* gain8) {
    float ss = 0.f;
#pragma unroll
    for (int i = 0; i < 8; ++i) ss += x[i] * x[i];
#pragma unroll
    for (int o = 1; o < GL; o <<= 1) ss += __shfl_xor(ss, o);
    const float rstd = rsqrtf(ss * (1.0f / (8.0f * GL)) + NORM_EPS);
#pragma unroll
    for (int i = 0; i < 8; ++i) x[i] = x[i] * rstd * gain8[i];
}
__device__ __forceinline__ void phase_qkv(const Params& P, Frame& F) {
    const int gw = F.vcu * NWAVES + F.wave, NGW = 256 * NWAVES; const int l = F.lane;
    const bf16* PR = WSP(bf16, WS_PROJ); const float* r64 = WSP(float, WS_ROPE64); const float* r128 = WSP(float, WS_ROPE128);
    float gq[8], gk[8], gdq[8], gdk[8];
#pragma unroll
    for (int i = 0; i < 8; ++i) { gq[i] = P.in[I_ATT_Q_GAIN][(8 * l) % 128 + i]; gk[i] = P.in[I_ATT_K_GAIN][(8 * l) % 128 + i]; gdq[i] = P.in[I_DQ_GAIN][(8 * l) % 64 + i]; gdk[i] = P.in[I_DK_GAIN][(8 * l) % 64 + i]; }
    for (int r = gw; r < NTOK; r += NGW) {
        const bool lat = r < NLAT; const int rc = r - NLAT; const int b = lat ? (r >> 11) : (rc >> 8); const int t = r & 2047; const int pos = lat ? 256 + t : (rc & 255);
        const bf16* row = PR + (size_t)r * ATT_IN; float x[8];
        const int c128 = (8 * l) % 128, c64 = (8 * l) % 64;
        if (lat) {
            load8(row + 8 * l, x); headnorm8<16>(x, gq); rope8(x, r128 + ((size_t)t * 64 + c128 / 2) * 2);
            store8(WSP(bf16, WS_GQ) + ((size_t)(b * 4 + (l >> 4)) * 2048 + t) * 128 + c128, x);
        }
        {
            load8(row + 512 + 8 * l, x); float xn[8];
#pragma unroll
            for (int i = 0; i < 8; ++i) xn[i] = x[i];
            headnorm8<16>(xn, gk); if (lat) rope8(xn, r128 + ((size_t)t * 64 + c128 / 2) * 2);
            const int kvh = (l >> 4) & 1; const size_t off = ((size_t)(b * 2 + kvh) * 2304 + pos) * 128 + c128;
            if (l < 32) store8(WSP(bf16, WS_GK) + off, xn); else store8(WSP(bf16, WS_GV) + off, x);
        }
        if (lat) {
            load8(row + 1024 + 8 * l, x); headnorm8<8>(x, gdq); rope8(x, r64 + ((size_t)t * 32 + c64 / 2) * 2);
            store8(WSP(bf16, WS_DQ) + ((size_t)(b * 8 + (l >> 3)) * 2048 + t) * 64 + c64, x);
        }
        {
            load8(row + 1536 + 8 * l, x); headnorm8<8>(x, gdk); if (lat) rope8(x, r64 + ((size_t)t * 32 + c64 / 2) * 2);
            store8(WSP(bf16, WS_DK) + ((size_t)(b * 8 + (l >> 3)) * 2304 + pos) * 64 + c64, x);
        }
        {
            load8(row + 2048 + 8 * l, x);
            store8(WSP(bf16, WS_DV) + ((size_t)(b * 4 + (l >> 4)) * 2304 + pos) * 128 + c128, x);
        }
    }
}

namespace attn {
constexpr int DV = 128, NW = 8, QBLK = 32, KVBLK = 64, SKV = 2304;
constexpr float THR = 8.f;
constexpr int SHM_V = KVBLK * DV * 2, SHM_K = KVBLK * 128 * 2;
#define KSWZ(row, colB) ((row) * 256 + ((colB) ^ (((row) & 7) << 4)))
#define SBAR() __builtin_amdgcn_sched_barrier(0)
__device__ __forceinline__ int crow(int r, int hi) { return (r & 3) + 8 * (r >> 2) + 4 * hi; }
__device__ __forceinline__ unsigned cvtpk(float lo, float hi) { return pk2(lo, hi); }
template <int NQ> struct Cst { static constexpr float SCALE = NQ == 8 ? 0.088388347648318440f : 0.125f; };
template <int NQ>
__device__ __forceinline__ void partialSM(f32x16& p0, f32x16& p1, float& m_reg, float& mn, float& alpha) {
    constexpr float SCALE = Cst<NQ>::SCALE; constexpr float C = SCALE * 1.4426950408889634f;
    float pmax = p0[0];
#pragma unroll
    for (int r = 1; r < 16; ++r) pmax = fmaxf(pmax, p0[r]);
#pragma unroll
    for (int r = 0; r < 16; ++r) pmax = fmaxf(pmax, p1[r]);
    { auto rr = __builtin_amdgcn_permlane32_swap(__float_as_uint(pmax), __float_as_uint(pmax), false, false);
      pmax = fmaxf(__uint_as_float(rr[0]), __uint_as_float(rr[1])); }
    if (__builtin_expect(__all(pmax - m_reg <= THR / SCALE), 1)) { mn = m_reg; alpha = 1.f; }
    else { mn = fmaxf(m_reg, pmax); alpha = __builtin_amdgcn_exp2f((m_reg - mn) * C); m_reg = mn; }
    const float mnC = -mn * C;
#pragma unroll
    for (int r = 0; r < 16; ++r) p0[r] = fmaf(p0[r], C, mnC);
#pragma unroll
    for (int r = 0; r < 16; ++r) p1[r] = fmaf(p1[r], C, mnC);
#pragma unroll
    for (int r = 0; r < 16; ++r) p0[r] = __builtin_amdgcn_exp2f(p0[r]);
}
__device__ __forceinline__ void finishSM(f32x16& p0, f32x16& p1, float alpha, float& l_reg, bf16x8& pa0, bf16x8& pa1, bf16x8& pa2, bf16x8& pa3) {
#pragma unroll
    for (int r = 0; r < 16; ++r) p1[r] = __builtin_amdgcn_exp2f(p1[r]);
    float ps = 0;
#pragma unroll
    for (int r = 0; r < 16; ++r) ps += p0[r];
#pragma unroll
    for (int r = 0; r < 16; ++r) ps += p1[r];
    { auto rr = __builtin_amdgcn_permlane32_swap(__float_as_uint(ps), __float_as_uint(ps), false, false);
      ps = __uint_as_float(rr[0]) + __uint_as_float(rr[1]); }
    l_reg = l_reg * alpha + ps;
#define PK4(PP, BASE, OUT) do { unsigned a0 = cvtpk(PP[BASE + 0], PP[BASE + 1]), a1 = cvtpk(PP[BASE + 2], PP[BASE + 3]);   \
    unsigned b0 = cvtpk(PP[BASE + 4], PP[BASE + 5]), b1 = cvtpk(PP[BASE + 6], PP[BASE + 7]);                              \
    auto r0 = __builtin_amdgcn_permlane32_swap(a0, b0, false, false); auto r1 = __builtin_amdgcn_permlane32_swap(a1, b1, false, false); \
    u32x4 w = {r0[0], r1[0], r0[1], r1[1]}; OUT = *reinterpret_cast<bf16x8*>(&w); } while (0)
    PK4(p0, 0, pa0); PK4(p0, 8, pa1); PK4(p1, 0, pa2); PK4(p1, 8, pa3);
#undef PK4
}
template <int NQ>
__device__ __forceinline__ void qkt(f32x16& p0, f32x16& p1, const char* Ks, const bf16x8* qr, int r32, int hi) {
    p0 = f32x16{}; p1 = f32x16{};
#pragma unroll
    for (int d0 = 0; d0 < NQ; ++d0) { const int cb = (d0 * 16 + hi * 8) * 2;
        const bf16x8 b0 = *reinterpret_cast<const bf16x8*>(Ks + KSWZ(r32, cb));
        const bf16x8 b1 = *reinterpret_cast<const bf16x8*>(Ks + KSWZ(32 + r32, cb));
        p0 = __builtin_amdgcn_mfma_f32_32x32x16_bf16(b0, qr[d0], p0, 0, 0, 0);
        p1 = __builtin_amdgcn_mfma_f32_32x32x16_bf16(b1, qr[d0], p1, 0, 0, 0); }
}
__device__ __forceinline__ int v_st(int k, int c) { const int kk = (k & ~0xC) | ((k & 4) << 1) | ((k & 8) >> 1); return ((kk >> 3) * 4 + (c >> 5)) * 512 + ((kk & 7) * 32 + (c & 31)) * 2; }
__device__ __forceinline__ int v_rd_base(int lane) { return ((lane & 3) << 3) | (((lane >> 2) & 3) << 6) | (((lane >> 4) & 1) << 5) | (((lane >> 5) & 1) << 8); }
constexpr int v_rd_off(int d0, int ks, int half) { return d0 * 512 + ks * 4096 + half * 2048; }
template <int OFF> __device__ __forceinline__ s16x4 tr_read(int vb) {
    s16x4 r; asm volatile("ds_read_b64_tr_b16 %0, %1 offset:%2" : "=&v"(r) : "v"(vb), "i"(OFF) : "memory"); return r;
}
template <int D0> __device__ __forceinline__ void pv_one(f32x16& od, int vb, bf16x8 pa0, bf16x8 pa1, bf16x8 pa2, bf16x8 pa3) {
    const s16x4 l0 = tr_read<v_rd_off(D0, 0, 0)>(vb), h0 = tr_read<v_rd_off(D0, 0, 1)>(vb), l1 = tr_read<v_rd_off(D0, 1, 0)>(vb), h1 = tr_read<v_rd_off(D0, 1, 1)>(vb);
    const s16x4 l2 = tr_read<v_rd_off(D0, 2, 0)>(vb), h2 = tr_read<v_rd_off(D0, 2, 1)>(vb), l3 = tr_read<v_rd_off(D0, 3, 0)>(vb), h3 = tr_read<v_rd_off(D0, 3, 1)>(vb);
    asm volatile("s_waitcnt lgkmcnt(0)" ::: "memory"); SBAR();
#define PKV(L, H) (bf16x8){L[0], L[1], L[2], L[3], H[0], H[1], H[2], H[3]}
    od = __builtin_amdgcn_mfma_f32_32x32x16_bf16(pa0, PKV(l0, h0), od, 0, 0, 0);
    od = __builtin_amdgcn_mfma_f32_32x32x16_bf16(pa1, PKV(l1, h1), od, 0, 0, 0);
    od = __builtin_amdgcn_mfma_f32_32x32x16_bf16(pa2, PKV(l2, h2), od, 0, 0, 0);
    od = __builtin_amdgcn_mfma_f32_32x32x16_bf16(pa3, PKV(l3, h3), od, 0, 0, 0);
#undef PKV
}
__device__ __forceinline__ void pv_d0(f32x16* o, int vb, bf16x8 pa0, bf16x8 pa1, bf16x8 pa2, bf16x8 pa3) {
    pv_one<0>(o[0], vb, pa0, pa1, pa2, pa3); pv_one<1>(o[1], vb, pa0, pa1, pa2, pa3); pv_one<2>(o[2], vb, pa0, pa1, pa2, pa3); pv_one<3>(o[3], vb, pa0, pa1, pa2, pa3);
}
template <int NQ, int EPI>
__device__ __forceinline__ void attn_body(const bf16* __restrict__ Qb, const bf16* __restrict__ Kh, const bf16* __restrict__ Vh, bf16* __restrict__ Y, float* scratch, float lam, const float* dgain, char* lds) {
    constexpr int LDQ = NQ * 16, LDK = NQ * 16, LDV = DV;
    const int tid = threadIdx.x, wid = __builtin_amdgcn_readfirstlane(tid >> 6), lane = tid & 63, r32 = lane & 31, hi = lane >> 5;
    char* V_lds = lds; char* K_lds = lds + 2 * SHM_V;
    float* wsf = (float*)(lds + 2 * SHM_V + 2 * SHM_K) + wid * 64; float* li_l = wsf; float* al_l = wsf + 32;
    float m_reg = -1e30f, l_reg = 0; f32x16 o[4] = {}; bf16x8 qr[NQ];
    const bf16* Qw = Qb + (size_t)(wid * QBLK + r32) * LDQ + hi * 8;
#pragma unroll
    for (int d0 = 0; d0 < NQ; ++d0) qr[d0] = *reinterpret_cast<const bf16x8*>(Qw + d0 * 16);
    const int sr = tid >> 4, sc = (tid & 15) * 8, vst0 = v_st(sr, sc), vst1 = v_st(32 + sr, sc);
    const int kr = NQ == 8 ? sr : (tid >> 3), kc = NQ == 8 ? sc : (tid & 7) * 8;
    const int vb0 = (int)(uintptr_t)V_lds + v_rd_base(lane);
    struct { bf16x8 vs0, vs1, ks0, ks1; } sr_[2];
    const unsigned voff0 = (unsigned)(sr * LDV + sc) * 2u, voff1 = voff0 + 32u * LDV * 2u, koff0 = (unsigned)(kr * LDK + kc) * 2u, koff1 = koff0 + 32u * LDK * 2u;
#define SLOAD(i, k0) do { const char* _vb = (const char*)Vh + (size_t)(k0) * (LDV * 2); const char* _kb = (const char*)Kh + (size_t)(k0) * (LDK * 2); \
    sr_[i].vs0 = *reinterpret_cast<const bf16x8*>(_vb + voff0); sr_[i].vs1 = *reinterpret_cast<const bf16x8*>(_vb + voff1); \
    sr_[i].ks0 = *reinterpret_cast<const bf16x8*>(_kb + koff0); if (NQ == 8) sr_[i].ks1 = *reinterpret_cast<const bf16x8*>(_kb + koff1); } while (0)
#define SWRITE(b, i) do { *(bf16x8*)(V_lds + (b) * SHM_V + vst0) = sr_[i].vs0; *(bf16x8*)(V_lds + (b) * SHM_V + vst1) = sr_[i].vs1; \
    *(bf16x8*)(K_lds + (b) * SHM_K + KSWZ(kr, kc * 2)) = sr_[i].ks0; if (NQ == 8) *(bf16x8*)(K_lds + (b) * SHM_K + KSWZ(32 + kr, kc * 2)) = sr_[i].ks1; } while (0)
#define SWAIT() do { if (NQ == 8) asm volatile("s_waitcnt vmcnt(4)" ::: "memory"); else asm volatile("s_waitcnt vmcnt(3)" ::: "memory"); } while (0)
#define RESC(a) do { if (__any((a) < 1.f)) { if (hi == 0) al_l[r32] = (a); asm volatile("s_waitcnt lgkmcnt(0)" ::: "memory"); \
    _Pragma("unroll") for (int d = 0; d < 4; ++d) _Pragma("unroll") for (int r = 0; r < 16; ++r) o[d][r] *= al_l[crow(r, hi)]; } } while (0)
    f32x16 pA0, pA1, pB0, pB1; float mnA, mnB, alA, alB; bf16x8 pa0, pa1, pa2, pa3; constexpr int NT = SKV / KVBLK;
    constexpr int SE = 0, SO = 1;
    SLOAD(SE, 0); asm volatile("s_waitcnt vmcnt(0)" ::: "memory"); SWRITE(0, SE); __syncthreads();
    qkt<NQ>(pA0, pA1, K_lds, qr, r32, hi); partialSM<NQ>(pA0, pA1, m_reg, mnA, alA);
    SLOAD(SO, KVBLK); SLOAD(SE, 2 * KVBLK);
    SWAIT(); SWRITE(1, SO); __syncthreads();
    for (int j = 1; j + 1 < NT; j += 2) {
        SBAR(); qkt<NQ>(pB0, pB1, K_lds + SHM_K, qr, r32, hi);
        finishSM(pA0, pA1, alA, l_reg, pa0, pa1, pa2, pa3); SBAR();
        SLOAD(SO, (j + 2) * KVBLK); SBAR();
        pv_d0(o, vb0, pa0, pa1, pa2, pa3); partialSM<NQ>(pB0, pB1, m_reg, mnB, alB);
        __syncthreads(); SWAIT(); SWRITE(0, SE);
        RESC(alB); __syncthreads();
        SBAR(); qkt<NQ>(pA0, pA1, K_lds, qr, r32, hi);
        finishSM(pB0, pB1, alB, l_reg, pa0, pa1, pa2, pa3); SBAR();
        if (j + 3 < NT) SLOAD(SE, (j + 3) * KVBLK); SBAR();
        pv_d0(o, vb0 + (int)SHM_V, pa0, pa1, pa2, pa3); partialSM<NQ>(pA0, pA1, m_reg, mnA, alA);
        __syncthreads(); SWAIT(); SWRITE(1, SO);
        RESC(alA); __syncthreads();
    }
    SBAR(); qkt<NQ>(pB0, pB1, K_lds + SHM_K, qr, r32, hi);
    finishSM(pA0, pA1, alA, l_reg, pa0, pa1, pa2, pa3); SBAR();
    pv_d0(o, vb0, pa0, pa1, pa2, pa3); partialSM<NQ>(pB0, pB1, m_reg, mnB, alB);
    __syncthreads(); RESC(alB);
    finishSM(pB0, pB1, alB, l_reg, pa0, pa1, pa2, pa3); SBAR();
    pv_d0(o, vb0 + (int)SHM_V, pa0, pa1, pa2, pa3);
    if (hi == 0) li_l[r32] = l_reg; asm volatile("s_waitcnt lgkmcnt(0)" ::: "memory");
    float rli[16];
#pragma unroll
    for (int r = 0; r < 16; ++r) rli[r] = __builtin_amdgcn_rcpf(li_l[crow(r, hi)]);
    if (EPI == 0) {
        bf16* Yw = Y + (size_t)(wid * QBLK) * 1024;
#pragma unroll
        for (int r = 0; r < 16; ++r) { const int orow = crow(r, hi);
#pragma unroll
            for (int d0 = 0; d0 < 4; ++d0) Yw[(size_t)orow * 1024 + d0 * 32 + r32] = (bf16)(pk2(o[d0][r] * rli[r], 0.f) & 0xffffu); }
    } else if (EPI == 1) {
#pragma unroll
        for (int r = 0; r < 16; ++r)
#pragma unroll
            for (int d0 = 0; d0 < 4; ++d0) scratch[((wid * 16 + r) * 4 + d0) * 64 + lane] = o[d0][r] * rli[r];
    } else {
        bf16* Yw = Y + (size_t)(wid * QBLK) * 1024; float gn[4];
#pragma unroll
        for (int d0 = 0; d0 < 4; ++d0) gn[d0] = dgain[d0 * 32 + r32] * (1.0f - LAM_INIT);
#pragma unroll
        for (int r = 0; r < 16; ++r) { float od[4]; float ss = 0.f;
#pragma unroll
            for (int d0 = 0; d0 < 4; ++d0) { od[d0] = scratch[((wid * 16 + r) * 4 + d0) * 64 + lane] - lam * (o[d0][r] * rli[r]); ss += od[d0] * od[d0]; }
#pragma unroll
            for (int of = 1; of < 32; of <<= 1) ss += __shfl_xor(ss, of);
            const float rstd = rsqrtf(ss * (1.0f / 128.0f) + NORM_EPS); const int orow = crow(r, hi);
#pragma unroll
            for (int d0 = 0; d0 < 4; ++d0) Yw[(size_t)orow * 1024 + d0 * 32 + r32] = (bf16)(pk2(od[d0] * rstd * gn[d0], 0.f) & 0xffffu); }
    }
#undef SLOAD
#undef SWRITE
#undef SWAIT
#undef RESC
}
}
__device__ __forceinline__ void phase_attn(const Params& P, Frame& F) {
    char* lds = (char*)(unsigned char*)F.lds;
    float lam; { const float* lp = P.in[I_DLAMBDA]; const float a = wave_sum(lp[F.lane] * lp[64 + F.lane]), b = wave_sum(lp[128 + F.lane] * lp[192 + F.lane]); lam = __expf(a) - __expf(b) + LAM_INIT; }
    const int u = F.vcu; const int b = u >> 5, h = (u >> 3) & 3, qb = u & 7;
    bf16* Y = WSP(bf16, WS_ABF) + (size_t)(b * 2048 + qb * 256) * 1024;
#ifndef ATTN_TEST
#define ATTN_TEST 7
#endif
    if (ATTN_TEST & 1) {
        const bf16* Q = WSP(bf16, WS_GQ) + ((size_t)(b * 4 + h) * 2048 + qb * 256) * 128;
        const bf16* K = WSP(bf16, WS_GK) + (size_t)(b * 2 + (h >> 1)) * 2304 * 128; const bf16* V = WSP(bf16, WS_GV) + (size_t)(b * 2 + (h >> 1)) * 2304 * 128;
        attn::attn_body<8, 0>(Q, K, V, Y + h * 128, nullptr, 0.f, nullptr, lds);
        __syncthreads();
    }
    {
        float* scr = WSP(float, WS_O0) + (size_t)F.bid * 32768;
        const bf16* V = WSP(bf16, WS_DV) + (size_t)(b * 4 + h) * 2304 * 128;
        const bf16* Q0 = WSP(bf16, WS_DQ) + ((size_t)(b * 8 + 2 * h) * 2048 + qb * 256) * 64; const bf16* K0 = WSP(bf16, WS_DK) + (size_t)(b * 8 + 2 * h) * 2304 * 64;
        if (ATTN_TEST & 2) attn::attn_body<4, 1>(Q0, K0, V, nullptr, scr, 0.f, nullptr, lds);
        __syncthreads();
        if (ATTN_TEST & 4) attn::attn_body<4, 2>(Q0 + (size_t)2048 * 64, K0 + (size_t)2304 * 64, V, Y + 512 + h * 128, scr, lam, P.in[I_DGAIN], lds);
        __syncthreads();
    }
}
#ifndef MK_N_LAUNCHES
#define MK_N_LAUNCHES 1
#endif
constexpr int N_PHASES = 20;
__global__ void __launch_bounds__(NTHR, 2) hybrid_fwd(Params P) {
    extern __shared__ __attribute__((aligned(16))) unsigned char lds_raw[];
    Frame F;
    F.lds = (LAS unsigned char*)lds_raw; F.ws = P.ws;
    F.tid = threadIdx.x; F.lane = F.tid & 63; F.wave = __builtin_amdgcn_readfirstlane(F.tid >> 6);
    F.bid = blockIdx.x; F.vcu = (F.bid & 7) * 32 + (F.bid >> 3);
    volatile LAS unsigned* MISC = (volatile LAS unsigned*)(F.lds + MISC_OFF);
    for (int u = F.tid; u < (LDS_BYTES - LDSCTL_OFF) / 4; u += NTHR) ((LAS unsigned*)(F.lds + LDSCTL_OFF))[u] = 0u;
    __syncthreads();
    XcdBarrier bar; bar.bar = (unsigned*)(P.ws + WS_CTL) + CW_BAR; bar.x = 0; bar.st = nullptr;
    const int lo = P.ph_lo, hi = P.ph_hi;
    if (hi - lo > 1) bar = xcd_barrier_post((unsigned*)(P.ws + WS_CTL) + CW_BAR, MISC + 8);
#ifndef PHASE_MASK
#define PHASE_MASK 0xFFFFF
#endif
#define IN(k) (((PHASE_MASK >> (k)) & 1) && lo <= (k) && (k) < hi)
#ifndef DUP_MASK
#define DUP_MASK 0
#endif
#define REP(k)
#define SEAM(k) do { if (IN(k) && IN((k) + 1)) xcd_barrier(bar); } while (0)
    const float* mod = WSP(float, WS_MOD);
    if (IN(0)) REP(0) { phase_pre(P, F); } SEAM(0);
    if (IN(1)) REP(1) { phase_norm0(P, F); } SEAM(1);
    if (IN(2)) REP(2) {
        pg8::DenseOrder S; S.init(WSP(bf16, WS_ABF), WSP(bf16, WS_WT_RECIN), NTOK, REC_IN, F.bid);
        pg8::EpiRecIn E{WSP(bf16, WS_PROJ), WSP(float, WS_FF), WSP(float, WS_LB), WSP(float, WS_ROPE64)};
        pg8::gemm_phase(F.lds, S, E);
    } SEAM(2);
    if (IN(3)) REP(3) { phase_rec(P, F); } SEAM(3);
    if (IN(4)) REP(4) { phase_merge(P, F); } SEAM(4);
    if (IN(5)) REP(5) {
        pg8::DenseOrder S; S.init(WSP(bf16, WS_ABF), WSP(bf16, WS_WT_RECOUT), NTOK, DM, F.bid);
        pg8::EpiResidual E{P.in[I_X], P.in[I_CTX], WSP(float, WS_H1), mod + 2 * 1024};
        pg8::gemm_phase(F.lds, S, E);
    } SEAM(5);
    if (IN(6)) REP(6) { phase_route<NTOK, 0>(P, F, WSP(float, WS_H1)); } SEAM(6);
    if (IN(7)) REP(7) { phase_scatter<NTOK>(P, F); } SEAM(7);
    if (IN(8)) REP(8) {
        pg8::MoeOrder<8, true, 1024> S{(const char*)WSP(bf16, WS_XS), (const char*)WSP(bf16, WS_WT_GU), WSP(int, WS_BLKE), 0, F.vcu};
        S.nrb = __builtin_amdgcn_readfirstlane(__hip_atomic_load(WSP(int, WS_BLKE) + MAXRB, RLX_AGENT));
        pg8::EpiSwigluI8 E{WSP(bf16, WS_H1S), P.in[I_B_GU], WSP(float, WS_RSC), WSP(float, WS_SGU)};
        pg8::gemm_phase(F.lds, S, E);
    } SEAM(8);
    if (IN(9)) REP(9) {
        pg8::MoeOrder<4, false, 2048> S{(const char*)WSP(bf16, WS_H1S), (const char*)WSP(bf16, WS_WT_DN), WSP(int, WS_BLKE), 0, F.vcu};
        S.nrb = __builtin_amdgcn_readfirstlane(__hip_atomic_load(WSP(int, WS_BLKE) + MAXRB, RLX_AGENT));
        pg8::EpiMoeOut E{WSP(bf16, WS_YS), P.in[I_B_DOWN], WSP(int, WS_RTOK), WSP(float, WS_RGATE)};
        pg8::gemm_phase(F.lds, S, E);
    } SEAM(9);
    if (IN(10)) REP(10) { phase_norm1(P, F); } SEAM(10);
    if (IN(11)) REP(11) {
        pg8::DenseOrder S; S.init(WSP(bf16, WS_ABF), WSP(bf16, WS_WT_ATTIN), NTOK, ATT_IN, F.bid);
        pg8::EpiBf16 E{WSP(bf16, WS_PROJ), ATT_IN};
        pg8::gemm_phase(F.lds, S, E);
    } SEAM(11);
    if (IN(12)) REP(12) { phase_qkv(P, F); } SEAM(12);
    if (IN(13)) REP(13) { phase_attn(P, F); } SEAM(13);
    if (IN(14)) REP(14) {
        pg8::DenseOrder S; S.init(WSP(bf16, WS_ABF), WSP(bf16, WS_WT_ATTOUT), NLAT, DM, F.bid);
        pg8::EpiResidual E{WSP(float, WS_H2), WSP(float, WS_H2) + (size_t)NLAT * 1024, WSP(float, WS_H3), mod + 9 * 6144 + 2 * 1024};
        pg8::gemm_phase(F.lds, S, E);
    } SEAM(14);
    if (IN(15)) REP(15) { phase_route<NLAT, 1>(P, F, WSP(float, WS_H3)); } SEAM(15);
    if (IN(16)) REP(16) { phase_scatter<NLAT>(P, F); } SEAM(16);
    if (IN(17)) REP(17) {
        pg8::MoeOrder<8, true, 1024> S{(const char*)WSP(bf16, WS_XS), (const char*)(WSP(signed char, WS_WT_GU) + (size_t)32 * 2048 * 1024), WSP(int, WS_BLKE), 0, F.vcu};
        S.nrb = __builtin_amdgcn_readfirstlane(__hip_atomic_load(WSP(int, WS_BLKE) + MAXRB, RLX_AGENT));
        pg8::EpiSwigluI8 E{WSP(bf16, WS_H1S), P.in[I_B_GU] + 32 * 2048, WSP(float, WS_RSC), WSP(float, WS_SGU) + 32 * 2048};
        pg8::gemm_phase(F.lds, S, E);
    } SEAM(17);
    if (IN(18)) REP(18) {
        pg8::MoeOrder<4, false, 2048> S{(const char*)WSP(bf16, WS_H1S), (const char*)(WSP(bf16, WS_WT_DN) + (size_t)32 * 1024 * 1024), WSP(int, WS_BLKE), 0, F.vcu};
        S.nrb = __builtin_amdgcn_readfirstlane(__hip_atomic_load(WSP(int, WS_BLKE) + MAXRB, RLX_AGENT));
        pg8::EpiMoeOut E{WSP(bf16, WS_YS), P.in[I_B_DOWN] + 32 * 1024, WSP(int, WS_RTOK), WSP(float, WS_RGATE)};
        pg8::gemm_phase(F.lds, S, E);
    } SEAM(18);
    if (IN(19)) REP(19) { phase_final(P, F); }
#undef IN
#undef SEAM
}

extern "C" void kernel_launch(void* const* d_in, const int* in_sizes, int n_in, void* d_out, int out_size, void* d_ws, size_t ws_size, hipStream_t stream) {
    static int grid = 0;
    if (grid == 0) {
        if (n_in != 27 || out_size != NLAT * DM || ws_size < WS_END) { fprintf(stderr, "kernel_launch: unexpected shapes: n_in %d out %d ws %zu (need >= %zu)\n", n_in, out_size, ws_size, (size_t)WS_END); grid = -1; return; }
        int dev = 0, cus = 0;
        if (hipGetDevice(&dev) != hipSuccess || hipDeviceGetAttribute(&cus, hipDeviceAttributeMultiprocessorCount, dev) != hipSuccess) { grid = -1; return; }
        if (hipFuncSetAttribute((const void*)hybrid_fwd, hipFuncAttributeMaxDynamicSharedMemorySize, LDS_BYTES) != hipSuccess) { fprintf(stderr, "kernel_launch: hipFuncSetAttribute failed\n"); grid = -1; return; }
        if (cus != 256) fprintf(stderr, "kernel_launch: %d CUs (built for 256)\n", cus);
        grid = 256;
    }
    if (grid < 0) return;
    if (hipMemsetAsync((char*)d_ws + WS_CTL, 0, CTL_ZERO_BYTES, stream) != hipSuccess) return;
    Params p{};
    for (int i = 0; i < 27; ++i) p.in[i] = (const float*)d_in[i];
    p.out = (float*)d_out; p.ws = (unsigned char*)d_ws;
#ifndef DBG_STAGE
#define DBG_STAGE 0
#endif
    const int n_ph = DBG_STAGE == 1 ? 6 : DBG_STAGE == 2 ? 11 : DBG_STAGE == 3 ? 15 : DBG_STAGE == 4 ? 3 : DBG_STAGE == 5 ? 3 : DBG_STAGE == 6 ? 4 : DBG_STAGE == 7 ? 2 : DBG_STAGE == 8 ? 1 : N_PHASES;
#if MK_N_LAUNCHES == 1
    p.ph_lo = 0; p.ph_hi = n_ph;
    hipLaunchKernelGGL(hybrid_fwd, dim3(grid), dim3(NTHR), LDS_BYTES, stream, p);
#else
    for (int k = 0; k < n_ph; ++k) for (int rep = 0; rep < (((DUP_MASK >> k) & 1) ? 2 : 1); ++rep) { p.ph_lo = k; p.ph_hi = k + 1; hipLaunchKernelGGL(hybrid_fwd, dim3(grid), dim3(NTHR), LDS_BYTES, stream, p); }
#endif
    if (DBG_STAGE) { const size_t off = DBG_STAGE == 1 ? WS_H1 : DBG_STAGE == 2 ? WS_H2 : DBG_STAGE == 3 ? WS_H3 : DBG_STAGE == 4 ? WS_FF : DBG_STAGE == 5 ? WS_PROJ : DBG_STAGE == 6 ? WS_OREC : DBG_STAGE == 7 ? WS_ABF : WS_WT_GU; (void)hipMemcpyAsync(d_out, (char*)d_ws + off, DBG_STAGE == 7 ? (size_t)36 * MiB : (size_t)NLAT * DM * 4, hipMemcpyDeviceToDevice, stream); }
}
```

```cpp
#include <hip/hip_runtime.h>
#include <cstdio>
#include <cstdint>

#define GAS __attribute__((address_space(1)))
#define LAS __attribute__((address_space(3)))
typedef unsigned short bf16;
typedef float f32x2 __attribute__((ext_vector_type(2)));
typedef float f32x4 __attribute__((ext_vector_type(4)));
typedef float f32x16 __attribute__((ext_vector_type(16)));
typedef unsigned u32x2 __attribute__((ext_vector_type(2)));
typedef unsigned u32x4 __attribute__((ext_vector_type(4)));
typedef short bf16x8 __attribute__((ext_vector_type(8)));
typedef short s16x4 __attribute__((ext_vector_type(4)));

constexpr int BATCH = 8, SEQ = 2048, CTXL = 256, DM = 1024;
constexpr int NLAT = BATCH * SEQ, NCTX = BATCH * CTXL, NTOK = NLAT + NCTX;
constexpr int REC_IN = 4096, ATT_IN = 2560, NEXP = 32, MAXRB = 320;
constexpr float NORM_EPS = 1e-6f;
constexpr float LAM_INIT = 0.35550906759f;
constexpr int NWAVES = 8, NTHR = 512;

constexpr size_t MiB = 1u << 20;
constexpr size_t WS_CTL = 0, CTL_ZERO_BYTES = 1 * MiB;
constexpr size_t WS_MOD = 1 * MiB;
constexpr size_t WS_LB = 2 * MiB;
constexpr size_t WS_ROPE64 = 2 * MiB + 65536;
constexpr size_t WS_ROPE128 = 3 * MiB;
constexpr size_t WS_TOPE = 4 * MiB;
constexpr size_t WS_TOPG = WS_TOPE + 512 * 1024;
constexpr size_t WS_RANK = WS_TOPG + 512 * 1024;
constexpr size_t WS_BCNT = WS_RANK + 512 * 1024;
constexpr size_t WS_RTOK = WS_BCNT + 64 * 1024;
constexpr size_t WS_RGATE = WS_RTOK + 512 * 1024;
constexpr size_t WS_BLKE = WS_RGATE + 512 * 1024;
constexpr size_t WS_SGU = 7 * MiB;
constexpr size_t WS_FSC = 7 * MiB + 512 * 1024;
constexpr size_t WS_RSC = 7 * MiB + 640 * 1024;
constexpr size_t WS_SDN = 26 * MiB;
constexpr size_t WS_ASC = 26 * MiB + 65536;
constexpr size_t WS_WT_RECIN = 8 * MiB, WS_WT_RECOUT = 16 * MiB, WS_WT_ATTIN = 18 * MiB, WS_WT_ATTOUT = 24 * MiB;
constexpr size_t WS_WT_GU = 32 * MiB, WS_WT_DN = 288 * MiB;
constexpr size_t WS_ABF = 416 * MiB, WS_PROJ = 452 * MiB, WS_FF = 596 * MiB, WS_OREC = 668 * MiB;
constexpr size_t WS_H1 = 740 * MiB, WS_H2 = 812 * MiB, WS_H3 = 884 * MiB;
constexpr size_t WS_XS = 948 * MiB, WS_H1S = 1108 * MiB, WS_YS = 1268 * MiB;
constexpr size_t WS_F8 = WS_XS + 80 * MiB;
constexpr size_t WS_A8 = WS_XS + 100 * MiB;
constexpr size_t WS_GQ = 1412 * MiB, WS_GK = 1428 * MiB, WS_GV = 1438 * MiB, WS_DQ = 1448 * MiB, WS_DK = 1464 * MiB, WS_DV = 1482 * MiB, WS_O0 = 1500 * MiB;
constexpr size_t WS_END = 1532 * MiB;
constexpr int CW_BAR = 4096;

constexpr int RING_BYTES = 131072;
constexpr int LDSCTL_OFF = RING_BYTES, MISC_OFF = LDSCTL_OFF + 320;
constexpr int LDS_BYTES = 147456;

#define RLX_AGENT __ATOMIC_RELAXED, __HIP_MEMORY_SCOPE_AGENT
#define LDS_WAIT() asm volatile("s_waitcnt lgkmcnt(0)" ::: "memory")
#define VM_WAIT() asm volatile("s_waitcnt vmcnt(0)" ::: "memory")

__device__ __forceinline__ float bf2f(unsigned u) { return __uint_as_float(u << 16); }
__device__ __forceinline__ float bflo(unsigned w) { return __uint_as_float(w << 16); }
__device__ __forceinline__ float bfhi(unsigned w) { return __uint_as_float(w & 0xffff0000u); }
typedef __bf16 bf16x2_t __attribute__((ext_vector_type(2)));
__device__ __forceinline__ unsigned pk2(float lo, float hi) { f32x2 v = {lo, hi}; bf16x2_t b = __builtin_convertvector(v, bf16x2_t); return __builtin_bit_cast(unsigned, b); }
__device__ __forceinline__ float wave_sum(float v) {
#pragma unroll
    for (int o = 1; o < 64; o <<= 1) v += __shfl_xor(v, o);
    return v;
}
__device__ __forceinline__ float fsigmoid(float x) { return 1.0f / (1.0f + __expf(-x)); }
__device__ __forceinline__ float fsilu(float x) { return x / (1.0f + __expf(-x)); }

__device__ __forceinline__ unsigned q8pack(float a, float b, float c, float d, float inv) {
    int q0 = (int)rintf(a * inv), q1 = (int)rintf(b * inv), q2 = (int)rintf(c * inv), q3 = (int)rintf(d * inv);
    q0 = q0 > 127 ? 127 : (q0 < -127 ? -127 : q0); q1 = q1 > 127 ? 127 : (q1 < -127 ? -127 : q1); q2 = q2 > 127 ? 127 : (q2 < -127 ? -127 : q2); q3 = q3 > 127 ? 127 : (q3 < -127 ? -127 : q3);
    return (unsigned)(q0 & 255) | ((unsigned)(q1 & 255) << 8) | ((unsigned)(q2 & 255) << 16) | ((unsigned)(q3 & 255) << 24);
}
__device__ __forceinline__ float wave_max(float v) {
#pragma unroll
    for (int o = 1; o < 64; o <<= 1) v = fmaxf(v, __shfl_xor(v, o));
    return v;
}
#define XB_TMO      128
#define XB_XCNT(j)  (256  + 64 * (j))
#define XB_XSUB(j)  (1280 + 64 * (j))
#define XB_XGEN(j)  (2304 + 64 * (j))
#define XB_TOP      3328
#define XB_TOPGEN   3392
#define XCD_BAR_WORDS 3456
#define XB_SPIN_CAP (1u << 18)
__device__ __forceinline__ unsigned xb_ld(unsigned* p)              { return __hip_atomic_load(p, __ATOMIC_RELAXED, __HIP_MEMORY_SCOPE_AGENT); }
__device__ __forceinline__ unsigned xb_add(unsigned* p, unsigned v) { return __hip_atomic_fetch_add(p, v, __ATOMIC_RELAXED, __HIP_MEMORY_SCOPE_AGENT); }
__device__ __forceinline__ unsigned xb_xcc_id() { return (unsigned)__builtin_amdgcn_s_getreg((3 << 11) | 20) & 0xFu; }
#define XB_SPIN(cond, bar) do { unsigned _sp = 0; while (cond) { __builtin_amdgcn_s_sleep(1); \
    if ((++_sp & 255u) == 0u) { if (xb_ld(&(bar)[XB_TMO])) break; if (_sp > XB_SPIN_CAP) { atomicAdd(&(bar)[XB_TMO], 1u); break; } } } } while (0)
struct XcdBarrier { unsigned* bar; unsigned x; volatile LAS unsigned* st; };
__device__ __forceinline__ XcdBarrier xcd_barrier_post(unsigned* bar, volatile LAS unsigned* st) {
    XcdBarrier b; b.bar = bar; b.x = xb_xcc_id(); b.st = st;
    if (threadIdx.x == 0) (void)xb_add(&bar[XB_XCNT(b.x)], 1u);
    return b;
}
__device__ __forceinline__ void xcd_barrier_complete(unsigned* bar, unsigned x, unsigned& nloc, unsigned& nx) {
    const unsigned G = gridDim.x * gridDim.y * gridDim.z;
    unsigned sum, cnt, mine, sp = 0u;
    for (;;) {
        sum = 0u; cnt = 0u; mine = 0u;
#pragma unroll
        for (unsigned j = 0; j < 16; ++j) { const unsigned c = xb_ld(&bar[XB_XCNT(j)]); sum += c; cnt += (c > 0u) ? 1u : 0u; mine = (j == x) ? c : mine; }
        if (sum == G) break;
        __builtin_amdgcn_s_sleep(1);
        if ((++sp & 255u) == 0u) { if (xb_ld(&bar[XB_TMO])) break; if (sp > XB_SPIN_CAP) { atomicAdd(&bar[XB_TMO], 1u); break; } }
    }
    nloc = mine > 0u ? mine : 1u; nx = cnt > 0u ? cnt : 1u;
}
__device__ __forceinline__ void xcd_barrier(const XcdBarrier& b) {
    asm volatile("s_waitcnt vmcnt(0)" ::: "memory");
    __syncthreads();
    if (threadIdx.x == 0) {
        unsigned* bar = b.bar;
        __builtin_amdgcn_s_waitcnt(0);
        unsigned nloc = b.st[0], nx = b.st[1];
        if (nloc == 0u) { xcd_barrier_complete(bar, b.x, nloc, nx); b.st[0] = nloc; b.st[1] = nx; }
        const unsigned old = xb_add(&bar[XB_XSUB(b.x)], 1u);
        const unsigned gen = old / nloc;
        if (old + 1u == (gen + 1u) * nloc) {
            __builtin_amdgcn_fence(__ATOMIC_RELEASE, "agent");
            asm volatile("s_waitcnt vmcnt(0)" ::: "memory");
            const unsigned og = xb_add(&bar[XB_TOP], 1u);
            const unsigned tg = og / nx;
            if (og + 1u == (tg + 1u) * nx) xb_add(&bar[XB_TOPGEN], 1u);
            else XB_SPIN(xb_ld(&bar[XB_TOPGEN]) == tg, bar);
            __builtin_amdgcn_fence(__ATOMIC_ACQUIRE, "agent");
            xb_add(&bar[XB_XGEN(b.x)], 1u);
            asm volatile("s_waitcnt vmcnt(0)" ::: "memory");
        } else {
            XB_SPIN(xb_ld(&bar[XB_XGEN(b.x)]) == gen, bar);
            __builtin_amdgcn_fence(__ATOMIC_ACQUIRE, "agent");
            asm volatile("s_waitcnt vmcnt(0)" ::: "memory");
        }
    }
    __syncthreads();
}

struct Params { const float* in[27]; float* out; unsigned char* ws; int ph_lo, ph_hi; };
struct Frame {
    LAS unsigned char* lds;
    unsigned char* ws;
    int tid, lane, wave, bid, vcu;
};
enum { I_X = 0, I_C, I_CTX, I_CCTX, I_NORM_MIX, I_NORM_FFN, I_W_ADA, I_B_ADA, I_REC_W_IN, I_REC_LB, I_REC_W_OUT, I_HG_GAIN, I_RET_GAIN,
       I_ATT_W_IN, I_ATT_W_OUT, I_ATT_Q_GAIN, I_ATT_K_GAIN, I_DQ_GAIN, I_DK_GAIN, I_DLAMBDA, I_DGAIN, I_W_ROUTER, I_B_ROUTER, I_W_GU, I_B_GU, I_W_DOWN, I_B_DOWN };
#define WSP(T, off) ((T*)(F.ws + (off)))
__device__ __forceinline__ int mod_row(int r) { return r < NLAT ? (r >> 11) : 8; }
__device__ __forceinline__ void pre_modulation(const Params& P, Frame& F) {
    LAS float* s = (LAS float*)F.lds;
    LAS float* red = (LAS float*)(F.lds + 36864);
    const float* c = P.in[I_C]; const float* cctx = P.in[I_CCTX];
    for (int idx = F.tid; idx < 9 * 1024; idx += NTHR) { const int r = idx >> 10, k = idx & 1023; const float cv = r < 8 ? c[r * 1024 + k] : cctx[k]; s[idx] = fsilu(cv); }
    __syncthreads();
    const int l = F.bid / 96, col0 = (F.bid % 96) * 64;
    const float* W = P.in[I_W_ADA] + (size_t)l * 1024 * 6144 + col0 + F.lane;
    float acc[9];
#pragma unroll
    for (int r = 0; r < 9; ++r) acc[r] = 0.f;
    const int k0 = F.wave * 128;
#pragma unroll 2
    for (int kk = 0; kk < 128; kk += 4) {
        float wv[4];
#pragma unroll
        for (int i = 0; i < 4; ++i) wv[i] = W[(size_t)(k0 + kk + i) * 6144];
#pragma unroll
        for (int r = 0; r < 9; ++r) { const f32x4 sv = *(const LAS f32x4*)(s + r * 1024 + k0 + kk); acc[r] += sv.x * wv[0] + sv.y * wv[1] + sv.z * wv[2] + sv.w * wv[3]; }
    }
#pragma unroll
    for (int r = 0; r < 9; ++r) red[(F.wave * 9 + r) * 64 + F.lane] = acc[r];
    __syncthreads();
    float* mod = WSP(float, WS_MOD);
    for (int idx = F.tid; idx < 9 * 64; idx += NTHR) { const int r = idx >> 6, cl = idx & 63; float t = P.in[I_B_ADA][l * 6144 + col0 + cl];
#pragma unroll
        for (int w = 0; w < 8; ++w) t += red[(w * 9 + r) * 64 + cl];
        mod[(size_t)(l * 9 + r) * 6144 + col0 + cl] = t; }
    __syncthreads();
}
__device__ __forceinline__ void pre_tables(const Params& P, Frame& F) {
    const int gt = F.bid * NTHR + F.tid, GT = 256 * NTHR;
    if (gt < 1024) { const float* lg = P.in[I_REC_LB]; const float a = lg[gt], b = lg[1024 + gt], c = lg[2048 + gt]; const float m = fmaxf(a, fmaxf(b, c));
        const float ea = expf(a - m), eb = expf(b - m), ec = expf(c - m); WSP(float, WS_LB)[gt] = ea / (ea + eb + ec); }
    for (int idx = gt; idx < 2048 * 96; idx += GT) {
        const int t = idx / 96, p = idx % 96; const int row = t >> 6, col = t & 63;
        float* dst; int axis_dim, pp;
        if (p < 32) { dst = WSP(float, WS_ROPE64) + ((size_t)t * 32 + p) * 2; axis_dim = 32; pp = p; }
        else { dst = WSP(float, WS_ROPE128) + ((size_t)t * 64 + (p - 32)) * 2; axis_dim = 64; pp = p - 32; }
        const int nf = axis_dim / 2; const int fi = pp < nf ? pp : pp - nf; const float pos = pp < nf ? (float)row : (float)col;
        const float inv = powf(10000.0f, -(float)(2 * fi) / (float)axis_dim); const float ang = pos * inv;
        dst[0] = cosf(ang); dst[1] = sinf(ang);
    }
}
constexpr int TI_ATTOUT = 256, TI_DN = 64 * 256;
constexpr int TI_TOTAL = TI_ATTOUT + TI_DN;
__device__ __forceinline__ void titem_decode(const Params& P, Frame& F, int it, const float*& src, bf16*& dst, int& N) {
    const float* m; bf16* d; int local;
    if (it < TI_ATTOUT) { N = 1024; m = P.in[I_ATT_W_OUT]; d = WSP(bf16, WS_WT_ATTOUT); local = it; }
    else { it -= TI_ATTOUT; N = 1024; const int mat = it >> 8; local = it & 255; m = P.in[I_W_DOWN] + (size_t)mat * 1024 * 1024; d = WSP(bf16, WS_WT_DN) + (size_t)mat * 1024 * 1024; }
    const int nblk = N >> 6, nb = local % nblk, kb = local / nblk;
    src = m + (size_t)(kb * 64) * N + nb * 64; dst = d + (size_t)(nb * 64) * 1024 + kb * 64;
}
__device__ __forceinline__ void pre_transposes(const Params& P, Frame& F) {
    LAS float* scr = (LAS float*)(F.lds + F.wave * 16384);
    const int gw = F.vcu * NWAVES + F.wave, NGW = 256 * NWAVES;
    const int lr = F.lane >> 4, lc = (F.lane & 15) * 4;
    f32x4 cur[16];
    const float* src; bf16* dst; int N;
    int it = gw;
    if (it < TI_TOTAL) { titem_decode(P, F, it, src, dst, N);
#pragma unroll
        for (int i = 0; i < 16; ++i) cur[i] = *(const f32x4*)(src + (size_t)(4 * i + lr) * N + lc); }
    while (it < TI_TOTAL) {
        const int itn = it + NGW; f32x4 nxt[16]; const float* srcn; bf16* dstn; int Nn;
        if (itn < TI_TOTAL) { titem_decode(P, F, itn, srcn, dstn, Nn);
#pragma unroll
            for (int i = 0; i < 16; ++i) nxt[i] = *(const f32x4*)(srcn + (size_t)(4 * i + lr) * Nn + lc); }
#pragma unroll
        for (int i = 0; i < 16; ++i) { const int k = 4 * i + lr; *(LAS f32x4*)(scr + k * 64 + (lc ^ (((k >> 3) & 7) << 2))) = cur[i]; }
        const int c = F.lane & 7;
#pragma unroll
        for (int j = 0; j < 8; ++j) { const int n = (F.lane >> 3) + 8 * j; const LAS float* sp = scr + (8 * c) * 64 + (n ^ (c << 2));
            u32x4 o; o.x = pk2(sp[0], sp[64]); o.y = pk2(sp[128], sp[192]); o.z = pk2(sp[256], sp[320]); o.w = pk2(sp[384], sp[448]);
            *(u32x4*)(dst + (size_t)n * 1024 + 8 * c) = o; }
        if (itn < TI_TOTAL) {
#pragma unroll
            for (int i = 0; i < 16; ++i) cur[i] = nxt[i];
            dst = dstn; }
        it = itn;
    }
}
constexpr int NSTRIP_GU = 64 * 32, NSTRIP = NSTRIP_GU + 64 + 16 + 40;
__device__ __forceinline__ void strip_src(const Params& P, Frame& F, int s, const float*& src, signed char*& dst, float*& sc, int& N) {
    if (s < 64) { N = 4096; src = P.in[I_REC_W_IN] + s * 64; dst = WSP(signed char, WS_WT_RECIN) + (size_t)s * 64 * 1024; sc = WSP(float, WS_SDN) + s * 64; }
    else if ((s -= 64) < 16) { N = 1024; src = P.in[I_REC_W_OUT] + s * 64; dst = WSP(signed char, WS_WT_RECOUT) + (size_t)s * 64 * 1024; sc = WSP(float, WS_SDN) + 4096 + s * 64; }
    else if ((s -= 16) < 40) { N = 2560; src = P.in[I_ATT_W_IN] + s * 64; dst = WSP(signed char, WS_WT_ATTIN) + (size_t)s * 64 * 1024; sc = WSP(float, WS_SDN) + 5120 + s * 64; }
    else { s -= 40; N = 2048; const int mat = s >> 5, nb = s & 31;
        src = P.in[I_W_GU] + (size_t)mat * 1024 * 2048 + nb * 64; dst = WSP(signed char, WS_WT_GU) + ((size_t)mat * 2048 + nb * 64) * 1024; sc = WSP(float, WS_SGU) + mat * 2048 + nb * 64; }
}
__device__ __forceinline__ void pre_strips(const Params& P, Frame& F) {
    LAS unsigned char* tile = F.lds; LAS float* wmax = (LAS float*)(F.lds + 133120); LAS float* scl = (LAS float*)(F.lds + 135168);
    const int w = F.wave, l = F.lane, lr = l >> 4, nq = (l & 15) * 4;
    f32x4 regs[32]; const float* src; signed char* dst; float* sc; int N;
    int s = F.vcu;
    if (s < NSTRIP) { strip_src(P, F, s, src, dst, sc, N);
#pragma unroll
        for (int i = 0; i < 32; ++i) regs[i] = *(const f32x4*)(src + (size_t)(i * 32 + w * 4 + lr) * N + nq); }
    while (s < NSTRIP) {
        f32x4 pm = {0.f, 0.f, 0.f, 0.f};
#pragma unroll
        for (int i = 0; i < 32; ++i) { const int kr = i * 32 + w * 4 + lr; const f32x4 v = regs[i];
            pm.x = fmaxf(pm.x, fabsf(v.x)); pm.y = fmaxf(pm.y, fabsf(v.y)); pm.z = fmaxf(pm.z, fabsf(v.z)); pm.w = fmaxf(pm.w, fabsf(v.w));
            u32x2 pw; pw.x = pk2(v.x, v.y); pw.y = pk2(v.z, v.w);
            *(LAS u32x2*)(tile + kr * 128 + ((nq ^ (((kr >> 4) & 7) * 8)) * 2)) = pw; }
#pragma unroll
        for (int j = 0; j < 4; ++j) { float t = pm[j]; t = fmaxf(t, __shfl_xor(t, 16)); t = fmaxf(t, __shfl_xor(t, 32)); pm[j] = t; }
        if (l < 16) *(LAS f32x4*)(wmax + w * 64 + nq) = pm;
        __syncthreads();
        if (F.tid < 64) { float m = 0.f;
#pragma unroll
            for (int ww = 0; ww < 8; ++ww) m = fmaxf(m, wmax[ww * 64 + F.tid]);
            const float scv = m > 0.f ? m * (1.0f / 127.0f) : 1.0f; scl[F.tid] = scv; sc[F.tid] = scv; }
        signed char* dcur = dst;
        const int sn = s + 256;
        if (sn < NSTRIP) { strip_src(P, F, sn, src, dst, sc, N);
#pragma unroll
            for (int i = 0; i < 32; ++i) regs[i] = *(const f32x4*)(src + (size_t)(i * 32 + w * 4 + lr) * N + nq); }
        __syncthreads();
        { const int n = (l >> 3) + 8 * w, c = l & 7; const float inv = 1.0f / scl[n]; const int nsw = (n ^ (c * 8)) * 2;
#pragma unroll 1
            for (int kb = 0; kb < 8; ++kb) { const int k0 = kb * 128 + c * 16; u32x4 o;
#pragma unroll
                for (int d = 0; d < 4; ++d) { unsigned wd = 0;
#pragma unroll
                    for (int b = 0; b < 4; ++b) { const float v = bf2f(*(const LAS bf16*)(tile + (k0 + 4 * d + b) * 128 + nsw)); int q = (int)rintf(v * inv); q = q > 127 ? 127 : (q < -127 ? -127 : q); wd |= (unsigned)(q & 255) << (8 * b); }
                    o[d] = wd; }
                *(u32x4*)(dcur + (size_t)n * 1024 + k0) = o; } }
        __syncthreads();
        s = sn;
    }
}
__device__ __forceinline__ void phase_pre(const Params& P, Frame& F) {
    if (F.bid < 192) pre_modulation(P, F);
    pre_tables(P, F);
    pre_strips(P, F);
    pre_transposes(P, F);
}

__device__ __forceinline__ void norm_mod_store(const f32x4 (&v)[4], const float* gain, const float* sc, const float* sh, bf16* orow, int lane) {
    float ss = 0.f;
#pragma unroll
    for (int j = 0; j < 4; ++j) ss += (v[j].x * v[j].x + v[j].y * v[j].y) + (v[j].z * v[j].z + v[j].w * v[j].w);
    const float rstd = rsqrtf(wave_sum(ss) * (1.0f / 1024.0f) + NORM_EPS);
#pragma unroll
    for (int j = 0; j < 4; ++j) { const int c = 4 * lane + 256 * j; const f32x4 g = *(const f32x4*)(gain + c), s1 = *(const f32x4*)(sc + c), s0 = *(const f32x4*)(sh + c);
        const f32x4 a = v[j] * rstd * g * (s1 + 1.0f) + s0; u32x2 w; w.x = pk2(a.x, a.y); w.y = pk2(a.z, a.w); *(u32x2*)(orow + c) = w; }
}
__device__ __forceinline__ void norm_mod_store_q8(const f32x4 (&v)[4], const float* gain, const float* sc, const float* sh, signed char* orow, float* oscale, int lane) {
    float ss = 0.f;
#pragma unroll
    for (int j = 0; j < 4; ++j) ss += (v[j].x * v[j].x + v[j].y * v[j].y) + (v[j].z * v[j].z + v[j].w * v[j].w);
    const float rstd = rsqrtf(wave_sum(ss) * (1.0f / 1024.0f) + NORM_EPS);
    f32x4 a[4]; float amax = 0.f;
#pragma unroll
    for (int j = 0; j < 4; ++j) { const int c = 4 * lane + 256 * j; const f32x4 g = *(const f32x4*)(gain + c), s1 = *(const f32x4*)(sc + c), s0 = *(const f32x4*)(sh + c);
        a[j] = v[j] * rstd * g * (s1 + 1.0f) + s0; amax = fmaxf(amax, fmaxf(fmaxf(fabsf(a[j].x), fabsf(a[j].y)), fmaxf(fabsf(a[j].z), fabsf(a[j].w)))); }
    amax = wave_max(amax); const float qs = amax > 0.f ? amax * (1.0f / 127.0f) : 1.0f, qi = 1.0f / qs;
    if (lane == 0) *oscale = qs;
#pragma unroll
    for (int j = 0; j < 4; ++j) *(unsigned*)(orow + 4 * lane + 256 * j) = q8pack(a[j].x, a[j].y, a[j].z, a[j].w, qi);
}
__device__ __forceinline__ void phase_norm0(const Params& P, Frame& F) {
    const int gw = F.vcu * NWAVES + F.wave, NGW = 256 * NWAVES; const float* mod = WSP(float, WS_MOD);
    for (int r = gw; r < NTOK; r += NGW) {
        const float* src = r < NLAT ? P.in[I_X] + (size_t)r * 1024 : P.in[I_CTX] + (size_t)(r - NLAT) * 1024; f32x4 v[4];
#pragma unroll
        for (int j = 0; j < 4; ++j) v[j] = *(const f32x4*)(src + 4 * F.lane + 256 * j);
        const float* m = mod + (size_t)mod_row(r) * 6144;
        norm_mod_store_q8(v, P.in[I_NORM_MIX], m + 1024, m, WSP(signed char, WS_A8) + (size_t)r * 1024, WSP(float, WS_ASC) + r, F.lane);
    }
}
__device__ __forceinline__ void load_moe_sum(const float* h1row, const bf16* ysrow  , const float* g2, f32x4 (&v)[4], int lane) {
#pragma unroll
    for (int j = 0; j < 4; ++j) { const int c = 4 * lane + 256 * j; f32x4 s = {0.f, 0.f, 0.f, 0.f};
#pragma unroll
        for (int sl = 0; sl < 4; ++sl) { const u32x2 w = *(const u32x2*)(ysrow + sl * 1024 + c); s.x += bflo(w.x); s.y += bfhi(w.x); s.z += bflo(w.y); s.w += bfhi(w.y); }
        v[j] = *(const f32x4*)(h1row + c) + *(const f32x4*)(g2 + c) * s; }
}
__device__ __forceinline__ void phase_norm1(const Params& P, Frame& F) {
    const int gw = F.vcu * NWAVES + F.wave, NGW = 256 * NWAVES; const float* mod = WSP(float, WS_MOD);
    for (int r = gw; r < NTOK; r += NGW) {
        f32x4 v[4]; const int mr = mod_row(r);
        load_moe_sum(WSP(float, WS_H1) + (size_t)r * 1024, WSP(bf16, WS_YS) + (size_t)r * 4096, mod + (size_t)mr * 6144 + 5 * 1024, v, F.lane);
        float* h2 = WSP(float, WS_H2) + (size_t)r * 1024;
#pragma unroll
        for (int j = 0; j < 4; ++j) *(f32x4*)(h2 + 4 * F.lane + 256 * j) = v[j];
        const float* m = mod + (size_t)(9 + mr) * 6144;
        norm_mod_store_q8(v, P.in[I_NORM_MIX] + 1024, m + 1024, m, WSP(signed char, WS_A8) + (size_t)r * 1024, WSP(float, WS_ASC) + r, F.lane);
    }
}
__device__ __forceinline__ void phase_final(const Params& P, Frame& F) {
    const int gw = F.vcu * NWAVES + F.wave, NGW = 256 * NWAVES; const float* mod = WSP(float, WS_MOD);
    for (int r = gw; r < NLAT; r += NGW) {
        f32x4 v[4]; const int mr = mod_row(r);
        load_moe_sum(WSP(float, WS_H3) + (size_t)r * 1024, WSP(bf16, WS_YS) + (size_t)r * 4096, mod + (size_t)(9 + mr) * 6144 + 5 * 1024, v, F.lane);
        float* o = P.out + (size_t)r * 1024;
#pragma unroll
        for (int j = 0; j < 4; ++j) *(f32x4*)(o + 4 * F.lane + 256 * j) = v[j];
    }
}
namespace pg8 {
constexpr int BM = 256, BK = 64, HALF = 128, HTB = HALF * BK * 2, STAGE_BYTES = 8 * HTB, KD = 1024;
__device__ __forceinline__ int lds_byte(int r, int c) { const int st = (r >> 4) * 2 + (c >> 5), rr = r & 15, cc = c & 31, ob = rr * 64 + cc * 2; return st * 1024 + (ob ^ (((ob >> 9) & 1) << 5)); }
__device__ __forceinline__ void stage_rc(int b, int& R, int& C) { const int st = b / 1024, sb = b % 1024, swz = sb ^ (((sb >> 9) & 1) << 5); R = (st >> 1) * 16 + swz / 64; C = (st & 1) * 32 + (swz % 64) / 2; }
__device__ __forceinline__ int perm32(int rho) { const int n = rho >> 4, i = rho & 15; return 8 * (i >> 2) + 4 * n + (i & 3); }

struct Unit { const char *A0, *A1, *B0, *B1; int r0, c0, aux; };

typedef int i32x4 __attribute__((ext_vector_type(4)));
template <bool I8> struct AccT { typedef f32x4 T; };
template <> struct AccT<true> { typedef i32x4 T; };
template <bool I8> __device__ __forceinline__ typename AccT<I8>::T mma1(bf16x8 b, bf16x8 a, typename AccT<I8>::T c);
template <> __device__ __forceinline__ f32x4 mma1<false>(bf16x8 b, bf16x8 a, f32x4 c) { return __builtin_amdgcn_mfma_f32_16x16x32_bf16(b, a, c, 0, 0, 0); }
template <> __device__ __forceinline__ i32x4 mma1<true>(bf16x8 b, bf16x8 a, i32x4 c) { return __builtin_amdgcn_mfma_i32_16x16x64_i8(__builtin_bit_cast(i32x4, b), __builtin_bit_cast(i32x4, a), c, 0, 0, 0); }
template <class Epi, class Sched>
__device__ __forceinline__ void gemm_phase(LAS unsigned char* lds, const Sched& S, const Epi& E) {
    const int tid = threadIdx.x, wid = __builtin_amdgcn_readfirstlane(tid >> 6), lane = tid & 63, wr = wid >> 2, wc = wid & 3, fr = lane & 15, fq = lane >> 4;
    constexpr bool I8 = Epi::I8; typedef typename AccT<I8>::T acc_t;
    constexpr int K = I8 ? KD / 2 : KD  , nt = I8 ? KD / 128 : KD / BK;
    unsigned voffA[2], voffB[2];
#pragma unroll
    for (int i = 0; i < 2; ++i) { int R, C; stage_rc(tid * 16 + i * 8192, R, C); const int Rb = Epi::PERM ? ((R & ~31) + perm32(R & 31)) : R;
        voffA[i] = (unsigned)(R * K + C) * 2u; voffB[i] = (unsigned)(Rb * K + C) * 2u; }
    constexpr size_t kstep = (size_t)(BK * 2);
    const unsigned ldsw = (unsigned)wid * 1024u;
    const int aoff = lds_byte(wr * 64 + fr, fq * 8), boff = lds_byte(wc * 32 + fr, fq * 8);
#define PG8_SA(b, h) (((b) * 2 + (h)) * HTB)
#define PG8_SB(b, h) ((4 + (b) * 2 + (h)) * HTB)
#define PG8_STAGE(bufoff, gbase, voff) do { _Pragma("unroll") for (int _i = 0; _i < 2; ++_i) \
        __builtin_amdgcn_global_load_lds((const unsigned*)((const char*)(gbase) + (voff)[_i]), (LAS unsigned*)(lds + (bufoff) + ldsw + _i * 8192), 16, 0, 0); } while (0)
#define PG8_LDA(dst, b, h) do { _Pragma("unroll") for (int m = 0; m < 4; ++m) _Pragma("unroll") for (int k = 0; k < 2; ++k) dst[m][k] = *(const LAS bf16x8*)(lds + PG8_SA(b, h) + aoff + m * 2048 + k * 1024); } while (0)
#define PG8_LDB(dst, b, h) do { _Pragma("unroll") for (int n = 0; n < 2; ++n) _Pragma("unroll") for (int k = 0; k < 2; ++k) dst[n][k] = *(const LAS bf16x8*)(lds + PG8_SB(b, h) + boff + n * 2048 + k * 1024); } while (0)
#define PG8_MMA(ai, bj, At, Bt) do { __builtin_amdgcn_s_setprio(1); _Pragma("unroll") for (int m = 0; m < 4; ++m) _Pragma("unroll") for (int n = 0; n < 2; ++n) _Pragma("unroll") for (int k = 0; k < 2; ++k) \
        acc[ai][bj][m][n] = mma1<I8>(Bt[n][k], At[m][k], acc[ai][bj][m][n]); __builtin_amdgcn_s_setprio(0); } while (0)
#define PG8_WAIT_V(n) asm volatile("s_waitcnt vmcnt(" #n ")" ::: "memory")
#define PG8_WAIT_L(n) asm volatile("s_waitcnt lgkmcnt(" #n ")" ::: "memory")
#define PG8_BAR __builtin_amdgcn_s_barrier()
#define PG8_SCHED __builtin_amdgcn_sched_barrier(0)
    Unit cur, nxt; int ui = 0;
    if (!S.next(0, cur)) return;
    acc_t acc[2][2][4][2];
#pragma unroll
    for (int a = 0; a < 2; ++a)
#pragma unroll
        for (int b = 0; b < 2; ++b)
#pragma unroll
            for (int m = 0; m < 4; ++m)
#pragma unroll
                for (int n = 0; n < 2; ++n) acc[a][b][m][n] = (acc_t){0, 0, 0, 0};
    bf16x8 At[4][2], B0[2][2], B1[2][2];
    PG8_STAGE(PG8_SB(0, 0), cur.B0, voffB); PG8_STAGE(PG8_SB(0, 1), cur.B1, voffB); PG8_STAGE(PG8_SA(0, 0), cur.A0, voffA); PG8_STAGE(PG8_SA(0, 1), cur.A1, voffA);
    if (wr == 1) PG8_BAR;
    PG8_WAIT_V(2); PG8_BAR;
    PG8_STAGE(PG8_SB(1, 0), cur.B0 + kstep, voffB); PG8_STAGE(PG8_SA(1, 0), cur.A0 + kstep, voffA); PG8_STAGE(PG8_SB(1, 1), cur.B1 + kstep, voffB);
    PG8_WAIT_V(6); PG8_BAR;
    for (;;) {
        const bool has_next = S.next(ui + 1, nxt);
        const char* nA0 = has_next ? nxt.A0 : cur.A0; const char* nA1 = has_next ? nxt.A1 : cur.A1;
        const char* nB0 = has_next ? nxt.B0 : cur.B0; const char* nB1 = has_next ? nxt.B1 : cur.B1;
        for (int t = 0; t < nt; t += 2) {
            const bool last = (t == nt - 2);
            const char* a1_1 = cur.A1 + (size_t)(t + 1) * kstep;
            const char* a2_0 = last ? nA0 : cur.A0 + (size_t)(t + 2) * kstep; const char* a2_1 = last ? nA1 : cur.A1 + (size_t)(t + 2) * kstep;
            const char* b2_0 = last ? nB0 : cur.B0 + (size_t)(t + 2) * kstep; const char* b2_1 = last ? nB1 : cur.B1 + (size_t)(t + 2) * kstep;
            const char* a3_0 = a2_0 + kstep; const char* b3_0 = b2_0 + kstep; const char* b3_1 = b2_1 + kstep;
            PG8_LDB(B0, 0, 0); PG8_LDB(B1, 0, 1); PG8_SCHED; PG8_LDA(At, 0, 0); PG8_STAGE(PG8_SA(1, 1), a1_1, voffA);
            PG8_WAIT_V(8); PG8_WAIT_L(0); PG8_BAR; PG8_MMA(0, 0, At, B0); PG8_MMA(0, 1, At, B1); PG8_BAR; PG8_SCHED;
            PG8_LDA(At, 0, 1); PG8_STAGE(PG8_SB(0, 0), b2_0, voffB); PG8_STAGE(PG8_SB(0, 1), b2_1, voffB); PG8_STAGE(PG8_SA(0, 0), a2_0, voffA);
            PG8_WAIT_V(8); PG8_WAIT_L(0); PG8_BAR; PG8_MMA(1, 0, At, B0); PG8_MMA(1, 1, At, B1); PG8_BAR; PG8_SCHED;
            PG8_LDB(B0, 1, 0); PG8_LDB(B1, 1, 1); PG8_SCHED; PG8_LDA(At, 1, 0); PG8_STAGE(PG8_SA(0, 1), a2_1, voffA);
            PG8_WAIT_V(8); PG8_WAIT_L(0); PG8_BAR; PG8_MMA(0, 0, At, B0); PG8_MMA(0, 1, At, B1); PG8_BAR; PG8_SCHED;
            PG8_LDA(At, 1, 1); PG8_STAGE(PG8_SB(1, 0), b3_0, voffB); PG8_STAGE(PG8_SB(1, 1), b3_1, voffB); PG8_STAGE(PG8_SA(1, 0), a3_0, voffA);
            PG8_WAIT_V(8); PG8_WAIT_L(0); PG8_BAR; PG8_MMA(1, 0, At, B0); PG8_MMA(1, 1, At, B1); PG8_BAR; PG8_SCHED;
        }
        if (wr == 0) PG8_BAR;
        E(acc, cur, wr, wc, fr, fq);
        if (!has_next) break;
#pragma unroll
        for (int a = 0; a < 2; ++a)
#pragma unroll
            for (int b = 0; b < 2; ++b)
#pragma unroll
                for (int m = 0; m < 4; ++m)
#pragma unroll
                    for (int n = 0; n < 2; ++n) acc[a][b][m][n] = (acc_t){0, 0, 0, 0};
        cur = nxt; ++ui;
        if (wr == 1) PG8_BAR;
    }
    PG8_WAIT_V(0);
    PG8_BAR;
#undef PG8_SA
#undef PG8_SB
#undef PG8_STAGE
#undef PG8_LDA
#undef PG8_LDB
#undef PG8_MMA
#undef PG8_WAIT_V
#undef PG8_WAIT_L
#undef PG8_BAR
#undef PG8_SCHED
}

template <int RP  >
struct DenseOrder {
    const char* A; const char* Bt; int nM, nN, nwg, c;
    __device__ __forceinline__ void init(const void* A_, const void* Bt_, int M, int N, int c_) { A = (const char*)A_; Bt = (const char*)Bt_; nM = M / BM; nN = N / BM; nwg = nM * nN; c = c_; }
    __device__ __forceinline__ bool next(int i, Unit& u) const {
        const int L = i * 256 + c; if (L >= nwg) return false;
        int wgid = L; { const int q = nwg / 8, r = nwg % 8, xcd = wgid % 8, off = wgid / 8; wgid = (xcd < r ? xcd * (q + 1) : r * (q + 1) + (xcd - r) * q) + off; }
        const int nig = 8 * nN, gid = wgid / nig, fm = gid * 8, gsz = (nM - fm) < 8 ? (nM - fm) : 8;
        const int pm = fm + ((wgid % nig) % gsz), pn = (wgid % nig) / gsz;
        u.A0 = A + (size_t)pm * (BM * RP); u.A1 = u.A0 + (size_t)HALF * RP; u.B0 = Bt + (size_t)pn * (BM * RP); u.B1 = u.B0 + (size_t)HALF * RP;
        u.r0 = pm * BM; u.c0 = pn * BM; u.aux = pn; return true;
    }
};
template <int NPN, bool GU, int RP  >
struct MoeOrder {
    const char* A; const char* W; const int* blke; int nrb, vcu;
    __device__ __forceinline__ bool next(int i, Unit& u) const {
        const int L = i * 256 + vcu; const int rb = L / NPN, pn = L % NPN; if (rb >= nrb) return false;
        const int e = __builtin_amdgcn_readfirstlane(__hip_atomic_load(blke + rb, RLX_AGENT));
        u.A0 = A + (size_t)rb * (BM * RP); u.A1 = u.A0 + (size_t)HALF * RP;
        if (GU) { u.B0 = W + (size_t)e * (2048 * RP) + (size_t)pn * (HALF * RP); u.B1 = u.B0 + (size_t)1024 * RP; u.c0 = pn * HALF; }
        else    { u.B0 = W + (size_t)e * (1024 * RP) + (size_t)pn * (BM * RP); u.B1 = u.B0 + (size_t)HALF * RP; u.c0 = pn * BM; }
        u.r0 = rb * BM; u.aux = e; return true;
    }
};

template <bool I8> struct AccCvt;
template <> struct AccCvt<false> { static __device__ __forceinline__ f32x4 f(const f32x4& a, float, const f32x4&) { return a; } };
template <> struct AccCvt<true> { static __device__ __forceinline__ f32x4 f(const i32x4& a, float sr, const f32x4& sc) { return (f32x4){(float)a[0] * (sr * sc[0]), (float)a[1] * (sr * sc[1]), (float)a[2] * (sr * sc[2]), (float)a[3] * (sr * sc[3])}; } };
#define EPI_ROWS_BEGIN _Pragma("unroll") for (int ai = 0; ai < 2; ++ai) _Pragma("unroll") for (int m = 0; m < 4; ++m) { const int row = u.r0 + ai * HALF + wr * 64 + m * 16 + fr;
#define EPI_ROWS_END }
template <bool I8_>
struct EpiBf16 {
    static constexpr bool PERM = true, I8 = I8_;
    bf16* O; int ldc; const float* sa; const float* sb;
    __device__ __forceinline__ void operator()(const typename AccT<I8_>::T (&acc)[2][2][4][2], const Unit& u, int wr, int wc, int fr, int fq) const {
        const int col0 = u.c0 + wc * 32 + 8 * fq;
        f32x4 scv[2][2];
#pragma unroll
        for (int bj = 0; bj < 2; ++bj)
#pragma unroll
            for (int n = 0; n < 2; ++n) scv[bj][n] = I8_ ? *(const f32x4*)(sb + col0 + bj * HALF + 4 * n) : (f32x4){1.f, 1.f, 1.f, 1.f};
        EPI_ROWS_BEGIN bf16* rowp = O + (size_t)row * ldc + col0; const float sr = I8_ ? sa[row] : 1.f;
#pragma unroll
            for (int bj = 0; bj < 2; ++bj) { const f32x4 v0 = AccCvt<I8_>::f(acc[ai][bj][m][0], sr, scv[bj][0]), v1 = AccCvt<I8_>::f(acc[ai][bj][m][1], sr, scv[bj][1]); u32x4 w; w.x = pk2(v0[0], v0[1]); w.y = pk2(v0[2], v0[3]); w.z = pk2(v1[0], v1[1]); w.w = pk2(v1[2], v1[3]);
                *(u32x4*)(rowp + bj * HALF) = w; }
        EPI_ROWS_END
    }
};
template <bool I8_>
struct EpiRecIn {
    static constexpr bool PERM = true, I8 = I8_;
    bf16* O; float* FFo; const float* lb; const float* rope; const float* sa; const float* sb;
    __device__ __forceinline__ void operator()(const typename AccT<I8_>::T (&acc)[2][2][4][2], const Unit& u, int wr, int wc, int fr, int fq) const {
        const int pn = u.aux; const int col0 = u.c0 + wc * 32 + 8 * fq;
        f32x4 scv[2][2];
#pragma unroll
        for (int bj = 0; bj < 2; ++bj)
#pragma unroll
            for (int n = 0; n < 2; ++n) scv[bj][n] = I8_ ? *(const f32x4*)(sb + col0 + bj * HALF + 4 * n) : (f32x4){1.f, 1.f, 1.f, 1.f};
        if (pn >= 2 && pn < 6) {
            f32x4 lbv[2][2];
#pragma unroll
            for (int bj = 0; bj < 2; ++bj)
#pragma unroll
                for (int n = 0; n < 2; ++n) lbv[bj][n] = *(const f32x4*)(lb + col0 - 512 + bj * HALF + 4 * n);
            EPI_ROWS_BEGIN float* rowp = FFo + (size_t)row * 1024 + (col0 - 512); const float sr = I8_ ? sa[row] : 1.f;
#pragma unroll
                for (int bj = 0; bj < 2; ++bj)
#pragma unroll
                    for (int n = 0; n < 2; ++n) { const f32x4 z = AccCvt<I8_>::f(acc[ai][bj][m][n], sr, scv[bj][n]); f32x4 o;
#pragma unroll
                        for (int j = 0; j < 4; ++j) o[j] = lbv[bj][n][j] + (1.0f - lbv[bj][n][j]) * fsigmoid(z[j]);
                        *(f32x4*)(rowp + bj * HALF + 4 * n) = o; }
            EPI_ROWS_END
            return;
        }
        const int mode = (pn < 2) ? 1 : (pn == 8 || pn == 9 || pn >= 14) ? 2 : (pn == 10) ? 3 : (pn == 11) ? 4 : 0;
        EPI_ROWS_BEGIN bf16* rowp = O + (size_t)row * REC_IN + col0; const float sr = I8_ ? sa[row] : 1.f;
#pragma unroll
            for (int bj = 0; bj < 2; ++bj) { f32x4 v[2] = {AccCvt<I8_>::f(acc[ai][bj][m][0], sr, scv[bj][0]), AccCvt<I8_>::f(acc[ai][bj][m][1], sr, scv[bj][1])};
                if (mode == 1) {
#pragma unroll
                    for (int n = 0; n < 2; ++n)
#pragma unroll
                        for (int j = 0; j < 4; ++j) v[n][j] = fsilu(v[n][j]) * 0.08838834764831845f;
                } else if (mode == 2) {
#pragma unroll
                    for (int n = 0; n < 2; ++n)
#pragma unroll
                        for (int j = 0; j < 4; ++j) v[n][j] = fsilu(v[n][j]);
                } else if (mode >= 3) {
                    const float sc = (mode == 4) ? 0.125f : 1.0f;
                    if (row < NLAT) { const int t = row & 2047; const int p0 = ((col0 + bj * HALF) & 63) >> 1;
                        const f32x4 cs0 = *(const f32x4*)(rope + ((size_t)t * 32 + p0) * 2), cs1 = *(const f32x4*)(rope + ((size_t)t * 32 + p0 + 2) * 2);
                        f32x4 a = v[0], b = v[1];
                        v[0][0] = (a[0] * cs0[0] - a[1] * cs0[1]) * sc; v[0][1] = (a[0] * cs0[1] + a[1] * cs0[0]) * sc;
                        v[0][2] = (a[2] * cs0[2] - a[3] * cs0[3]) * sc; v[0][3] = (a[2] * cs0[3] + a[3] * cs0[2]) * sc;
                        v[1][0] = (b[0] * cs1[0] - b[1] * cs1[1]) * sc; v[1][1] = (b[0] * cs1[1] + b[1] * cs1[0]) * sc;
                        v[1][2] = (b[2] * cs1[2] - b[3] * cs1[3]) * sc; v[1][3] = (b[2] * cs1[3] + b[3] * cs1[2]) * sc;
                    } else { v[0] = v[0] * sc; v[1] = v[1] * sc; }
                }
                u32x4 w; w.x = pk2(v[0][0], v[0][1]); w.y = pk2(v[0][2], v[0][3]); w.z = pk2(v[1][0], v[1][1]); w.w = pk2(v[1][2], v[1][3]);
                *(u32x4*)(rowp + bj * HALF) = w; }
        EPI_ROWS_END
    }
};
template <bool I8_>
struct EpiResidual {
    static constexpr bool PERM = false, I8 = I8_;
    const float* baseLat; const float* baseCtx; float* out; const float* gate; const float* sa; const float* sb;
    __device__ __forceinline__ void operator()(const typename AccT<I8_>::T (&acc)[2][2][4][2], const Unit& u, int wr, int wc, int fr, int fq) const {
        const int col0 = u.c0 + wc * 32 + 4 * fq; const float* g = gate + (size_t)mod_row(u.r0) * 6144 + col0;
        f32x4 gv[2][2];
#pragma unroll
        for (int bj = 0; bj < 2; ++bj)
#pragma unroll
            for (int n = 0; n < 2; ++n) { gv[bj][n] = *(const f32x4*)(g + bj * HALF + n * 16); if (I8_) gv[bj][n] = gv[bj][n] * *(const f32x4*)(sb + col0 + bj * HALF + n * 16); }
        EPI_ROWS_BEGIN const float* bp = (row < NLAT ? baseLat + (size_t)row * 1024 : baseCtx + (size_t)(row - NLAT) * 1024) + col0; float* op = out + (size_t)row * 1024 + col0; const float sr = I8_ ? sa[row] : 1.f;
#pragma unroll
            for (int bj = 0; bj < 2; ++bj)
#pragma unroll
                for (int n = 0; n < 2; ++n) *(f32x4*)(op + bj * HALF + n * 16) = *(const f32x4*)(bp + bj * HALF + n * 16) + gv[bj][n] * AccCvt<I8_>::f(acc[ai][bj][m][n], sr, (f32x4){1.f, 1.f, 1.f, 1.f});
        EPI_ROWS_END
    }
};
struct EpiSwiglu {
    static constexpr bool PERM = true, I8 = false;
    bf16* O; const float* bgu;
    __device__ __forceinline__ void operator()(const f32x4 (&acc)[2][2][4][2], const Unit& u, int wr, int wc, int fr, int fq) const {
        const int col0 = u.c0 + wc * 32 + 8 * fq; const float* bb = bgu + (size_t)u.aux * 2048 + col0;
        f32x4 bg[2], bu[2];
#pragma unroll
        for (int n = 0; n < 2; ++n) { bg[n] = *(const f32x4*)(bb + 4 * n); bu[n] = *(const f32x4*)(bb + 1024 + 4 * n); }
        EPI_ROWS_BEGIN f32x4 h[2];
#pragma unroll
            for (int n = 0; n < 2; ++n)
#pragma unroll
                for (int j = 0; j < 4; ++j) { const float g = fminf(acc[ai][0][m][n][j] + bg[n][j], 7.0f); const float up = fminf(fmaxf(acc[ai][1][m][n][j] + bu[n][j], -7.0f), 7.0f);
                    h[n][j] = (up + 1.0f) * g * fsigmoid(1.702f * g); }
            u32x4 w; w.x = pk2(h[0][0], h[0][1]); w.y = pk2(h[0][2], h[0][3]); w.z = pk2(h[1][0], h[1][1]); w.w = pk2(h[1][2], h[1][3]);
            *(u32x4*)(O + (size_t)row * 1024 + col0) = w;
        EPI_ROWS_END
    }
};
struct EpiSwigluI8 {
    static constexpr bool PERM = true, I8 = true;
    bf16* O; const float* bgu; const float* sa; const float* sb;
    __device__ __forceinline__ void operator()(const i32x4 (&acc)[2][2][4][2], const Unit& u, int wr, int wc, int fr, int fq) const {
        const int col0 = u.c0 + wc * 32 + 8 * fq; const float* bb = bgu + (size_t)u.aux * 2048 + col0; const float* ss = sb + (size_t)u.aux * 2048 + col0;
        f32x4 bg[2], bu[2], sg[2], su[2];
#pragma unroll
        for (int n = 0; n < 2; ++n) { bg[n] = *(const f32x4*)(bb + 4 * n); bu[n] = *(const f32x4*)(bb + 1024 + 4 * n); sg[n] = *(const f32x4*)(ss + 4 * n); su[n] = *(const f32x4*)(ss + 1024 + 4 * n); }
        EPI_ROWS_BEGIN const float sr = sa[row]; f32x4 h[2];
#pragma unroll
            for (int n = 0; n < 2; ++n)
#pragma unroll
                for (int j = 0; j < 4; ++j) { const float g = fminf((float)acc[ai][0][m][n][j] * (sr * sg[n][j]) + bg[n][j], 7.0f); const float up = fminf(fmaxf((float)acc[ai][1][m][n][j] * (sr * su[n][j]) + bu[n][j], -7.0f), 7.0f);
                    h[n][j] = (up + 1.0f) * g * fsigmoid(1.702f * g); }
            u32x4 w; w.x = pk2(h[0][0], h[0][1]); w.y = pk2(h[0][2], h[0][3]); w.z = pk2(h[1][0], h[1][1]); w.w = pk2(h[1][2], h[1][3]);
            *(u32x4*)(O + (size_t)row * 1024 + col0) = w;
        EPI_ROWS_END
    }
};
struct EpiMoeOut {
    static constexpr bool PERM = true, I8 = false;
    bf16* YS; const float* bdn; const int* rtok; const float* rgate;
    __device__ __forceinline__ void operator()(const f32x4 (&acc)[2][2][4][2], const Unit& u, int wr, int wc, int fr, int fq) const {
        const int col0 = u.c0 + wc * 32 + 8 * fq; const float* bb = bdn + (size_t)u.aux * 1024 + col0;
        f32x4 bv[2][2];
#pragma unroll
        for (int bj = 0; bj < 2; ++bj)
#pragma unroll
            for (int n = 0; n < 2; ++n) bv[bj][n] = *(const f32x4*)(bb + bj * HALF + 4 * n);
        EPI_ROWS_BEGIN const int tk = rtok[row]; const float gt = rgate[row];
            if (tk >= 0) { bf16* rowp = YS + (size_t)tk * 1024 + col0;
#pragma unroll
                for (int bj = 0; bj < 2; ++bj) { const f32x4 v0 = (acc[ai][bj][m][0] + bv[bj][0]) * gt, v1 = (acc[ai][bj][m][1] + bv[bj][1]) * gt;
                    u32x4 w; w.x = pk2(v0[0], v0[1]); w.y = pk2(v0[2], v0[3]); w.z = pk2(v1[0], v1[1]); w.w = pk2(v1[2], v1[3]); *(u32x4*)(rowp + bj * HALF) = w; } }
        EPI_ROWS_END
    }
};
}
namespace rec {
template <int DK> struct LL {
    static constexpr int SD = (DK + 8) * 2;
    static constexpr int QIN = 0, KIN = QIN + 64 * SD, ST = KIN + 64 * SD, KSTT = ST + 64 * SD, VT = KSTT + DK * 144, ATT = VT + 64 * 144, TOT = ATT + 64 * 144, DEC = TOT + 8 * 128 * 4, END = DEC + 128 * 4;
};
template <bool RET>
__device__ __forceinline__ void rec_unit(const Params& P, Frame& F, int b, int head, int dir, int vh) {
    constexpr int DK = RET ? 64 : 128, NT_ = RET ? 4 : 8, NVT = RET ? 2 : 4, KS = DK / 32;
    typedef LL<DK> L; constexpr int SD = L::SD;
    LAS unsigned char* lds = F.lds;
    const bf16* PROJ = WSP(bf16, WS_PROJ); const float* FFp = WSP(float, WS_FF); bf16* OR = WSP(bf16, WS_OREC) + (size_t)dir * NTOK * 1024;
    const int qcol = RET ? 2560 + head * 64 : head * 128, kcol = 2816 + head * 64, fcol = dir * 512 + head * 128;
    const int vcol = (RET ? 3072 : 1536) + head * 128 + vh * 64, ocol = (RET ? 512 : 0) + head * 128 + vh * 64;
    const float lg = RET ? __logf(1.0f - exp2f(-5.0f - (float)(dir ? 3 - head : head))) : 0.f;
    const int dp = RET ? (F.tid & 31) : F.lane, tg = RET ? (F.tid >> 5) : F.wave;
    const int vs = F.tid >> 3, vc = (F.tid & 7) * 8;
    const int fr = F.lane & 15, fq = F.lane >> 4;
    const int sdt = RET ? (F.wave >> 1) : F.wave, svt0 = RET ? 2 * (F.wave & 1) : 0;
    f32x4 sacc[NVT];
#pragma unroll
    for (int i = 0; i < NVT; ++i) sacc[i] = (f32x4){0.f, 0.f, 0.f, 0.f};
    for (int idx = F.tid; idx < 64 * SD / 4; idx += NTHR) ((LAS unsigned*)(lds + L::ST))[idx] = 0u;
    if (RET && F.tid < 64) ((LAS float*)(lds + L::DEC))[F.tid] = __expf(64.0f * lg);
    f32x2 fv[NT_]; unsigned qv[NT_], kv[NT_]; u32x4 vv;
#define REC_BASE(n) ((n) < 4 ? NLAT + b * 256 + (dir ? 3 - (n) : (n)) * 64 : b * 2048 + (dir ? 35 - (n) : (n) - 4) * 64)
#define REC_ROW(base, j) ((base) + (dir ? 63 - (j) : (j)))
#define REC_LOAD(n) do { const int _bs = REC_BASE(n); _Pragma("unroll") for (int i = 0; i < NT_; ++i) { const size_t _r = (size_t)REC_ROW(_bs, NT_ * tg + i); \
        qv[i] = *(const unsigned*)(PROJ + _r * REC_IN + qcol + 2 * dp); \
        if (RET) kv[i] = *(const unsigned*)(PROJ + _r * REC_IN + kcol + 2 * dp); else fv[i] = *(const f32x2*)(FFp + _r * 1024 + fcol + 2 * dp); } \
        vv = *(const u32x4*)(PROJ + (size_t)REC_ROW(_bs, vs) * REC_IN + vcol + vc); } while (0)
    REC_LOAD(0);
    for (int n = 0; n < 36; ++n) {
        const int base = REC_BASE(n);
        float kst0[NT_], kst1[NT_];
        if (!RET) {
            f32x2 cs[NT_]; f32x2 run = {0.f, 0.f};
#pragma unroll
            for (int i = 0; i < NT_; ++i) { run.x += __logf(fv[i].x); run.y += __logf(fv[i].y); cs[i] = run; }
            *(LAS f32x2*)(lds + L::TOT + (tg * 128 + 2 * dp) * 4) = run;
            __syncthreads();
            f32x2 pre = {0.f, 0.f}, all = {0.f, 0.f};
#pragma unroll
            for (int g = 0; g < 8; ++g) { const f32x2 t = *(const LAS f32x2*)(lds + L::TOT + (g * 128 + 2 * dp) * 4); all += t; if (g < tg) pre += t; }
#pragma unroll
            for (int i = 0; i < NT_; ++i) { const int j = NT_ * tg + i; const float bx = pre.x + cs[i].x, by = pre.y + cs[i].y;
                const float q0 = bflo(qv[i]), q1 = bfhi(qv[i]), k0 = 1.0f - fv[i].x, k1 = 1.0f - fv[i].y;
                *(LAS unsigned*)(lds + L::QIN + j * SD + 4 * dp) = pk2(q0 * __expf(bx), q1 * __expf(by));
                *(LAS unsigned*)(lds + L::KIN + j * SD + 4 * dp) = pk2(k0 * __expf(fminf(-bx, 80.f)), k1 * __expf(fminf(-by, 80.f)));
                kst0[i] = k0 * __expf(all.x - bx); kst1[i] = k1 * __expf(all.y - by); }
            if (tg == 0) *(LAS f32x2*)(lds + L::DEC + 8 * dp) = (f32x2){__expf(all.x), __expf(all.y)};
            u32x4 w0, w1; w0.x = pk2(kst0[0], kst0[1]); w0.y = pk2(kst0[2], kst0[3]); w0.z = pk2(kst0[4], kst0[5]); w0.w = pk2(kst0[6], kst0[7]);
            w1.x = pk2(kst1[0], kst1[1]); w1.y = pk2(kst1[2], kst1[3]); w1.z = pk2(kst1[4], kst1[5]); w1.w = pk2(kst1[6], kst1[7]);
            *(LAS u32x4*)(lds + L::KSTT + (2 * dp) * 144 + tg * 16) = w0; *(LAS u32x4*)(lds + L::KSTT + (2 * dp + 1) * 144 + tg * 16) = w1;
        } else {
#pragma unroll
            for (int i = 0; i < NT_; ++i) { const int j = NT_ * tg + i; const float eb = __expf((float)(j + 1) * lg), enb = __expf(-(float)(j + 1) * lg), est = __expf((float)(63 - j) * lg);
                const float q0 = bflo(qv[i]), q1 = bfhi(qv[i]), k0 = bflo(kv[i]), k1 = bfhi(kv[i]);
                *(LAS unsigned*)(lds + L::QIN + j * SD + 4 * dp) = pk2(q0 * eb, q1 * eb);
                *(LAS unsigned*)(lds + L::KIN + j * SD + 4 * dp) = pk2(k0 * enb, k1 * enb);
                kst0[i] = k0 * est; kst1[i] = k1 * est; }
            u32x2 w0, w1; w0.x = pk2(kst0[0], kst0[1]); w0.y = pk2(kst0[2], kst0[3]); w1.x = pk2(kst1[0], kst1[1]); w1.y = pk2(kst1[2], kst1[3]);
            *(LAS u32x2*)(lds + L::KSTT + (2 * dp) * 144 + tg * 8) = w0; *(LAS u32x2*)(lds + L::KSTT + (2 * dp + 1) * 144 + tg * 8) = w1;
        }
#pragma unroll
        for (int i = 0; i < 8; ++i) *(LAS bf16*)(lds + L::VT + (vc + i) * 144 + vs * 2) = (bf16)(vv[i >> 1] >> (16 * (i & 1)));
        if (n + 1 < 36) REC_LOAD(n + 1);
        __syncthreads();
        {
            const int ti = F.wave >> 1;
#pragma unroll
            for (int q = 0; q < 2; ++q) { const int si = 2 * (F.wave & 1) + q; f32x4 a4 = {0.f, 0.f, 0.f, 0.f};
                if (si <= ti) {
#pragma unroll
                    for (int kk = 0; kk < KS; ++kk) { const bf16x8 a = *(const LAS bf16x8*)(lds + L::KIN + (si * 16 + fr) * SD + (kk * 32 + fq * 8) * 2);
                        const bf16x8 bb = *(const LAS bf16x8*)(lds + L::QIN + (ti * 16 + fr) * SD + (kk * 32 + fq * 8) * 2);
                        a4 = __builtin_amdgcn_mfma_f32_16x16x32_bf16(a, bb, a4, 0, 0, 0); }
                }
                const int t = ti * 16 + fr, s0 = si * 16 + 4 * fq;
#pragma unroll
                for (int j = 0; j < 4; ++j) if (s0 + j > t) a4[j] = 0.f;
                u32x2 w; w.x = pk2(a4[0], a4[1]); w.y = pk2(a4[2], a4[3]);
                *(LAS u32x2*)(lds + L::ATT + t * 144 + s0 * 2) = w; }
        }
        __syncthreads();
        {
            const int ti = F.wave >> 1; const int t = ti * 16 + fr; bf16* orow = OR + (size_t)REC_ROW(base, t) * 1024 + ocol;
#pragma unroll
            for (int q = 0; q < 2; ++q) { const int vi = 2 * (F.wave & 1) + q; f32x4 a4 = {0.f, 0.f, 0.f, 0.f};
#pragma unroll
                for (int kk = 0; kk < 2; ++kk) { const bf16x8 a = *(const LAS bf16x8*)(lds + L::VT + (vi * 16 + fr) * 144 + (kk * 32 + fq * 8) * 2);
                    const bf16x8 bb = *(const LAS bf16x8*)(lds + L::ATT + t * 144 + (kk * 32 + fq * 8) * 2);
                    a4 = __builtin_amdgcn_mfma_f32_16x16x32_bf16(a, bb, a4, 0, 0, 0); }
#pragma unroll
                for (int kk = 0; kk < KS; ++kk) { const bf16x8 a = *(const LAS bf16x8*)(lds + L::ST + (vi * 16 + fr) * SD + (kk * 32 + fq * 8) * 2);
                    const bf16x8 bb = *(const LAS bf16x8*)(lds + L::QIN + t * SD + (kk * 32 + fq * 8) * 2);
                    a4 = __builtin_amdgcn_mfma_f32_16x16x32_bf16(a, bb, a4, 0, 0, 0); }
                u32x2 w; w.x = pk2(a4[0], a4[1]); w.y = pk2(a4[2], a4[3]);
                *(u32x2*)(orow + vi * 16 + 4 * fq) = w; }
        }
        {
            const f32x4 dec4 = *(const LAS f32x4*)(lds + L::DEC + (sdt * 16 + 4 * fq) * 4);
#pragma unroll
            for (int vt = 0; vt < NVT; ++vt) { f32x4 a4 = sacc[vt] * dec4;
#pragma unroll
                for (int kk = 0; kk < 2; ++kk) { const bf16x8 a = *(const LAS bf16x8*)(lds + L::KSTT + (sdt * 16 + fr) * 144 + (kk * 32 + fq * 8) * 2);
                    const bf16x8 bb = *(const LAS bf16x8*)(lds + L::VT + ((svt0 + vt) * 16 + fr) * 144 + (kk * 32 + fq * 8) * 2);
                    a4 = __builtin_amdgcn_mfma_f32_16x16x32_bf16(a, bb, a4, 0, 0, 0); }
                sacc[vt] = a4; }
        }
        __syncthreads();
#pragma unroll
        for (int vt = 0; vt < NVT; ++vt) { u32x2 w; w.x = pk2(sacc[vt][0], sacc[vt][1]); w.y = pk2(sacc[vt][2], sacc[vt][3]);
            *(LAS u32x2*)(lds + L::ST + ((svt0 + vt) * 16 + fr) * SD + (sdt * 16 + 4 * fq) * 2) = w; }
    }
#undef REC_BASE
#undef REC_ROW
#undef REC_LOAD
    __syncthreads();
}
}
__device__ __forceinline__ void phase_rec(const Params& P, Frame& F) {
    const int u = F.bid; const int vh = u & 1, dir = (u >> 1) & 1, head = (u >> 2) & 3, type = (u >> 4) & 1, b = u >> 5;
    if (type) rec::rec_unit<true>(P, F, b, head, dir, vh); else rec::rec_unit<false>(P, F, b, head, dir, vh);
}
__device__ __forceinline__ void phase_merge(const Params& P, Frame& F) {
    const int gw = F.vcu * NWAVES + F.wave, NGW = 256 * NWAVES; const int c0 = 16 * F.lane; const bool isret = F.lane >= 32;
    const float* gain = (isret ? P.in[I_RET_GAIN] : P.in[I_HG_GAIN]) + (c0 & 127);
    float gn[16];
#pragma unroll
    for (int i = 0; i < 16; ++i) gn[i] = gain[i];
    for (int r = gw; r < NTOK; r += NGW) {
        const bf16* o0 = WSP(bf16, WS_OREC) + (size_t)r * 1024 + c0; const bf16* o1 = o0 + (size_t)NTOK * 1024;
        const bf16* gp = WSP(bf16, WS_PROJ) + (size_t)r * REC_IN + c0 + (isret ? 3072 : 2048);
        u32x4 a[2] = {*(const u32x4*)o0, *(const u32x4*)(o0 + 8)}, bq[2] = {*(const u32x4*)o1, *(const u32x4*)(o1 + 8)}, g[2] = {*(const u32x4*)gp, *(const u32x4*)(gp + 8)};
        float o[16], gt[16]; float s1 = 0.f;
#pragma unroll
        for (int i = 0; i < 8; ++i) { const unsigned wa = a[i >> 2][i & 3], wb = bq[i >> 2][i & 3], wg = g[i >> 2][i & 3];
            o[2 * i] = bflo(wa) + bflo(wb); o[2 * i + 1] = bfhi(wa) + bfhi(wb); gt[2 * i] = bflo(wg); gt[2 * i + 1] = bfhi(wg); s1 += o[2 * i] + o[2 * i + 1]; }
        s1 += __shfl_xor(s1, 1); s1 += __shfl_xor(s1, 2); s1 += __shfl_xor(s1, 4);
        const float mean = isret ? s1 * (1.0f / 128.0f) : 0.f; float s2 = 0.f;
#pragma unroll
        for (int i = 0; i < 16; ++i) { o[i] -= mean; s2 += o[i] * o[i]; }
        s2 += __shfl_xor(s2, 1); s2 += __shfl_xor(s2, 2); s2 += __shfl_xor(s2, 4);
        const float rstd = rsqrtf(s2 * (1.0f / 128.0f) + NORM_EPS);
        float amax = 0.f;
#pragma unroll
        for (int i = 0; i < 16; ++i) { o[i] = o[i] * rstd * gn[i] * gt[i]; amax = fmaxf(amax, fabsf(o[i])); }
        amax = wave_max(amax); const float qs = amax > 0.f ? amax * (1.0f / 127.0f) : 1.0f, qi = 1.0f / qs;
        if (F.lane == 0) WSP(float, WS_ASC)[r] = qs;
        u32x4 w;
#pragma unroll
        for (int i = 0; i < 4; ++i) w[i] = q8pack(o[4 * i], o[4 * i + 1], o[4 * i + 2], o[4 * i + 3], qi);
        *(u32x4*)(WSP(signed char, WS_A8) + (size_t)r * 1024 + c0) = w;
    }
}
template <int NROWS, int LAYER>
__device__ __forceinline__ void phase_route(const Params& P, Frame& F, const float* H) {
    constexpr int RPB = NROWS / 256, RPW = RPB / 8;
    LAS float* tile = (LAS float*)(F.lds + F.wave * 16384);
    LAS int* hist = (LAS int*)(F.lds + 131072);
    if (F.tid < 32) hist[F.tid] = 0;
    __syncthreads();
    const float* mod = WSP(float, WS_MOD); const float* wr = P.in[I_W_ROUTER] + (size_t)LAYER * 1024 * 32; const float* br = P.in[I_B_ROUTER] + LAYER * 32;
    const float* gain = P.in[I_NORM_FFN] + LAYER * 1024;
    int* tope = WSP(int, WS_TOPE); float* topg = WSP(float, WS_TOPG); int* rank = WSP(int, WS_RANK);
    const int e = F.lane & 31, kh = F.lane >> 5;
    const float bias = br[e];
    const int row_w0 = F.bid * RPB + F.wave * RPW;
    for (int g0 = 0; g0 < RPW; g0 += 4) {
        const int nr = (RPW - g0) < 4 ? (RPW - g0) : 4;
        for (int rr = 0; rr < nr; ++rr) {
            const int r = row_w0 + g0 + rr; const float* src = H + (size_t)r * 1024; f32x4 v[4];
#pragma unroll
            for (int j = 0; j < 4; ++j) v[j] = *(const f32x4*)(src + 4 * F.lane + 256 * j);
            float ss = 0.f;
#pragma unroll
            for (int j = 0; j < 4; ++j) ss += (v[j].x * v[j].x + v[j].y * v[j].y) + (v[j].z * v[j].z + v[j].w * v[j].w);
            const float rstd = rsqrtf(wave_sum(ss) * (1.0f / 1024.0f) + NORM_EPS);
            const float* m = mod + (size_t)(LAYER * 9 + mod_row(r)) * 6144;
            signed char* orow = WSP(signed char, WS_F8) + (size_t)r * 1024; float amax = 0.f;
#pragma unroll
            for (int j = 0; j < 4; ++j) { const int c = 4 * F.lane + 256 * j; const f32x4 gg = *(const f32x4*)(gain + c), s1 = *(const f32x4*)(m + 4096 + c), s0 = *(const f32x4*)(m + 3072 + c);
                const f32x4 a = v[j] * rstd * gg * (s1 + 1.0f) + s0; *(LAS f32x4*)(tile + rr * 1024 + c) = a; v[j] = a;
                amax = fmaxf(amax, fmaxf(fmaxf(fabsf(a.x), fabsf(a.y)), fmaxf(fabsf(a.z), fabsf(a.w)))); }
#pragma unroll
            for (int o = 1; o < 64; o <<= 1) amax = fmaxf(amax, __shfl_xor(amax, o));
            const float qs = amax > 0.f ? amax * (1.0f / 127.0f) : 1.0f, qi = 1.0f / qs;
            if (F.lane == 0) WSP(float, WS_FSC)[r] = qs;
#pragma unroll
            for (int j = 0; j < 4; ++j) { const int c = 4 * F.lane + 256 * j; unsigned wd = 0;
#pragma unroll
                for (int b = 0; b < 4; ++b) { int q = (int)rintf(v[j][b] * qi); q = q > 127 ? 127 : (q < -127 ? -127 : q); wd |= (unsigned)(q & 255) << (8 * b); }
                *(unsigned*)(orow + c) = wd; }
        }
        float acc[4] = {0.f, 0.f, 0.f, 0.f};
        const float* wp = wr + (size_t)(kh * 512) * 32 + e; const LAS float* tp = tile + kh * 512;
#pragma unroll 4
        for (int s = 0; s < 512; s += 4) {
            const float w0 = wp[(s + 0) * 32], w1 = wp[(s + 1) * 32], w2 = wp[(s + 2) * 32], w3 = wp[(s + 3) * 32];
#pragma unroll
            for (int rr = 0; rr < 4; ++rr) { const f32x4 fvv = *(const LAS f32x4*)(tp + rr * 1024 + s); acc[rr] += fvv.x * w0 + fvv.y * w1 + fvv.z * w2 + fvv.w * w3; }
        }
#pragma unroll
        for (int rr = 0; rr < 4; ++rr) { acc[rr] += __shfl_xor(acc[rr], 32); acc[rr] += bias; }
        for (int rr = 0; rr < nr; ++rr) {
            const int r = row_w0 + g0 + rr; float val = acc[rr]; float tv[4]; int ti[4];
#pragma unroll
            for (int k = 0; k < 4; ++k) { float mx = val;
#pragma unroll
                for (int o = 1; o < 32; o <<= 1) mx = fmaxf(mx, __shfl_xor(mx, o));
                const unsigned long long bal = __ballot(val == mx); const int idx = __ffsll((long long)bal) - 1;
                tv[k] = mx; ti[k] = idx & 31; if (e == (idx & 31)) val = -3.0e38f; }
            const float e1 = __expf(tv[1] - tv[0]), e2 = __expf(tv[2] - tv[0]), e3 = __expf(tv[3] - tv[0]); const float inv = 1.0f / (1.0f + e1 + e2 + e3);
            if (F.lane < 4) { const int k = F.lane; const int ex = k == 0 ? ti[0] : k == 1 ? ti[1] : k == 2 ? ti[2] : ti[3]; const float gv = (k == 0 ? 1.0f : k == 1 ? e1 : k == 2 ? e2 : e3) * inv;
                const int rk = atomicAdd((int*)(hist + ex), 1);
                tope[r * 4 + k] = ex; topg[r * 4 + k] = gv; rank[r * 4 + k] = rk; }
        }
    }
    __syncthreads();
    if (F.tid < 32) WSP(int, WS_BCNT)[F.bid * 32 + F.tid] = hist[F.tid];
    __syncthreads();
}
template <int NROWS>
__device__ __forceinline__ void phase_scatter(const Params& P, Frame& F) {
    constexpr int RPB = NROWS / 256;
    LAS int* part_tot = (LAS int*)F.lds;
    LAS int* part_pre = part_tot + 512;
    LAS int* baseL = part_pre + 512;
    LAS int* padS = baseL + 32;
    LAS int* totL = padS + 40;
    const int* bcnt = WSP(int, WS_BCNT);
    { const int e = F.tid & 31, part = F.tid >> 5; int t = 0, pr = 0;
        for (int bb = part * 16; bb < part * 16 + 16; ++bb) { const int c = bcnt[bb * 32 + e]; t += c; if (bb < F.bid) pr += c; }
        part_tot[part * 32 + e] = t; part_pre[part * 32 + e] = pr; }
    __syncthreads();
    if (F.tid < 32) { int t = 0, pr = 0;
        for (int p = 0; p < 16; ++p) { t += part_tot[p * 32 + F.tid]; pr += part_pre[p * 32 + F.tid]; }
        totL[F.tid] = t; baseL[F.tid] = pr; }
    __syncthreads();
    if (F.tid == 0) { int run = 0; for (int e = 0; e < 32; ++e) { padS[e] = run; run += (totL[e] + 255) & ~255; } padS[32] = run; }
    __syncthreads();
    if (F.tid < 32) baseL[F.tid] += padS[F.tid];
    __syncthreads();
    const int* tope = WSP(int, WS_TOPE); const float* topg = WSP(float, WS_TOPG); const int* rank = WSP(int, WS_RANK);
    int* rtok = WSP(int, WS_RTOK); float* rgate = WSP(float, WS_RGATE);
    for (int a = F.wave; a < RPB * 4; a += NWAVES) {
        const int r = F.bid * RPB + (a >> 2), k = a & 3; const int ex = tope[r * 4 + k]; const int dest = baseL[ex] + rank[r * 4 + k];
        const u32x4* src = (const u32x4*)(WSP(signed char, WS_F8) + (size_t)r * 1024); u32x4* dst = (u32x4*)(WSP(signed char, WS_XS) + (size_t)dest * 1024);
        dst[F.lane] = src[F.lane];
        if (F.lane == 0) { rtok[dest] = r * 4 + k; rgate[dest] = topg[r * 4 + k]; WSP(float, WS_RSC)[dest] = WSP(float, WS_FSC)[r]; }
    }
    if (F.bid < 32) { const int e = F.bid; const int s = padS[e] + totL[e], en = padS[e + 1]; for (int i = s + F.tid; i < en; i += NTHR) { rtok[i] = -1; rgate[i] = 0.f; WSP(float, WS_RSC)[i] = 0.f; } }
    if (F.bid == 32) { int* blke = WSP(int, WS_BLKE); const int nrb = padS[32] >> 8;
        for (int rb = F.tid; rb < MAXRB; rb += NTHR) { int ex = -1; if (rb < nrb) { const int row = rb << 8; ex = 0; for (int e = 1; e < 32; ++e) if (row >= padS[e]) ex = e; } blke[rb] = ex; }
        if (F.tid == 0) blke[MAXRB] = nrb; }
    __syncthreads();
}
__device__ __forceinline__ void load8(const bf16* p, float (&x)[8]) { const u32x4 w = *(const u32x4*)p;
#pragma unroll
    for (int i = 0; i < 4; ++i) { x[2 * i] = bflo(w[i]); x[2 * i + 1] = bfhi(w[i]); } }
__device__ __forceinline__ void store8(bf16* p, const float (&x)[8]) { u32x4 w;
#pragma unroll
    for (int i = 0; i < 4; ++i) w[i] = pk2(x[2 * i], x[2 * i + 1]);
    *(u32x4*)p = w; }
__device__ __forceinline__ void rope8(float (&x)[8], const float* cs  ) {
    const f32x4 c0 = *(const f32x4*)cs, c1 = *(const f32x4*)(cs + 4); float y[8];
    y[0] = x[0] * c0[0] - x[1] * c0[1]; y[1] = x[0] * c0[1] + x[1] * c0[0]; y[2] = x[2] * c0[2] - x[3] * c0[3]; y[3] = x[2] * c0[3] + x[3] * c0[2];
    y[4] = x[4] * c1[0] - x[5] * c1[1]; y[5] = x[4] * c1[1] + x[5] * c1[0]; y[6] = x[6] * c1[2] - x[7] * c1[3]; y[7] = x[6] * c1[3] + x[7] * c1[2];
#pragma unroll
    for (int i = 0; i < 8; ++i) x[i] = y[i];
}
template <int GL>
__device__ __forceinline__ void headnorm8(float (&x)[8], const float* gain8) {
    float ss = 0.f;
#pragma unroll
    for (int i = 0; i < 8; ++i) ss += x[i] * x[i];
#pragma unroll
    for (int o = 1; o < GL; o <<= 1) ss += __shfl_xor(ss, o);
    const float rstd = rsqrtf(ss * (1.0f / (8.0f * GL)) + NORM_EPS);
#pragma unroll
    for (int i = 0; i < 8; ++i) x[i] = x[i] * rstd * gain8[i];
}
__device__ __forceinline__ void phase_qkv(const Params& P, Frame& F) {
    const int gw = F.vcu * NWAVES + F.wave, NGW = 256 * NWAVES; const int l = F.lane;
    const bf16* PR = WSP(bf16, WS_PROJ); const float* r64 = WSP(float, WS_ROPE64); const float* r128 = WSP(float, WS_ROPE128);
    float gq[8], gk[8], gdq[8], gdk[8];
#pragma unroll
    for (int i = 0; i < 8; ++i) { gq[i] = P.in[I_ATT_Q_GAIN][(8 * l) % 128 + i]; gk[i] = P.in[I_ATT_K_GAIN][(8 * l) % 128 + i]; gdq[i] = P.in[I_DQ_GAIN][(8 * l) % 64 + i]; gdk[i] = P.in[I_DK_GAIN][(8 * l) % 64 + i]; }
    for (int r = gw; r < NTOK; r += NGW) {
        const bool lat = r < NLAT; const int rc = r - NLAT; const int b = lat ? (r >> 11) : (rc >> 8); const int t = r & 2047; const int pos = lat ? 256 + t : (rc & 255);
        const bf16* row = PR + (size_t)r * ATT_IN; float x[8];
        const int c128 = (8 * l) % 128, c64 = (8 * l) % 64;
        if (lat) {
            load8(row + 8 * l, x); headnorm8<16>(x, gq); rope8(x, r128 + ((size_t)t * 64 + c128 / 2) * 2);
            store8(WSP(bf16, WS_GQ) + ((size_t)(b * 4 + (l >> 4)) * 2048 + t) * 128 + c128, x);
        }
        {
            load8(row + 512 + 8 * l, x); float xn[8];
#pragma unroll
            for (int i = 0; i < 8; ++i) xn[i] = x[i];
            headnorm8<16>(xn, gk); if (lat) rope8(xn, r128 + ((size_t)t * 64 + c128 / 2) * 2);
            const int kvh = (l >> 4) & 1; const size_t off = ((size_t)(b * 2 + kvh) * 2304 + pos) * 128 + c128;
            if (l < 32) store8(WSP(bf16, WS_GK) + off, xn); else store8(WSP(bf16, WS_GV) + off, x);
        }
        if (lat) {
            load8(row + 1024 + 8 * l, x); headnorm8<8>(x, gdq); rope8(x, r64 + ((size_t)t * 32 + c64 / 2) * 2);
            store8(WSP(bf16, WS_DQ) + ((size_t)(b * 8 + (l >> 3)) * 2048 + t) * 64 + c64, x);
        }
        {
            load8(row + 1536 + 8 * l, x); headnorm8<8>(x, gdk); if (lat) rope8(x, r64 + ((size_t)t * 32 + c64 / 2) * 2);
            store8(WSP(bf16, WS_DK) + ((size_t)(b * 8 + (l >> 3)) * 2304 + pos) * 64 + c64, x);
        }
        {
            load8(row + 2048 + 8 * l, x);
            store8(WSP(bf16, WS_DV) + ((size_t)(b * 4 + (l >> 4)) * 2304 + pos) * 128 + c128, x);
        }
    }
}

namespace attn {
constexpr int DV = 128, NW = 8, QBLK = 32, KVBLK = 64, SKV = 2304;
constexpr float THR = 8.f;
constexpr int SHM_V = KVBLK * DV * 2, SHM_K = KVBLK * 128 * 2;
#define KSWZ(row, colB) ((row) * 256 + ((colB) ^ (((row) & 7) << 4)))
#define SBAR() __builtin_amdgcn_sched_barrier(0)
__device__ __forceinline__ int crow(int r, int hi) { return (r & 3) + 8 * (r >> 2) + 4 * hi; }
__device__ __forceinline__ unsigned cvtpk(float lo, float hi) { return pk2(lo, hi); }
template <int NQ> struct Cst { static constexpr float SCALE = NQ == 8 ? 0.088388347648318440f : 0.125f; };
template <int NQ>
__device__ __forceinline__ void partialSM(f32x16& p0, f32x16& p1, float& m_reg, float& mn, float& alpha) {
    constexpr float SCALE = Cst<NQ>::SCALE; constexpr float C = SCALE * 1.4426950408889634f;
    float pmax = p0[0];
#pragma unroll
    for (int r = 1; r < 16; ++r) pmax = fmaxf(pmax, p0[r]);
#pragma unroll
    for (int r = 0; r < 16; ++r) pmax = fmaxf(pmax, p1[r]);
    { auto rr = __builtin_amdgcn_permlane32_swap(__float_as_uint(pmax), __float_as_uint(pmax), false, false);
      pmax = fmaxf(__uint_as_float(rr[0]), __uint_as_float(rr[1])); }
    if (__builtin_expect(__all(pmax - m_reg <= THR / SCALE), 1)) { mn = m_reg; alpha = 1.f; }
    else { mn = fmaxf(m_reg, pmax); alpha = __builtin_amdgcn_exp2f((m_reg - mn) * C); m_reg = mn; }
    const float mnC = -mn * C;
#pragma unroll
    for (int r = 0; r < 16; ++r) p0[r] = fmaf(p0[r], C, mnC);
#pragma unroll
    for (int r = 0; r < 16; ++r) p1[r] = fmaf(p1[r], C, mnC);
#pragma unroll
    for (int r = 0; r < 16; ++r) p0[r] = __builtin_amdgcn_exp2f(p0[r]);
}
__device__ __forceinline__ void finishSM(f32x16& p0, f32x16& p1, float alpha, float& l_reg, bf16x8& pa0, bf16x8& pa1, bf16x8& pa2, bf16x8& pa3) {
#pragma unroll
    for (int r = 0; r < 16; ++r) p1[r] = __builtin_amdgcn_exp2f(p1[r]);
    float ps = 0;
#pragma unroll
    for (int r = 0; r < 16; ++r) ps += p0[r];
#pragma unroll
    for (int r = 0; r < 16; ++r) ps += p1[r];
    { auto rr = __builtin_amdgcn_permlane32_swap(__float_as_uint(ps), __float_as_uint(ps), false, false);
      ps = __uint_as_float(rr[0]) + __uint_as_float(rr[1]); }
    l_reg = l_reg * alpha + ps;
#define PK4(PP, BASE, OUT) do { unsigned a0 = cvtpk(PP[BASE + 0], PP[BASE + 1]), a1 = cvtpk(PP[BASE + 2], PP[BASE + 3]);   \
    unsigned b0 = cvtpk(PP[BASE + 4], PP[BASE + 5]), b1 = cvtpk(PP[BASE + 6], PP[BASE + 7]);                              \
    auto r0 = __builtin_amdgcn_permlane32_swap(a0, b0, false, false); auto r1 = __builtin_amdgcn_permlane32_swap(a1, b1, false, false); \
    u32x4 w = {r0[0], r1[0], r0[1], r1[1]}; OUT = *reinterpret_cast<bf16x8*>(&w); } while (0)
    PK4(p0, 0, pa0); PK4(p0, 8, pa1); PK4(p1, 0, pa2); PK4(p1, 8, pa3);
#undef PK4
}
template <int NQ>
__device__ __forceinline__ void qkt(f32x16& p0, f32x16& p1, const char* Ks, const bf16x8* qr, int r32, int hi) {
    p0 = f32x16{}; p1 = f32x16{};
#pragma unroll
    for (int d0 = 0; d0 < NQ; ++d0) { const int cb = (d0 * 16 + hi * 8) * 2;
        const bf16x8 b0 = *reinterpret_cast<const bf16x8*>(Ks + KSWZ(r32, cb));
        const bf16x8 b1 = *reinterpret_cast<const bf16x8*>(Ks + KSWZ(32 + r32, cb));
        p0 = __builtin_amdgcn_mfma_f32_32x32x16_bf16(b0, qr[d0], p0, 0, 0, 0);
        p1 = __builtin_amdgcn_mfma_f32_32x32x16_bf16(b1, qr[d0], p1, 0, 0, 0); }
}
__device__ __forceinline__ int v_st(int k, int c) { const int kk = (k & ~0xC) | ((k & 4) << 1) | ((k & 8) >> 1); return ((kk >> 3) * 4 + (c >> 5)) * 512 + ((kk & 7) * 32 + (c & 31)) * 2; }
__device__ __forceinline__ int v_rd_base(int lane) { return ((lane & 3) << 3) | (((lane >> 2) & 3) << 6) | (((lane >> 4) & 1) << 5) | (((lane >> 5) & 1) << 8); }
constexpr int v_rd_off(int d0, int ks, int half) { return d0 * 512 + ks * 4096 + half * 2048; }
template <int OFF> __device__ __forceinline__ s16x4 tr_read(int vb) {
    s16x4 r; asm volatile("ds_read_b64_tr_b16 %0, %1 offset:%2" : "=&v"(r) : "v"(vb), "i"(OFF) : "memory"); return r;
}
template <int D0> __device__ __forceinline__ void pv_one(f32x16& od, int vb, bf16x8 pa0, bf16x8 pa1, bf16x8 pa2, bf16x8 pa3) {
    const s16x4 l0 = tr_read<v_rd_off(D0, 0, 0)>(vb), h0 = tr_read<v_rd_off(D0, 0, 1)>(vb), l1 = tr_read<v_rd_off(D0, 1, 0)>(vb), h1 = tr_read<v_rd_off(D0, 1, 1)>(vb);
    const s16x4 l2 = tr_read<v_rd_off(D0, 2, 0)>(vb), h2 = tr_read<v_rd_off(D0, 2, 1)>(vb), l3 = tr_read<v_rd_off(D0, 3, 0)>(vb), h3 = tr_read<v_rd_off(D0, 3, 1)>(vb);
    asm volatile("s_waitcnt lgkmcnt(0)" ::: "memory"); SBAR();
#define PKV(L, H) (bf16x8){L[0], L[1], L[2], L[3], H[0], H[1], H[2], H[3]}
    od = __builtin_amdgcn_mfma_f32_32x32x16_bf16(pa0, PKV(l0, h0), od, 0, 0, 0);
    od = __builtin_amdgcn_mfma_f32_32x32x16_bf16(pa1, PKV(l1, h1), od, 0, 0, 0);
    od = __builtin_amdgcn_mfma_f32_32x32x16_bf16(pa2, PKV(l2, h2), od, 0, 0, 0);
    od = __builtin_amdgcn_mfma_f32_32x32x16_bf16(pa3, PKV(l3, h3), od, 0, 0, 0);
#undef PKV
}
__device__ __forceinline__ void pv_d0(f32x16* o, int vb, bf16x8 pa0, bf16x8 pa1, bf16x8 pa2, bf16x8 pa3) {
    pv_one<0>(o[0], vb, pa0, pa1, pa2, pa3); pv_one<1>(o[1], vb, pa0, pa1, pa2, pa3); pv_one<2>(o[2], vb, pa0, pa1, pa2, pa3); pv_one<3>(o[3], vb, pa0, pa1, pa2, pa3);
}
template <int NQ, int EPI>
__device__ __forceinline__ void attn_body(const bf16* __restrict__ Qb, const bf16* __restrict__ Kh, const bf16* __restrict__ Vh, bf16* __restrict__ Y, float* scratch, float lam, const float* dgain, char* lds) {
    constexpr int LDQ = NQ * 16, LDK = NQ * 16, LDV = DV;
    const int tid = threadIdx.x, wid = __builtin_amdgcn_readfirstlane(tid >> 6), lane = tid & 63, r32 = lane & 31, hi = lane >> 5;
    char* V_lds = lds; char* K_lds = lds + 2 * SHM_V;
    float* wsf = (float*)(lds + 2 * SHM_V + 2 * SHM_K) + wid * 64; float* li_l = wsf; float* al_l = wsf + 32;
    float m_reg = -1e30f, l_reg = 0; f32x16 o[4] = {}; bf16x8 qr[NQ];
    const bf16* Qw = Qb + (size_t)(wid * QBLK + r32) * LDQ + hi * 8;
#pragma unroll
    for (int d0 = 0; d0 < NQ; ++d0) qr[d0] = *reinterpret_cast<const bf16x8*>(Qw + d0 * 16);
    const int sr = tid >> 4, sc = (tid & 15) * 8, vst0 = v_st(sr, sc), vst1 = v_st(32 + sr, sc);
    const int kr = NQ == 8 ? sr : (tid >> 3), kc = NQ == 8 ? sc : (tid & 7) * 8;
    const int vb0 = (int)(uintptr_t)V_lds + v_rd_base(lane);
    struct { bf16x8 vs0, vs1, ks0, ks1; } sr_[2];
    const unsigned voff0 = (unsigned)(sr * LDV + sc) * 2u, voff1 = voff0 + 32u * LDV * 2u, koff0 = (unsigned)(kr * LDK + kc) * 2u, koff1 = koff0 + 32u * LDK * 2u;
#define SLOAD(i, k0) do { const char* _vb = (const char*)Vh + (size_t)(k0) * (LDV * 2); const char* _kb = (const char*)Kh + (size_t)(k0) * (LDK * 2); \
    sr_[i].vs0 = *reinterpret_cast<const bf16x8*>(_vb + voff0); sr_[i].vs1 = *reinterpret_cast<const bf16x8*>(_vb + voff1); \
    sr_[i].ks0 = *reinterpret_cast<const bf16x8*>(_kb + koff0); if (NQ == 8) sr_[i].ks1 = *reinterpret_cast<const bf16x8*>(_kb + koff1); } while (0)
#define SWRITE(b, i) do { *(bf16x8*)(V_lds + (b) * SHM_V + vst0) = sr_[i].vs0; *(bf16x8*)(V_lds + (b) * SHM_V + vst1) = sr_[i].vs1; \
    *(bf16x8*)(K_lds + (b) * SHM_K + KSWZ(kr, kc * 2)) = sr_[i].ks0; if (NQ == 8) *(bf16x8*)(K_lds + (b) * SHM_K + KSWZ(32 + kr, kc * 2)) = sr_[i].ks1; } while (0)
#define SWAIT() do { if (NQ == 8) asm volatile("s_waitcnt vmcnt(4)" ::: "memory"); else asm volatile("s_waitcnt vmcnt(3)" ::: "memory"); } while (0)
#define RESC(a) do { if (__any((a) < 1.f)) { if (hi == 0) al_l[r32] = (a); asm volatile("s_waitcnt lgkmcnt(0)" ::: "memory"); \
    _Pragma("unroll") for (int d = 0; d < 4; ++d) _Pragma("unroll") for (int r = 0; r < 16; ++r) o[d][r] *= al_l[crow(r, hi)]; } } while (0)
    f32x16 pA0, pA1, pB0, pB1; float mnA, mnB, alA, alB; bf16x8 pa0, pa1, pa2, pa3; constexpr int NT = SKV / KVBLK;
    constexpr int SE = 0, SO = 1;
    SLOAD(SE, 0); asm volatile("s_waitcnt vmcnt(0)" ::: "memory"); SWRITE(0, SE); __syncthreads();
    qkt<NQ>(pA0, pA1, K_lds, qr, r32, hi); partialSM<NQ>(pA0, pA1, m_reg, mnA, alA);
    SLOAD(SO, KVBLK); SLOAD(SE, 2 * KVBLK);
    SWAIT(); SWRITE(1, SO); __syncthreads();
    for (int j = 1; j + 1 < NT; j += 2) {
        SBAR(); qkt<NQ>(pB0, pB1, K_lds + SHM_K, qr, r32, hi);
        finishSM(pA0, pA1, alA, l_reg, pa0, pa1, pa2, pa3); SBAR();
        SLOAD(SO, (j + 2) * KVBLK); SBAR();
        pv_d0(o, vb0, pa0, pa1, pa2, pa3); partialSM<NQ>(pB0, pB1, m_reg, mnB, alB);
        __syncthreads(); SWAIT(); SWRITE(0, SE);
        RESC(alB); __syncthreads();
        SBAR(); qkt<NQ>(pA0, pA1, K_lds, qr, r32, hi);
        finishSM(pB0, pB1, alB, l_reg, pa0, pa1, pa2, pa3); SBAR();
        if (j + 3 < NT) SLOAD(SE, (j + 3) * KVBLK); SBAR();
        pv_d0(o, vb0 + (int)SHM_V, pa0, pa1, pa2, pa3); partialSM<NQ>(pA0, pA1, m_reg, mnA, alA);
        __syncthreads(); SWAIT(); SWRITE(1, SO);
        RESC(alA); __syncthreads();
    }
    SBAR(); qkt<NQ>(pB0, pB1, K_lds + SHM_K, qr, r32, hi);
    finishSM(pA0, pA1, alA, l_reg, pa0, pa1, pa2, pa3); SBAR();
    pv_d0(o, vb0, pa0, pa1, pa2, pa3); partialSM<NQ>(pB0, pB1, m_reg, mnB, alB);
    __syncthreads(); RESC(alB);
    finishSM(pB0, pB1, alB, l_reg, pa0, pa1, pa2, pa3); SBAR();
    pv_d0(o, vb0 + (int)SHM_V, pa0, pa1, pa2, pa3);
    if (hi == 0) li_l[r32] = l_reg; asm volatile("s_waitcnt lgkmcnt(0)" ::: "memory");
    float rli[16];
#pragma unroll
    for (int r = 0; r < 16; ++r) rli[r] = __builtin_amdgcn_rcpf(li_l[crow(r, hi)]);
    if (EPI == 0) {
        bf16* Yw = Y + (size_t)(wid * QBLK) * 1024;
#pragma unroll
        for (int r = 0; r < 16; ++r) { const int orow = crow(r, hi);
#pragma unroll
            for (int d0 = 0; d0 < 4; ++d0) Yw[(size_t)orow * 1024 + d0 * 32 + r32] = (bf16)(pk2(o[d0][r] * rli[r], 0.f) & 0xffffu); }
    } else if (EPI == 1) {
#pragma unroll
        for (int r = 0; r < 16; ++r)
#pragma unroll
            for (int d0 = 0; d0 < 4; ++d0) scratch[((wid * 16 + r) * 4 + d0) * 64 + lane] = o[d0][r] * rli[r];
    } else {
        bf16* Yw = Y + (size_t)(wid * QBLK) * 1024; float gn[4];
#pragma unroll
        for (int d0 = 0; d0 < 4; ++d0) gn[d0] = dgain[d0 * 32 + r32] * (1.0f - LAM_INIT);
#pragma unroll
        for (int r = 0; r < 16; ++r) { float od[4]; float ss = 0.f;
#pragma unroll
            for (int d0 = 0; d0 < 4; ++d0) { od[d0] = scratch[((wid * 16 + r) * 4 + d0) * 64 + lane] - lam * (o[d0][r] * rli[r]); ss += od[d0] * od[d0]; }
#pragma unroll
            for (int of = 1; of < 32; of <<= 1) ss += __shfl_xor(ss, of);
            const float rstd = rsqrtf(ss * (1.0f / 128.0f) + NORM_EPS); const int orow = crow(r, hi);
#pragma unroll
            for (int d0 = 0; d0 < 4; ++d0) Yw[(size_t)orow * 1024 + d0 * 32 + r32] = (bf16)(pk2(od[d0] * rstd * gn[d0], 0.f) & 0xffffu); }
    }
#undef SLOAD
#undef SWRITE
#undef SWAIT
#undef RESC
}
}
__device__ __forceinline__ void phase_attn(const Params& P, Frame& F) {
    char* lds = (char*)(unsigned char*)F.lds;
    float lam; { const float* lp = P.in[I_DLAMBDA]; const float a = wave_sum(lp[F.lane] * lp[64 + F.lane]), b = wave_sum(lp[128 + F.lane] * lp[192 + F.lane]); lam = __expf(a) - __expf(b) + LAM_INIT; }
    const int u = F.vcu; const int b = u >> 5, h = (u >> 3) & 3, qb = u & 7;
    bf16* Y = WSP(bf16, WS_ABF) + (size_t)(b * 2048 + qb * 256) * 1024;
#ifndef ATTN_TEST
#define ATTN_TEST 7
#endif
    if (ATTN_TEST & 1) {
        const bf16* Q = WSP(bf16, WS_GQ) + ((size_t)(b * 4 + h) * 2048 + qb * 256) * 128;
        const bf16* K = WSP(bf16, WS_GK) + (size_t)(b * 2 + (h >> 1)) * 2304 * 128; const bf16* V = WSP(bf16, WS_GV) + (size_t)(b * 2 + (h >> 1)) * 2304 * 128;
        attn::attn_body<8, 0>(Q, K, V, Y + h * 128, nullptr, 0.f, nullptr, lds);
        __syncthreads();
    }
    {
        float* scr = WSP(float, WS_O0) + (size_t)F.bid * 32768;
        const bf16* V = WSP(bf16, WS_DV) + (size_t)(b * 4 + h) * 2304 * 128;
        const bf16* Q0 = WSP(bf16, WS_DQ) + ((size_t)(b * 8 + 2 * h) * 2048 + qb * 256) * 64; const bf16* K0 = WSP(bf16, WS_DK) + (size_t)(b * 8 + 2 * h) * 2304 * 64;
        if (ATTN_TEST & 2) attn::attn_body<4, 1>(Q0, K0, V, nullptr, scr, 0.f, nullptr, lds);
        __syncthreads();
        if (ATTN_TEST & 4) attn::attn_body<4, 2>(Q0 + (size_t)2048 * 64, K0 + (size_t)2304 * 64, V, Y + 512 + h * 128, scr, lam, P.in[I_DGAIN], lds);
        __syncthreads();
    }
}
#ifndef MK_N_LAUNCHES
#define MK_N_LAUNCHES 1
#endif
constexpr int N_PHASES = 20;
__global__ void __launch_bounds__(NTHR, 2) hybrid_fwd(Params P) {
    extern __shared__ __attribute__((aligned(16))) unsigned char lds_raw[];
    Frame F;
    F.lds = (LAS unsigned char*)lds_raw; F.ws = P.ws;
    F.tid = threadIdx.x; F.lane = F.tid & 63; F.wave = __builtin_amdgcn_readfirstlane(F.tid >> 6);
    F.bid = blockIdx.x; F.vcu = (F.bid & 7) * 32 + (F.bid >> 3);
    volatile LAS unsigned* MISC = (volatile LAS unsigned*)(F.lds + MISC_OFF);
    for (int u = F.tid; u < (LDS_BYTES - LDSCTL_OFF) / 4; u += NTHR) ((LAS unsigned*)(F.lds + LDSCTL_OFF))[u] = 0u;
    __syncthreads();
    XcdBarrier bar; bar.bar = (unsigned*)(P.ws + WS_CTL) + CW_BAR; bar.x = 0; bar.st = nullptr;
    const int lo = P.ph_lo, hi = P.ph_hi;
    if (hi - lo > 1) bar = xcd_barrier_post((unsigned*)(P.ws + WS_CTL) + CW_BAR, MISC + 8);
#ifndef PHASE_MASK
#define PHASE_MASK 0xFFFFF
#endif
#define IN(k) (((PHASE_MASK >> (k)) & 1) && lo <= (k) && (k) < hi)
#ifndef DUP_MASK
#define DUP_MASK 0
#endif
#define REP(k)
#define SEAM(k) do { if (IN(k) && IN((k) + 1)) xcd_barrier(bar); } while (0)
    const float* mod = WSP(float, WS_MOD);
    if (IN(0)) REP(0) { phase_pre(P, F); } SEAM(0);
    if (IN(1)) REP(1) { phase_norm0(P, F); } SEAM(1);
    if (IN(2)) REP(2) {
        pg8::DenseOrder<1024> S; S.init(WSP(signed char, WS_A8), WSP(signed char, WS_WT_RECIN), NTOK, REC_IN, F.bid);
        pg8::EpiRecIn<true> E{WSP(bf16, WS_PROJ), WSP(float, WS_FF), WSP(float, WS_LB), WSP(float, WS_ROPE64), WSP(float, WS_ASC), WSP(float, WS_SDN)};
        pg8::gemm_phase(F.lds, S, E);
    } SEAM(2);
    if (IN(3)) REP(3) { phase_rec(P, F); } SEAM(3);
    if (IN(4)) REP(4) { phase_merge(P, F); } SEAM(4);
    if (IN(5)) REP(5) {
        pg8::DenseOrder<1024> S; S.init(WSP(signed char, WS_A8), WSP(signed char, WS_WT_RECOUT), NTOK, DM, F.bid);
        pg8::EpiResidual<true> E{P.in[I_X], P.in[I_CTX], WSP(float, WS_H1), mod + 2 * 1024, WSP(float, WS_ASC), WSP(float, WS_SDN) + 4096};
        pg8::gemm_phase(F.lds, S, E);
    } SEAM(5);
    if (IN(6)) REP(6) { phase_route<NTOK, 0>(P, F, WSP(float, WS_H1)); } SEAM(6);
    if (IN(7)) REP(7) { phase_scatter<NTOK>(P, F); } SEAM(7);
    if (IN(8)) REP(8) {
        pg8::MoeOrder<8, true, 1024> S{(const char*)WSP(bf16, WS_XS), (const char*)WSP(bf16, WS_WT_GU), WSP(int, WS_BLKE), 0, F.vcu};
        S.nrb = __builtin_amdgcn_readfirstlane(__hip_atomic_load(WSP(int, WS_BLKE) + MAXRB, RLX_AGENT));
        pg8::EpiSwigluI8 E{WSP(bf16, WS_H1S), P.in[I_B_GU], WSP(float, WS_RSC), WSP(float, WS_SGU)};
        pg8::gemm_phase(F.lds, S, E);
    } SEAM(8);
    if (IN(9)) REP(9) {
        pg8::MoeOrder<4, false, 2048> S{(const char*)WSP(bf16, WS_H1S), (const char*)WSP(bf16, WS_WT_DN), WSP(int, WS_BLKE), 0, F.vcu};
        S.nrb = __builtin_amdgcn_readfirstlane(__hip_atomic_load(WSP(int, WS_BLKE) + MAXRB, RLX_AGENT));
        pg8::EpiMoeOut E{WSP(bf16, WS_YS), P.in[I_B_DOWN], WSP(int, WS_RTOK), WSP(float, WS_RGATE)};
        pg8::gemm_phase(F.lds, S, E);
    } SEAM(9);
    if (IN(10)) REP(10) { phase_norm1(P, F); } SEAM(10);
    if (IN(11)) REP(11) {
        pg8::DenseOrder<1024> S; S.init(WSP(signed char, WS_A8), WSP(signed char, WS_WT_ATTIN), NTOK, ATT_IN, F.bid);
        pg8::EpiBf16<true> E{WSP(bf16, WS_PROJ), ATT_IN, WSP(float, WS_ASC), WSP(float, WS_SDN) + 5120};
        pg8::gemm_phase(F.lds, S, E);
    } SEAM(11);
    if (IN(12)) REP(12) { phase_qkv(P, F); } SEAM(12);
    if (IN(13)) REP(13) { phase_attn(P, F); } SEAM(13);
    if (IN(14)) REP(14) {
        pg8::DenseOrder<2048> S; S.init(WSP(bf16, WS_ABF), WSP(bf16, WS_WT_ATTOUT), NLAT, DM, F.bid);
        pg8::EpiResidual<false> E{WSP(float, WS_H2), WSP(float, WS_H2) + (size_t)NLAT * 1024, WSP(float, WS_H3), mod + 9 * 6144 + 2 * 1024, nullptr, nullptr};
        pg8::gemm_phase(F.lds, S, E);
    } SEAM(14);
    if (IN(15)) REP(15) { phase_route<NLAT, 1>(P, F, WSP(float, WS_H3)); } SEAM(15);
    if (IN(16)) REP(16) { phase_scatter<NLAT>(P, F); } SEAM(16);
    if (IN(17)) REP(17) {
        pg8::MoeOrder<8, true, 1024> S{(const char*)WSP(bf16, WS_XS), (const char*)(WSP(signed char, WS_WT_GU) + (size_t)32 * 2048 * 1024), WSP(int, WS_BLKE), 0, F.vcu};
        S.nrb = __builtin_amdgcn_readfirstlane(__hip_atomic_load(WSP(int, WS_BLKE) + MAXRB, RLX_AGENT));
        pg8::EpiSwigluI8 E{WSP(bf16, WS_H1S), P.in[I_B_GU] + 32 * 2048, WSP(float, WS_RSC), WSP(float, WS_SGU) + 32 * 2048};
        pg8::gemm_phase(F.lds, S, E);
    } SEAM(17);
    if (IN(18)) REP(18) {
        pg8::MoeOrder<4, false, 2048> S{(const char*)WSP(bf16, WS_H1S), (const char*)(WSP(bf16, WS_WT_DN) + (size_t)32 * 1024 * 1024), WSP(int, WS_BLKE), 0, F.vcu};
        S.nrb = __builtin_amdgcn_readfirstlane(__hip_atomic_load(WSP(int, WS_BLKE) + MAXRB, RLX_AGENT));
        pg8::EpiMoeOut E{WSP(bf16, WS_YS), P.in[I_B_DOWN] + 32 * 1024, WSP(int, WS_RTOK), WSP(float, WS_RGATE)};
        pg8::gemm_phase(F.lds, S, E);
    } SEAM(18);
    if (IN(19)) REP(19) { phase_final(P, F); }
#undef IN
#undef SEAM
}

extern "C" void kernel_launch(void* const* d_in, const int* in_sizes, int n_in, void* d_out, int out_size, void* d_ws, size_t ws_size, hipStream_t stream) {
    static int grid = 0;
    if (grid == 0) {
        if (n_in != 27 || out_size != NLAT * DM || ws_size < WS_END) { fprintf(stderr, "kernel_launch: unexpected shapes: n_in %d out %d ws %zu (need >= %zu)\n", n_in, out_size, ws_size, (size_t)WS_END); grid = -1; return; }
        int dev = 0, cus = 0;
        if (hipGetDevice(&dev) != hipSuccess || hipDeviceGetAttribute(&cus, hipDeviceAttributeMultiprocessorCount, dev) != hipSuccess) { grid = -1; return; }
        if (hipFuncSetAttribute((const void*)hybrid_fwd, hipFuncAttributeMaxDynamicSharedMemorySize, LDS_BYTES) != hipSuccess) { fprintf(stderr, "kernel_launch: hipFuncSetAttribute failed\n"); grid = -1; return; }
        if (cus != 256) fprintf(stderr, "kernel_launch: %d CUs (built for 256)\n", cus);
        grid = 256;
    }
    if (grid < 0) return;
    if (hipMemsetAsync((char*)d_ws + WS_CTL, 0, CTL_ZERO_BYTES, stream) != hipSuccess) return;
    Params p{};
    for (int i = 0; i < 27; ++i) p.in[i] = (const float*)d_in[i];
    p.out = (float*)d_out; p.ws = (unsigned char*)d_ws;
#ifndef DBG_STAGE
#define DBG_STAGE 0
#endif
    const int n_ph = DBG_STAGE == 1 ? 6 : DBG_STAGE == 2 ? 11 : DBG_STAGE == 3 ? 15 : DBG_STAGE == 4 ? 3 : DBG_STAGE == 5 ? 3 : DBG_STAGE == 6 ? 4 : DBG_STAGE == 7 ? 2 : DBG_STAGE == 8 ? 1 : N_PHASES;
#if MK_N_LAUNCHES == 1
    p.ph_lo = 0; p.ph_hi = n_ph;
    hipLaunchKernelGGL(hybrid_fwd, dim3(grid), dim3(NTHR), LDS_BYTES, stream, p);
#else
    for (int k = 0; k < n_ph; ++k) for (int rep = 0; rep < (((DUP_MASK >> k) & 1) ? 2 : 1); ++rep) { p.ph_lo = k; p.ph_hi = k + 1; hipLaunchKernelGGL(hybrid_fwd, dim3(grid), dim3(NTHR), LDS_BYTES, stream, p); }
#endif
    if (DBG_STAGE) { const size_t off = DBG_STAGE == 1 ? WS_H1 : DBG_STAGE == 2 ? WS_H2 : DBG_STAGE == 3 ? WS_H3 : DBG_STAGE == 4 ? WS_FF : DBG_STAGE == 5 ? WS_PROJ : DBG_STAGE == 6 ? WS_OREC : DBG_STAGE == 7 ? WS_ABF : WS_WT_GU; (void)hipMemcpyAsync(d_out, (char*)d_ws + off, DBG_STAGE == 7 ? (size_t)36 * MiB : (size_t)NLAT * DM * 4, hipMemcpyDeviceToDevice, stream); }
}
```

```cpp
#include <hip/hip_runtime.h>
#include <cstdio>
#include <cstdint>

#define GAS __attribute__((address_space(1)))
#define LAS __attribute__((address_space(3)))
typedef unsigned short bf16;
typedef float f32x2 __attribute__((ext_vector_type(2)));
typedef float f32x4 __attribute__((ext_vector_type(4)));
typedef float f32x16 __attribute__((ext_vector_type(16)));
typedef unsigned u32x2 __attribute__((ext_vector_type(2)));
typedef unsigned u32x4 __attribute__((ext_vector_type(4)));
typedef short bf16x8 __attribute__((ext_vector_type(8)));
typedef short s16x4 __attribute__((ext_vector_type(4)));

constexpr int BATCH = 8, SEQ = 2048, CTXL = 256, DM = 1024;
constexpr int NLAT = BATCH * SEQ, NCTX = BATCH * CTXL, NTOK = NLAT + NCTX;
constexpr int REC_IN = 4096, ATT_IN = 2560, NEXP = 32, MAXRB = 320;
constexpr float NORM_EPS = 1e-6f;
constexpr float LAM_INIT = 0.35550906759f;
constexpr int NWAVES = 8, NTHR = 512;

constexpr size_t MiB = 1u << 20;
constexpr size_t WS_CTL = 0, CTL_ZERO_BYTES = 1 * MiB;
constexpr size_t WS_MOD = 1 * MiB;
constexpr size_t WS_LB = 2 * MiB;
constexpr size_t WS_ROPE64 = 2 * MiB + 65536;
constexpr size_t WS_ROPE128 = 3 * MiB;
constexpr size_t WS_TOPE = 4 * MiB;
constexpr size_t WS_TOPG = WS_TOPE + 512 * 1024;
constexpr size_t WS_RANK = WS_TOPG + 512 * 1024;
constexpr size_t WS_BCNT = WS_RANK + 512 * 1024;
constexpr size_t WS_RTOK = WS_BCNT + 64 * 1024;
constexpr size_t WS_RGATE = WS_RTOK + 512 * 1024;
constexpr size_t WS_BLKE = WS_RGATE + 512 * 1024;
constexpr size_t WS_SGU = 7 * MiB;
constexpr size_t WS_FSC = 7 * MiB + 512 * 1024;
constexpr size_t WS_RSC = 7 * MiB + 640 * 1024;
constexpr size_t WS_SDN = 26 * MiB;
constexpr size_t WS_ASC = 26 * MiB + 65536;
constexpr size_t WS_WT_RECIN = 8 * MiB, WS_WT_RECOUT = 16 * MiB, WS_WT_ATTIN = 18 * MiB, WS_WT_ATTOUT = 24 * MiB;
constexpr size_t WS_WT_GU = 32 * MiB, WS_WT_DN = 288 * MiB;
constexpr size_t WS_ABF = 416 * MiB, WS_PROJ = 452 * MiB, WS_FF = 596 * MiB, WS_OREC = 668 * MiB;
constexpr size_t WS_H1 = 740 * MiB, WS_H2 = 812 * MiB, WS_H3 = 884 * MiB;
constexpr size_t WS_XS = 948 * MiB, WS_H1S = 1108 * MiB, WS_YS = 1268 * MiB;
constexpr size_t WS_F8 = WS_XS + 80 * MiB;
constexpr size_t WS_A8 = WS_XS + 100 * MiB;
constexpr size_t WS_GQ = 1412 * MiB, WS_GK = 1428 * MiB, WS_GV = 1438 * MiB, WS_DQ = 1448 * MiB, WS_DK = 1464 * MiB, WS_DV = 1482 * MiB, WS_O0 = 1500 * MiB;
constexpr size_t WS_END = 1532 * MiB;
constexpr int CW_BAR = 4096;

constexpr int RING_BYTES = 131072;
constexpr int LDSCTL_OFF = RING_BYTES, MISC_OFF = LDSCTL_OFF + 320;
constexpr int LDS_BYTES = 147456;

#define RLX_AGENT __ATOMIC_RELAXED, __HIP_MEMORY_SCOPE_AGENT
#define LDS_WAIT() asm volatile("s_waitcnt lgkmcnt(0)" ::: "memory")
#define VM_WAIT() asm volatile("s_waitcnt vmcnt(0)" ::: "memory")

__device__ __forceinline__ float bf2f(unsigned u) { return __uint_as_float(u << 16); }
__device__ __forceinline__ float bflo(unsigned w) { return __uint_as_float(w << 16); }
__device__ __forceinline__ float bfhi(unsigned w) { return __uint_as_float(w & 0xffff0000u); }
typedef __bf16 bf16x2_t __attribute__((ext_vector_type(2)));
__device__ __forceinline__ unsigned pk2(float lo, float hi) { f32x2 v = {lo, hi}; bf16x2_t b = __builtin_convertvector(v, bf16x2_t); return __builtin_bit_cast(unsigned, b); }
__device__ __forceinline__ float wave_sum(float v) {
#pragma unroll
    for (int o = 1; o < 64; o <<= 1) v += __shfl_xor(v, o);
    return v;
}
__device__ __forceinline__ float fsigmoid(float x) { return __builtin_amdgcn_rcpf(1.0f + __builtin_amdgcn_exp2f(-1.4426950408889634f * x)); }
__device__ __forceinline__ float fsilu(float x) { return x * fsigmoid(x); }

__device__ __forceinline__ unsigned q8pack(float a, float b, float c, float d, float inv) {
    int q0 = (int)rintf(a * inv), q1 = (int)rintf(b * inv), q2 = (int)rintf(c * inv), q3 = (int)rintf(d * inv);
    q0 = q0 > 127 ? 127 : (q0 < -127 ? -127 : q0); q1 = q1 > 127 ? 127 : (q1 < -127 ? -127 : q1); q2 = q2 > 127 ? 127 : (q2 < -127 ? -127 : q2); q3 = q3 > 127 ? 127 : (q3 < -127 ? -127 : q3);
    return (unsigned)(q0 & 255) | ((unsigned)(q1 & 255) << 8) | ((unsigned)(q2 & 255) << 16) | ((unsigned)(q3 & 255) << 24);
}
__device__ __forceinline__ float wave_max(float v) {
#pragma unroll
    for (int o = 1; o < 64; o <<= 1) v = fmaxf(v, __shfl_xor(v, o));
    return v;
}
#define XB_TMO      128
#define XB_XCNT(j)  (256  + 64 * (j))
#define XB_XSUB(j)  (1280 + 64 * (j))
#define XB_XGEN(j)  (2304 + 64 * (j))
#define XB_TOP      3328
#define XB_TOPGEN   3392
#define XCD_BAR_WORDS 3456
#define XB_SPIN_CAP (1u << 18)
__device__ __forceinline__ unsigned xb_ld(unsigned* p)              { return __hip_atomic_load(p, __ATOMIC_RELAXED, __HIP_MEMORY_SCOPE_AGENT); }
__device__ __forceinline__ unsigned xb_add(unsigned* p, unsigned v) { return __hip_atomic_fetch_add(p, v, __ATOMIC_RELAXED, __HIP_MEMORY_SCOPE_AGENT); }
__device__ __forceinline__ unsigned xb_xcc_id() { return (unsigned)__builtin_amdgcn_s_getreg((3 << 11) | 20) & 0xFu; }
#define XB_SPIN(cond, bar) do { unsigned _sp = 0; while (cond) { __builtin_amdgcn_s_sleep(1); \
    if ((++_sp & 255u) == 0u) { if (xb_ld(&(bar)[XB_TMO])) break; if (_sp > XB_SPIN_CAP) { atomicAdd(&(bar)[XB_TMO], 1u); break; } } } } while (0)
struct XcdBarrier { unsigned* bar; unsigned x; volatile LAS unsigned* st; };
__device__ __forceinline__ XcdBarrier xcd_barrier_post(unsigned* bar, volatile LAS unsigned* st) {
    XcdBarrier b; b.bar = bar; b.x = xb_xcc_id(); b.st = st;
    if (threadIdx.x == 0) (void)xb_add(&bar[XB_XCNT(b.x)], 1u);
    return b;
}
__device__ __forceinline__ void xcd_barrier_complete(unsigned* bar, unsigned x, unsigned& nloc, unsigned& nx) {
    const unsigned G = gridDim.x * gridDim.y * gridDim.z;
    unsigned sum, cnt, mine, sp = 0u;
    for (;;) {
        sum = 0u; cnt = 0u; mine = 0u;
#pragma unroll
        for (unsigned j = 0; j < 16; ++j) { const unsigned c = xb_ld(&bar[XB_XCNT(j)]); sum += c; cnt += (c > 0u) ? 1u : 0u; mine = (j == x) ? c : mine; }
        if (sum == G) break;
        __builtin_amdgcn_s_sleep(1);
        if ((++sp & 255u) == 0u) { if (xb_ld(&bar[XB_TMO])) break; if (sp > XB_SPIN_CAP) { atomicAdd(&bar[XB_TMO], 1u); break; } }
    }
    nloc = mine > 0u ? mine : 1u; nx = cnt > 0u ? cnt : 1u;
}
__device__ __forceinline__ void xcd_barrier(const XcdBarrier& b) {
    asm volatile("s_waitcnt vmcnt(0)" ::: "memory");
    __syncthreads();
    if (threadIdx.x == 0) {
        unsigned* bar = b.bar;
        __builtin_amdgcn_s_waitcnt(0);
        unsigned nloc = b.st[0], nx = b.st[1];
        if (nloc == 0u) { xcd_barrier_complete(bar, b.x, nloc, nx); b.st[0] = nloc; b.st[1] = nx; }
        const unsigned old = xb_add(&bar[XB_XSUB(b.x)], 1u);
        const unsigned gen = old / nloc;
        if (old + 1u == (gen + 1u) * nloc) {
            __builtin_amdgcn_fence(__ATOMIC_RELEASE, "agent");
            asm volatile("s_waitcnt vmcnt(0)" ::: "memory");
            const unsigned og = xb_add(&bar[XB_TOP], 1u);
            const unsigned tg = og / nx;
            if (og + 1u == (tg + 1u) * nx) xb_add(&bar[XB_TOPGEN], 1u);
            else XB_SPIN(xb_ld(&bar[XB_TOPGEN]) == tg, bar);
            __builtin_amdgcn_fence(__ATOMIC_ACQUIRE, "agent");
            xb_add(&bar[XB_XGEN(b.x)], 1u);
            asm volatile("s_waitcnt vmcnt(0)" ::: "memory");
        } else {
            XB_SPIN(xb_ld(&bar[XB_XGEN(b.x)]) == gen, bar);
            __builtin_amdgcn_fence(__ATOMIC_ACQUIRE, "agent");
            asm volatile("s_waitcnt vmcnt(0)" ::: "memory");
        }
    }
    __syncthreads();
}

struct Params { const float* in[27]; float* out; unsigned char* ws; int ph_lo, ph_hi; };
struct Frame {
    LAS unsigned char* lds;
    unsigned char* ws;
    int tid, lane, wave, bid, vcu;
};
enum { I_X = 0, I_C, I_CTX, I_CCTX, I_NORM_MIX, I_NORM_FFN, I_W_ADA, I_B_ADA, I_REC_W_IN, I_REC_LB, I_REC_W_OUT, I_HG_GAIN, I_RET_GAIN,
       I_ATT_W_IN, I_ATT_W_OUT, I_ATT_Q_GAIN, I_ATT_K_GAIN, I_DQ_GAIN, I_DK_GAIN, I_DLAMBDA, I_DGAIN, I_W_ROUTER, I_B_ROUTER, I_W_GU, I_B_GU, I_W_DOWN, I_B_DOWN };
#define WSP(T, off) ((T*)(F.ws + (off)))
__device__ __forceinline__ int mod_row(int r) { return r < NLAT ? (r >> 11) : 8; }
__device__ __forceinline__ void pre_modulation(const Params& P, Frame& F) {
    LAS float* s = (LAS float*)F.lds;
    LAS float* red = (LAS float*)(F.lds + 36864);
    const float* c = P.in[I_C]; const float* cctx = P.in[I_CCTX];
    for (int idx = F.tid; idx < 9 * 1024; idx += NTHR) { const int r = idx >> 10, k = idx & 1023; const float cv = r < 8 ? c[r * 1024 + k] : cctx[k]; s[idx] = fsilu(cv); }
    __syncthreads();
    const int l = F.bid / 96, col0 = (F.bid % 96) * 64;
    const float* W = P.in[I_W_ADA] + (size_t)l * 1024 * 6144 + col0 + F.lane;
    float acc[9];
#pragma unroll
    for (int r = 0; r < 9; ++r) acc[r] = 0.f;
    const int k0 = F.wave * 128;
#pragma unroll 2
    for (int kk = 0; kk < 128; kk += 4) {
        float wv[4];
#pragma unroll
        for (int i = 0; i < 4; ++i) wv[i] = W[(size_t)(k0 + kk + i) * 6144];
#pragma unroll
        for (int r = 0; r < 9; ++r) { const f32x4 sv = *(const LAS f32x4*)(s + r * 1024 + k0 + kk); acc[r] += sv.x * wv[0] + sv.y * wv[1] + sv.z * wv[2] + sv.w * wv[3]; }
    }
#pragma unroll
    for (int r = 0; r < 9; ++r) red[(F.wave * 9 + r) * 64 + F.lane] = acc[r];
    __syncthreads();
    float* mod = WSP(float, WS_MOD);
    for (int idx = F.tid; idx < 9 * 64; idx += NTHR) { const int r = idx >> 6, cl = idx & 63; float t = P.in[I_B_ADA][l * 6144 + col0 + cl];
#pragma unroll
        for (int w = 0; w < 8; ++w) t += red[(w * 9 + r) * 64 + cl];
        mod[(size_t)(l * 9 + r) * 6144 + col0 + cl] = t; }
    __syncthreads();
}
__device__ __forceinline__ void pre_tables(const Params& P, Frame& F) {
    const int gt = F.bid * NTHR + F.tid, GT = 256 * NTHR;
    if (gt < 1024) { const float* lg = P.in[I_REC_LB]; const float a = lg[gt], b = lg[1024 + gt], c = lg[2048 + gt]; const float m = fmaxf(a, fmaxf(b, c));
        const float ea = expf(a - m), eb = expf(b - m), ec = expf(c - m); WSP(float, WS_LB)[gt] = ea / (ea + eb + ec); }
    for (int idx = gt; idx < 2048 * 96; idx += GT) {
        const int t = idx / 96, p = idx % 96; const int row = t >> 6, col = t & 63;
        float* dst; int axis_dim, pp;
        if (p < 32) { dst = WSP(float, WS_ROPE64) + ((size_t)t * 32 + p) * 2; axis_dim = 32; pp = p; }
        else { dst = WSP(float, WS_ROPE128) + ((size_t)t * 64 + (p - 32)) * 2; axis_dim = 64; pp = p - 32; }
        const int nf = axis_dim / 2; const int fi = pp < nf ? pp : pp - nf; const float pos = pp < nf ? (float)row : (float)col;
        const float inv = powf(10000.0f, -(float)(2 * fi) / (float)axis_dim); const float ang = pos * inv;
        dst[0] = cosf(ang); dst[1] = sinf(ang);
    }
}
constexpr int TI_ATTOUT = 256, TI_DN = 64 * 256;
constexpr int TI_TOTAL = TI_ATTOUT + TI_DN;
__device__ __forceinline__ void titem_decode(const Params& P, Frame& F, int it, const float*& src, bf16*& dst, int& N) {
    const float* m; bf16* d; int local;
    if (it < TI_ATTOUT) { N = 1024; m = P.in[I_ATT_W_OUT]; d = WSP(bf16, WS_WT_ATTOUT); local = it; }
    else { it -= TI_ATTOUT; N = 1024; const int mat = it >> 8; local = it & 255; m = P.in[I_W_DOWN] + (size_t)mat * 1024 * 1024; d = WSP(bf16, WS_WT_DN) + (size_t)mat * 1024 * 1024; }
    const int nblk = N >> 6, nb = local % nblk, kb = local / nblk;
    src = m + (size_t)(kb * 64) * N + nb * 64; dst = d + (size_t)(nb * 64) * 1024 + kb * 64;
}
__device__ __forceinline__ void pre_transposes(const Params& P, Frame& F) {
    LAS float* scr = (LAS float*)(F.lds + F.wave * 16384);
    const int gw = F.vcu * NWAVES + F.wave, NGW = 256 * NWAVES;
    const int lr = F.lane >> 4, lc = (F.lane & 15) * 4;
    f32x4 cur[16];
    const float* src; bf16* dst; int N;
    int it = gw;
    if (it < TI_TOTAL) { titem_decode(P, F, it, src, dst, N);
#pragma unroll
        for (int i = 0; i < 16; ++i) cur[i] = *(const f32x4*)(src + (size_t)(4 * i + lr) * N + lc); }
    while (it < TI_TOTAL) {
        const int itn = it + NGW; f32x4 nxt[16]; const float* srcn; bf16* dstn; int Nn;
        if (itn < TI_TOTAL) { titem_decode(P, F, itn, srcn, dstn, Nn);
#pragma unroll
            for (int i = 0; i < 16; ++i) nxt[i] = *(const f32x4*)(srcn + (size_t)(4 * i + lr) * Nn + lc); }
#pragma unroll
        for (int i = 0; i < 16; ++i) { const int k = 4 * i + lr; *(LAS f32x4*)(scr + k * 64 + (lc ^ (((k >> 3) & 7) << 2))) = cur[i]; }
        const int c = F.lane & 7;
#pragma unroll
        for (int j = 0; j < 8; ++j) { const int n = (F.lane >> 3) + 8 * j; const LAS float* sp = scr + (8 * c) * 64 + (n ^ (c << 2));
            u32x4 o; o.x = pk2(sp[0], sp[64]); o.y = pk2(sp[128], sp[192]); o.z = pk2(sp[256], sp[320]); o.w = pk2(sp[384], sp[448]);
            *(u32x4*)(dst + (size_t)n * 1024 + 8 * c) = o; }
        if (itn < TI_TOTAL) {
#pragma unroll
            for (int i = 0; i < 16; ++i) cur[i] = nxt[i];
            dst = dstn; }
        it = itn;
    }
}
constexpr int NSTRIP_GU = 64 * 32, NSTRIP = NSTRIP_GU + 64 + 16 + 40;
__device__ __forceinline__ void strip_src(const Params& P, Frame& F, int s, const float*& src, signed char*& dst, float*& sc, int& N) {
    if (s < 64) { N = 4096; src = P.in[I_REC_W_IN] + s * 64; dst = WSP(signed char, WS_WT_RECIN) + (size_t)s * 64 * 1024; sc = WSP(float, WS_SDN) + s * 64; }
    else if ((s -= 64) < 16) { N = 1024; src = P.in[I_REC_W_OUT] + s * 64; dst = WSP(signed char, WS_WT_RECOUT) + (size_t)s * 64 * 1024; sc = WSP(float, WS_SDN) + 4096 + s * 64; }
    else if ((s -= 16) < 40) { N = 2560; src = P.in[I_ATT_W_IN] + s * 64; dst = WSP(signed char, WS_WT_ATTIN) + (size_t)s * 64 * 1024; sc = WSP(float, WS_SDN) + 5120 + s * 64; }
    else { s -= 40; N = 2048; const int mat = s >> 5, nb = s & 31;
        src = P.in[I_W_GU] + (size_t)mat * 1024 * 2048 + nb * 64; dst = WSP(signed char, WS_WT_GU) + ((size_t)mat * 2048 + nb * 64) * 1024; sc = WSP(float, WS_SGU) + mat * 2048 + nb * 64; }
}
__device__ __forceinline__ void pre_strips(const Params& P, Frame& F) {
    LAS unsigned char* tile = F.lds; LAS float* wmax = (LAS float*)(F.lds + 133120); LAS float* scl = (LAS float*)(F.lds + 135168);
    const int w = F.wave, l = F.lane, lr = l >> 4, nq = (l & 15) * 4;
    f32x4 regs[32]; const float* src; signed char* dst; float* sc; int N;
    int s = F.vcu;
    if (s < NSTRIP) { strip_src(P, F, s, src, dst, sc, N);
#pragma unroll
        for (int i = 0; i < 32; ++i) regs[i] = *(const f32x4*)(src + (size_t)(i * 32 + w * 4 + lr) * N + nq); }
    while (s < NSTRIP) {
        f32x4 pm = {0.f, 0.f, 0.f, 0.f};
#pragma unroll
        for (int i = 0; i < 32; ++i) { const int kr = i * 32 + w * 4 + lr; const f32x4 v = regs[i];
            pm.x = fmaxf(pm.x, fabsf(v.x)); pm.y = fmaxf(pm.y, fabsf(v.y)); pm.z = fmaxf(pm.z, fabsf(v.z)); pm.w = fmaxf(pm.w, fabsf(v.w));
            u32x2 pw; pw.x = pk2(v.x, v.y); pw.y = pk2(v.z, v.w);
            *(LAS u32x2*)(tile + kr * 128 + ((nq ^ (((kr >> 4) & 7) * 8)) * 2)) = pw; }
#pragma unroll
        for (int j = 0; j < 4; ++j) { float t = pm[j]; t = fmaxf(t, __shfl_xor(t, 16)); t = fmaxf(t, __shfl_xor(t, 32)); pm[j] = t; }
        if (l < 16) *(LAS f32x4*)(wmax + w * 64 + nq) = pm;
        __syncthreads();
        if (F.tid < 64) { float m = 0.f;
#pragma unroll
            for (int ww = 0; ww < 8; ++ww) m = fmaxf(m, wmax[ww * 64 + F.tid]);
            const float scv = m > 0.f ? m * (1.0f / 127.0f) : 1.0f; scl[F.tid] = scv; sc[F.tid] = scv; }
        signed char* dcur = dst;
        const int sn = s + 256;
        if (sn < NSTRIP) { strip_src(P, F, sn, src, dst, sc, N);
#pragma unroll
            for (int i = 0; i < 32; ++i) regs[i] = *(const f32x4*)(src + (size_t)(i * 32 + w * 4 + lr) * N + nq); }
        __syncthreads();
        { const int n = (l >> 3) + 8 * w, c = l & 7; const float inv = 1.0f / scl[n]; const int nsw = (n ^ (c * 8)) * 2;
#pragma unroll 1
            for (int kb = 0; kb < 8; ++kb) { const int k0 = kb * 128 + c * 16; u32x4 o;
#pragma unroll
                for (int d = 0; d < 4; ++d) { unsigned wd = 0;
#pragma unroll
                    for (int b = 0; b < 4; ++b) { const float v = bf2f(*(const LAS bf16*)(tile + (k0 + 4 * d + b) * 128 + nsw)); int q = (int)rintf(v * inv); q = q > 127 ? 127 : (q < -127 ? -127 : q); wd |= (unsigned)(q & 255) << (8 * b); }
                    o[d] = wd; }
                *(u32x4*)(dcur + (size_t)n * 1024 + k0) = o; } }
        __syncthreads();
        s = sn;
    }
}
__device__ __forceinline__ void phase_pre(const Params& P, Frame& F) {
    if (F.bid < 192) pre_modulation(P, F);
    pre_tables(P, F);
    pre_strips(P, F);
    pre_transposes(P, F);
}

__device__ __forceinline__ void norm_mod_store(const f32x4 (&v)[4], const float* gain, const float* sc, const float* sh, bf16* orow, int lane) {
    float ss = 0.f;
#pragma unroll
    for (int j = 0; j < 4; ++j) ss += (v[j].x * v[j].x + v[j].y * v[j].y) + (v[j].z * v[j].z + v[j].w * v[j].w);
    const float rstd = rsqrtf(wave_sum(ss) * (1.0f / 1024.0f) + NORM_EPS);
#pragma unroll
    for (int j = 0; j < 4; ++j) { const int c = 4 * lane + 256 * j; const f32x4 g = *(const f32x4*)(gain + c), s1 = *(const f32x4*)(sc + c), s0 = *(const f32x4*)(sh + c);
        const f32x4 a = v[j] * rstd * g * (s1 + 1.0f) + s0; u32x2 w; w.x = pk2(a.x, a.y); w.y = pk2(a.z, a.w); *(u32x2*)(orow + c) = w; }
}
__device__ __forceinline__ void norm_mod_store_q8(const f32x4 (&v)[4], const float* gain, const float* sc, const float* sh, signed char* orow, float* oscale, int lane) {
    float ss = 0.f;
#pragma unroll
    for (int j = 0; j < 4; ++j) ss += (v[j].x * v[j].x + v[j].y * v[j].y) + (v[j].z * v[j].z + v[j].w * v[j].w);
    const float rstd = rsqrtf(wave_sum(ss) * (1.0f / 1024.0f) + NORM_EPS);
    f32x4 a[4]; float amax = 0.f;
#pragma unroll
    for (int j = 0; j < 4; ++j) { const int c = 4 * lane + 256 * j; const f32x4 g = *(const f32x4*)(gain + c), s1 = *(const f32x4*)(sc + c), s0 = *(const f32x4*)(sh + c);
        a[j] = v[j] * rstd * g * (s1 + 1.0f) + s0; amax = fmaxf(amax, fmaxf(fmaxf(fabsf(a[j].x), fabsf(a[j].y)), fmaxf(fabsf(a[j].z), fabsf(a[j].w)))); }
    amax = wave_max(amax); const float qs = amax > 0.f ? amax * (1.0f / 127.0f) : 1.0f, qi = 1.0f / qs;
    if (lane == 0) *oscale = qs;
#pragma unroll
    for (int j = 0; j < 4; ++j) *(unsigned*)(orow + 4 * lane + 256 * j) = q8pack(a[j].x, a[j].y, a[j].z, a[j].w, qi);
}
__device__ __forceinline__ void phase_norm0(const Params& P, Frame& F) {
    const int gw = F.vcu * NWAVES + F.wave, NGW = 256 * NWAVES; const float* mod = WSP(float, WS_MOD);
    for (int r = gw; r < NTOK; r += NGW) {
        const float* src = r < NLAT ? P.in[I_X] + (size_t)r * 1024 : P.in[I_CTX] + (size_t)(r - NLAT) * 1024; f32x4 v[4];
#pragma unroll
        for (int j = 0; j < 4; ++j) v[j] = *(const f32x4*)(src + 4 * F.lane + 256 * j);
        const float* m = mod + (size_t)mod_row(r) * 6144;
        norm_mod_store_q8(v, P.in[I_NORM_MIX], m + 1024, m, WSP(signed char, WS_A8) + (size_t)r * 1024, WSP(float, WS_ASC) + r, F.lane);
    }
}
__device__ __forceinline__ void load_moe_sum(const float* h1row, const bf16* ysrow  , const float* g2, f32x4 (&v)[4], int lane) {
#pragma unroll
    for (int j = 0; j < 4; ++j) { const int c = 4 * lane + 256 * j; f32x4 s = {0.f, 0.f, 0.f, 0.f};
#pragma unroll
        for (int sl = 0; sl < 4; ++sl) { const u32x2 w = *(const u32x2*)(ysrow + sl * 1024 + c); s.x += bflo(w.x); s.y += bfhi(w.x); s.z += bflo(w.y); s.w += bfhi(w.y); }
        v[j] = *(const f32x4*)(h1row + c) + *(const f32x4*)(g2 + c) * s; }
}
__device__ __forceinline__ void phase_norm1(const Params& P, Frame& F) {
    const int gw = F.vcu * NWAVES + F.wave, NGW = 256 * NWAVES; const float* mod = WSP(float, WS_MOD);
    for (int r = gw; r < NTOK; r += NGW) {
        f32x4 v[4]; const int mr = mod_row(r);
        load_moe_sum(WSP(float, WS_H1) + (size_t)r * 1024, WSP(bf16, WS_YS) + (size_t)r * 4096, mod + (size_t)mr * 6144 + 5 * 1024, v, F.lane);
        float* h2 = WSP(float, WS_H2) + (size_t)r * 1024;
#pragma unroll
        for (int j = 0; j < 4; ++j) *(f32x4*)(h2 + 4 * F.lane + 256 * j) = v[j];
        const float* m = mod + (size_t)(9 + mr) * 6144;
        norm_mod_store_q8(v, P.in[I_NORM_MIX] + 1024, m + 1024, m, WSP(signed char, WS_A8) + (size_t)r * 1024, WSP(float, WS_ASC) + r, F.lane);
    }
}
__device__ __forceinline__ void phase_final(const Params& P, Frame& F) {
    const int gw = F.vcu * NWAVES + F.wave, NGW = 256 * NWAVES; const float* mod = WSP(float, WS_MOD);
    for (int r = gw; r < NLAT; r += NGW) {
        f32x4 v[4]; const int mr = mod_row(r);
        load_moe_sum(WSP(float, WS_H3) + (size_t)r * 1024, WSP(bf16, WS_YS) + (size_t)r * 4096, mod + (size_t)(9 + mr) * 6144 + 5 * 1024, v, F.lane);
        float* o = P.out + (size_t)r * 1024;
#pragma unroll
        for (int j = 0; j < 4; ++j) *(f32x4*)(o + 4 * F.lane + 256 * j) = v[j];
    }
}
namespace pg8 {
constexpr int BM = 256, BK = 64, HALF = 128, HTB = HALF * BK * 2, STAGE_BYTES = 8 * HTB, KD = 1024;
__device__ __forceinline__ int lds_byte(int r, int c) { const int st = (r >> 4) * 2 + (c >> 5), rr = r & 15, cc = c & 31, ob = rr * 64 + cc * 2; return st * 1024 + (ob ^ (((ob >> 9) & 1) << 5)); }
__device__ __forceinline__ void stage_rc(int b, int& R, int& C) { const int st = b / 1024, sb = b % 1024, swz = sb ^ (((sb >> 9) & 1) << 5); R = (st >> 1) * 16 + swz / 64; C = (st & 1) * 32 + (swz % 64) / 2; }
__device__ __forceinline__ int perm32(int rho) { const int n = rho >> 4, i = rho & 15; return 8 * (i >> 2) + 4 * n + (i & 3); }

struct Unit { const char *A0, *A1, *B0, *B1; int r0, c0, aux; };

typedef int i32x4 __attribute__((ext_vector_type(4)));
template <bool I8> struct AccT { typedef f32x4 T; };
template <> struct AccT<true> { typedef i32x4 T; };
template <bool I8> __device__ __forceinline__ typename AccT<I8>::T mma1(bf16x8 b, bf16x8 a, typename AccT<I8>::T c);
template <> __device__ __forceinline__ f32x4 mma1<false>(bf16x8 b, bf16x8 a, f32x4 c) { return __builtin_amdgcn_mfma_f32_16x16x32_bf16(b, a, c, 0, 0, 0); }
template <> __device__ __forceinline__ i32x4 mma1<true>(bf16x8 b, bf16x8 a, i32x4 c) { return __builtin_amdgcn_mfma_i32_16x16x64_i8(__builtin_bit_cast(i32x4, b), __builtin_bit_cast(i32x4, a), c, 0, 0, 0); }
template <class Epi, class Sched>
__device__ __forceinline__ void gemm_phase(LAS unsigned char* lds, const Sched& S, const Epi& E) {
    const int tid = threadIdx.x, wid = __builtin_amdgcn_readfirstlane(tid >> 6), lane = tid & 63, wr = wid >> 2, wc = wid & 3, fr = lane & 15, fq = lane >> 4;
    constexpr bool I8 = Epi::I8; typedef typename AccT<I8>::T acc_t;
    constexpr int K = I8 ? KD / 2 : KD  , nt = I8 ? KD / 128 : KD / BK;
    unsigned voffA[2], voffB[2];
#pragma unroll
    for (int i = 0; i < 2; ++i) { int R, C; stage_rc(tid * 16 + i * 8192, R, C); const int Rb = Epi::PERM ? ((R & ~31) + perm32(R & 31)) : R;
        voffA[i] = (unsigned)(R * K + C) * 2u; voffB[i] = (unsigned)(Rb * K + C) * 2u; }
    constexpr size_t kstep = (size_t)(BK * 2);
    const unsigned ldsw = (unsigned)wid * 1024u;
    const int aoff = lds_byte(wr * 64 + fr, fq * 8), boff = lds_byte(wc * 32 + fr, fq * 8);
#define PG8_SA(b, h) (((b) * 2 + (h)) * HTB)
#define PG8_SB(b, h) ((4 + (b) * 2 + (h)) * HTB)
#define PG8_STAGE(bufoff, gbase, voff) do { _Pragma("unroll") for (int _i = 0; _i < 2; ++_i) \
        __builtin_amdgcn_global_load_lds((const unsigned*)((const char*)(gbase) + (voff)[_i]), (LAS unsigned*)(lds + (bufoff) + ldsw + _i * 8192), 16, 0, 0); } while (0)
#define PG8_LDA(dst, b, h) do { _Pragma("unroll") for (int m = 0; m < 4; ++m) _Pragma("unroll") for (int k = 0; k < 2; ++k) dst[m][k] = *(const LAS bf16x8*)(lds + PG8_SA(b, h) + aoff + m * 2048 + k * 1024); } while (0)
#define PG8_LDB(dst, b, h) do { _Pragma("unroll") for (int n = 0; n < 2; ++n) _Pragma("unroll") for (int k = 0; k < 2; ++k) dst[n][k] = *(const LAS bf16x8*)(lds + PG8_SB(b, h) + boff + n * 2048 + k * 1024); } while (0)
#define PG8_MMA(ai, bj, At, Bt) do { __builtin_amdgcn_s_setprio(1); _Pragma("unroll") for (int m = 0; m < 4; ++m) _Pragma("unroll") for (int n = 0; n < 2; ++n) _Pragma("unroll") for (int k = 0; k < 2; ++k) \
        acc[ai][bj][m][n] = mma1<I8>(Bt[n][k], At[m][k], acc[ai][bj][m][n]); __builtin_amdgcn_s_setprio(0); } while (0)
#define PG8_WAIT_V(n) asm volatile("s_waitcnt vmcnt(" #n ")" ::: "memory")
#define PG8_WAIT_L(n) asm volatile("s_waitcnt lgkmcnt(" #n ")" ::: "memory")
#define PG8_BAR __builtin_amdgcn_s_barrier()
#define PG8_SCHED __builtin_amdgcn_sched_barrier(0)
    Unit cur, nxt; int ui = 0;
    if (!S.next(0, cur)) return;
    acc_t acc[2][2][4][2];
#pragma unroll
    for (int a = 0; a < 2; ++a)
#pragma unroll
        for (int b = 0; b < 2; ++b)
#pragma unroll
            for (int m = 0; m < 4; ++m)
#pragma unroll
                for (int n = 0; n < 2; ++n) acc[a][b][m][n] = (acc_t){0, 0, 0, 0};
    bf16x8 At[4][2], B0[2][2], B1[2][2];
    PG8_STAGE(PG8_SB(0, 0), cur.B0, voffB); PG8_STAGE(PG8_SB(0, 1), cur.B1, voffB); PG8_STAGE(PG8_SA(0, 0), cur.A0, voffA); PG8_STAGE(PG8_SA(0, 1), cur.A1, voffA);
    if (wr == 1) PG8_BAR;
    PG8_WAIT_V(2); PG8_BAR;
    PG8_STAGE(PG8_SB(1, 0), cur.B0 + kstep, voffB); PG8_STAGE(PG8_SA(1, 0), cur.A0 + kstep, voffA); PG8_STAGE(PG8_SB(1, 1), cur.B1 + kstep, voffB);
    PG8_WAIT_V(6); PG8_BAR;
    for (;;) {
        const bool has_next = S.next(ui + 1, nxt);
        const char* nA0 = has_next ? nxt.A0 : cur.A0; const char* nA1 = has_next ? nxt.A1 : cur.A1;
        const char* nB0 = has_next ? nxt.B0 : cur.B0; const char* nB1 = has_next ? nxt.B1 : cur.B1;
        for (int t = 0; t < nt; t += 2) {
            const bool last = (t == nt - 2);
            const char* a1_1 = cur.A1 + (size_t)(t + 1) * kstep;
            const char* a2_0 = last ? nA0 : cur.A0 + (size_t)(t + 2) * kstep; const char* a2_1 = last ? nA1 : cur.A1 + (size_t)(t + 2) * kstep;
            const char* b2_0 = last ? nB0 : cur.B0 + (size_t)(t + 2) * kstep; const char* b2_1 = last ? nB1 : cur.B1 + (size_t)(t + 2) * kstep;
            const char* a3_0 = a2_0 + kstep; const char* b3_0 = b2_0 + kstep; const char* b3_1 = b2_1 + kstep;
            PG8_LDB(B0, 0, 0); PG8_LDB(B1, 0, 1); PG8_SCHED; PG8_LDA(At, 0, 0); PG8_STAGE(PG8_SA(1, 1), a1_1, voffA);
            PG8_WAIT_V(8); PG8_WAIT_L(0); PG8_BAR; PG8_MMA(0, 0, At, B0); PG8_MMA(0, 1, At, B1); PG8_BAR; PG8_SCHED;
            PG8_LDA(At, 0, 1); PG8_STAGE(PG8_SB(0, 0), b2_0, voffB); PG8_STAGE(PG8_SB(0, 1), b2_1, voffB); PG8_STAGE(PG8_SA(0, 0), a2_0, voffA);
            PG8_WAIT_V(8); PG8_WAIT_L(0); PG8_BAR; PG8_MMA(1, 0, At, B0); PG8_MMA(1, 1, At, B1); PG8_BAR; PG8_SCHED;
            PG8_LDB(B0, 1, 0); PG8_LDB(B1, 1, 1); PG8_SCHED; PG8_LDA(At, 1, 0); PG8_STAGE(PG8_SA(0, 1), a2_1, voffA);
            PG8_WAIT_V(8); PG8_WAIT_L(0); PG8_BAR; PG8_MMA(0, 0, At, B0); PG8_MMA(0, 1, At, B1); PG8_BAR; PG8_SCHED;
            PG8_LDA(At, 1, 1); PG8_STAGE(PG8_SB(1, 0), b3_0, voffB); PG8_STAGE(PG8_SB(1, 1), b3_1, voffB); PG8_STAGE(PG8_SA(1, 0), a3_0, voffA);
            PG8_WAIT_V(8); PG8_WAIT_L(0); PG8_BAR; PG8_MMA(1, 0, At, B0); PG8_MMA(1, 1, At, B1); PG8_BAR; PG8_SCHED;
        }
        if (wr == 0) PG8_BAR;
        E(acc, cur, wr, wc, fr, fq);
        if (!has_next) break;
#pragma unroll
        for (int a = 0; a < 2; ++a)
#pragma unroll
            for (int b = 0; b < 2; ++b)
#pragma unroll
                for (int m = 0; m < 4; ++m)
#pragma unroll
                    for (int n = 0; n < 2; ++n) acc[a][b][m][n] = (acc_t){0, 0, 0, 0};
        cur = nxt; ++ui;
        if (wr == 1) PG8_BAR;
    }
    PG8_WAIT_V(0);
    PG8_BAR;
#undef PG8_SA
#undef PG8_SB
#undef PG8_STAGE
#undef PG8_LDA
#undef PG8_LDB
#undef PG8_MMA
#undef PG8_WAIT_V
#undef PG8_WAIT_L
#undef PG8_BAR
#undef PG8_SCHED
}

template <int RP  >
struct DenseOrder {
    const char* A; const char* Bt; int nM, nN, nwg, c;
    __device__ __forceinline__ void init(const void* A_, const void* Bt_, int M, int N, int c_) { A = (const char*)A_; Bt = (const char*)Bt_; nM = M / BM; nN = N / BM; nwg = nM * nN; c = c_; }
    __device__ __forceinline__ bool next(int i, Unit& u) const {
        const int L = i * 256 + c; if (L >= nwg) return false;
        int wgid = L; { const int q = nwg / 8, r = nwg % 8, xcd = wgid % 8, off = wgid / 8; wgid = (xcd < r ? xcd * (q + 1) : r * (q + 1) + (xcd - r) * q) + off; }
        const int nig = 8 * nN, gid = wgid / nig, fm = gid * 8, gsz = (nM - fm) < 8 ? (nM - fm) : 8;
        const int pm = fm + ((wgid % nig) % gsz), pn = (wgid % nig) / gsz;
        u.A0 = A + (size_t)pm * (BM * RP); u.A1 = u.A0 + (size_t)HALF * RP; u.B0 = Bt + (size_t)pn * (BM * RP); u.B1 = u.B0 + (size_t)HALF * RP;
        u.r0 = pm * BM; u.c0 = pn * BM; u.aux = pn; return true;
    }
};
template <int NPN, bool GU, int RP  >
struct MoeOrder {
    const char* A; const char* W; const int* blke; int nrb, vcu;
    __device__ __forceinline__ bool next(int i, Unit& u) const {
        const int L = i * 256 + vcu; const int rb = L / NPN, pn = L % NPN; if (rb >= nrb) return false;
        const int e = __builtin_amdgcn_readfirstlane(__hip_atomic_load(blke + rb, RLX_AGENT));
        u.A0 = A + (size_t)rb * (BM * RP); u.A1 = u.A0 + (size_t)HALF * RP;
        if (GU) { u.B0 = W + (size_t)e * (2048 * RP) + (size_t)pn * (HALF * RP); u.B1 = u.B0 + (size_t)1024 * RP; u.c0 = pn * HALF; }
        else    { u.B0 = W + (size_t)e * (1024 * RP) + (size_t)pn * (BM * RP); u.B1 = u.B0 + (size_t)HALF * RP; u.c0 = pn * BM; }
        u.r0 = rb * BM; u.aux = e; return true;
    }
};

template <bool I8> struct AccCvt;
template <> struct AccCvt<false> { static __device__ __forceinline__ f32x4 f(const f32x4& a, float, const f32x4&) { return a; } };
template <> struct AccCvt<true> { static __device__ __forceinline__ f32x4 f(const i32x4& a, float sr, const f32x4& sc) { return (f32x4){(float)a[0] * (sr * sc[0]), (float)a[1] * (sr * sc[1]), (float)a[2] * (sr * sc[2]), (float)a[3] * (sr * sc[3])}; } };
#define EPI_ROWS_BEGIN _Pragma("unroll") for (int ai = 0; ai < 2; ++ai) _Pragma("unroll") for (int m = 0; m < 4; ++m) { const int row = u.r0 + ai * HALF + wr * 64 + m * 16 + fr;
#define EPI_ROWS_END }
template <bool I8_>
struct EpiBf16 {
    static constexpr bool PERM = true, I8 = I8_;
    bf16* O; int ldc; const float* sa; const float* sb;
    __device__ __forceinline__ void operator()(const typename AccT<I8_>::T (&acc)[2][2][4][2], const Unit& u, int wr, int wc, int fr, int fq) const {
        const int col0 = u.c0 + wc * 32 + 8 * fq;
        f32x4 scv[2][2];
#pragma unroll
        for (int bj = 0; bj < 2; ++bj)
#pragma unroll
            for (int n = 0; n < 2; ++n) scv[bj][n] = I8_ ? *(const f32x4*)(sb + col0 + bj * HALF + 4 * n) : (f32x4){1.f, 1.f, 1.f, 1.f};
        EPI_ROWS_BEGIN bf16* rowp = O + (size_t)row * ldc + col0; const float sr = I8_ ? sa[row] : 1.f;
#pragma unroll
            for (int bj = 0; bj < 2; ++bj) { const f32x4 v0 = AccCvt<I8_>::f(acc[ai][bj][m][0], sr, scv[bj][0]), v1 = AccCvt<I8_>::f(acc[ai][bj][m][1], sr, scv[bj][1]); u32x4 w; w.x = pk2(v0[0], v0[1]); w.y = pk2(v0[2], v0[3]); w.z = pk2(v1[0], v1[1]); w.w = pk2(v1[2], v1[3]);
                *(u32x4*)(rowp + bj * HALF) = w; }
        EPI_ROWS_END
    }
};
template <bool I8_>
struct EpiRecIn {
    static constexpr bool PERM = true, I8 = I8_;
    bf16* O; float* FFo; const float* lb; const float* rope; const float* sa; const float* sb;
    __device__ __forceinline__ void operator()(const typename AccT<I8_>::T (&acc)[2][2][4][2], const Unit& u, int wr, int wc, int fr, int fq) const {
        const int pn = u.aux; const int col0 = u.c0 + wc * 32 + 8 * fq;
        f32x4 scv[2][2];
#pragma unroll
        for (int bj = 0; bj < 2; ++bj)
#pragma unroll
            for (int n = 0; n < 2; ++n) scv[bj][n] = I8_ ? *(const f32x4*)(sb + col0 + bj * HALF + 4 * n) : (f32x4){1.f, 1.f, 1.f, 1.f};
        if (pn >= 2 && pn < 6) {
            f32x4 lbv[2][2];
#pragma unroll
            for (int bj = 0; bj < 2; ++bj)
#pragma unroll
                for (int n = 0; n < 2; ++n) lbv[bj][n] = *(const f32x4*)(lb + col0 - 512 + bj * HALF + 4 * n);
            EPI_ROWS_BEGIN float* rowp = FFo + (size_t)row * 1024 + (col0 - 512); bf16* krow = O + (size_t)row * REC_IN + col0; const float sr = I8_ ? sa[row] : 1.f;
#pragma unroll
                for (int bj = 0; bj < 2; ++bj) { f32x4 kk[2];
#pragma unroll
                    for (int n = 0; n < 2; ++n) { const f32x4 z = AccCvt<I8_>::f(acc[ai][bj][m][n], sr, scv[bj][n]); f32x4 o;
#pragma unroll
                        for (int j = 0; j < 4; ++j) { const float sg = fsigmoid(z[j]); const float f = lbv[bj][n][j] + (1.0f - lbv[bj][n][j]) * sg; o[j] = __logf(f); kk[n][j] = (1.0f - lbv[bj][n][j]) * (1.0f - sg); }
                        *(f32x4*)(rowp + bj * HALF + 4 * n) = o; }
                    u32x4 w; w.x = pk2(kk[0][0], kk[0][1]); w.y = pk2(kk[0][2], kk[0][3]); w.z = pk2(kk[1][0], kk[1][1]); w.w = pk2(kk[1][2], kk[1][3]);
                    *(u32x4*)(krow + bj * HALF) = w; }
            EPI_ROWS_END
            return;
        }
        const int mode = (pn < 2) ? 1 : (pn == 8 || pn == 9 || pn >= 14) ? 2 : (pn == 10) ? 3 : (pn == 11) ? 4 : 0;
        EPI_ROWS_BEGIN bf16* rowp = O + (size_t)row * REC_IN + col0; const float sr = I8_ ? sa[row] : 1.f;
#pragma unroll
            for (int bj = 0; bj < 2; ++bj) { f32x4 v[2] = {AccCvt<I8_>::f(acc[ai][bj][m][0], sr, scv[bj][0]), AccCvt<I8_>::f(acc[ai][bj][m][1], sr, scv[bj][1])};
                if (mode == 1) {
#pragma unroll
                    for (int n = 0; n < 2; ++n)
#pragma unroll
                        for (int j = 0; j < 4; ++j) v[n][j] = fsilu(v[n][j]) * 0.08838834764831845f;
                } else if (mode == 2) {
#pragma unroll
                    for (int n = 0; n < 2; ++n)
#pragma unroll
                        for (int j = 0; j < 4; ++j) v[n][j] = fsilu(v[n][j]);
                } else if (mode >= 3) {
                    const float sc = (mode == 4) ? 0.125f : 1.0f;
                    if (row < NLAT) { const int t = row & 2047; const int p0 = ((col0 + bj * HALF) & 63) >> 1;
                        const f32x4 cs0 = *(const f32x4*)(rope + ((size_t)t * 32 + p0) * 2), cs1 = *(const f32x4*)(rope + ((size_t)t * 32 + p0 + 2) * 2);
                        f32x4 a = v[0], b = v[1];
                        v[0][0] = (a[0] * cs0[0] - a[1] * cs0[1]) * sc; v[0][1] = (a[0] * cs0[1] + a[1] * cs0[0]) * sc;
                        v[0][2] = (a[2] * cs0[2] - a[3] * cs0[3]) * sc; v[0][3] = (a[2] * cs0[3] + a[3] * cs0[2]) * sc;
                        v[1][0] = (b[0] * cs1[0] - b[1] * cs1[1]) * sc; v[1][1] = (b[0] * cs1[1] + b[1] * cs1[0]) * sc;
                        v[1][2] = (b[2] * cs1[2] - b[3] * cs1[3]) * sc; v[1][3] = (b[2] * cs1[3] + b[3] * cs1[2]) * sc;
                    } else { v[0] = v[0] * sc; v[1] = v[1] * sc; }
                }
                u32x4 w; w.x = pk2(v[0][0], v[0][1]); w.y = pk2(v[0][2], v[0][3]); w.z = pk2(v[1][0], v[1][1]); w.w = pk2(v[1][2], v[1][3]);
                *(u32x4*)(rowp + bj * HALF) = w; }
        EPI_ROWS_END
    }
};
template <bool I8_>
struct EpiResidual {
    static constexpr bool PERM = false, I8 = I8_;
    const float* baseLat; const float* baseCtx; float* out; const float* gate; const float* sa; const float* sb;
    __device__ __forceinline__ void operator()(const typename AccT<I8_>::T (&acc)[2][2][4][2], const Unit& u, int wr, int wc, int fr, int fq) const {
        const int col0 = u.c0 + wc * 32 + 4 * fq; const float* g = gate + (size_t)mod_row(u.r0) * 6144 + col0;
        f32x4 gv[2][2];
#pragma unroll
        for (int bj = 0; bj < 2; ++bj)
#pragma unroll
            for (int n = 0; n < 2; ++n) { gv[bj][n] = *(const f32x4*)(g + bj * HALF + n * 16); if (I8_) gv[bj][n] = gv[bj][n] * *(const f32x4*)(sb + col0 + bj * HALF + n * 16); }
        EPI_ROWS_BEGIN const float* bp = (row < NLAT ? baseLat + (size_t)row * 1024 : baseCtx + (size_t)(row - NLAT) * 1024) + col0; float* op = out + (size_t)row * 1024 + col0; const float sr = I8_ ? sa[row] : 1.f;
#pragma unroll
            for (int bj = 0; bj < 2; ++bj)
#pragma unroll
                for (int n = 0; n < 2; ++n) *(f32x4*)(op + bj * HALF + n * 16) = *(const f32x4*)(bp + bj * HALF + n * 16) + gv[bj][n] * AccCvt<I8_>::f(acc[ai][bj][m][n], sr, (f32x4){1.f, 1.f, 1.f, 1.f});
        EPI_ROWS_END
    }
};
struct EpiSwiglu {
    static constexpr bool PERM = true, I8 = false;
    bf16* O; const float* bgu;
    __device__ __forceinline__ void operator()(const f32x4 (&acc)[2][2][4][2], const Unit& u, int wr, int wc, int fr, int fq) const {
        const int col0 = u.c0 + wc * 32 + 8 * fq; const float* bb = bgu + (size_t)u.aux * 2048 + col0;
        f32x4 bg[2], bu[2];
#pragma unroll
        for (int n = 0; n < 2; ++n) { bg[n] = *(const f32x4*)(bb + 4 * n); bu[n] = *(const f32x4*)(bb + 1024 + 4 * n); }
        EPI_ROWS_BEGIN f32x4 h[2];
#pragma unroll
            for (int n = 0; n < 2; ++n)
#pragma unroll
                for (int j = 0; j < 4; ++j) { const float g = fminf(acc[ai][0][m][n][j] + bg[n][j], 7.0f); const float up = fminf(fmaxf(acc[ai][1][m][n][j] + bu[n][j], -7.0f), 7.0f);
                    h[n][j] = (up + 1.0f) * g * fsigmoid(1.702f * g); }
            u32x4 w; w.x = pk2(h[0][0], h[0][1]); w.y = pk2(h[0][2], h[0][3]); w.z = pk2(h[1][0], h[1][1]); w.w = pk2(h[1][2], h[1][3]);
            *(u32x4*)(O + (size_t)row * 1024 + col0) = w;
        EPI_ROWS_END
    }
};
struct EpiSwigluI8 {
    static constexpr bool PERM = true, I8 = true;
    bf16* O; const float* bgu; const float* sa; const float* sb;
    __device__ __forceinline__ void operator()(const i32x4 (&acc)[2][2][4][2], const Unit& u, int wr, int wc, int fr, int fq) const {
        const int col0 = u.c0 + wc * 32 + 8 * fq; const float* bb = bgu + (size_t)u.aux * 2048 + col0; const float* ss = sb + (size_t)u.aux * 2048 + col0;
        f32x4 bg[2], bu[2], sg[2], su[2];
#pragma unroll
        for (int n = 0; n < 2; ++n) { bg[n] = *(const f32x4*)(bb + 4 * n); bu[n] = *(const f32x4*)(bb + 1024 + 4 * n); sg[n] = *(const f32x4*)(ss + 4 * n); su[n] = *(const f32x4*)(ss + 1024 + 4 * n); }
        EPI_ROWS_BEGIN const float sr = sa[row]; f32x4 h[2];
#pragma unroll
            for (int n = 0; n < 2; ++n)
#pragma unroll
                for (int j = 0; j < 4; ++j) { const float g = fminf((float)acc[ai][0][m][n][j] * (sr * sg[n][j]) + bg[n][j], 7.0f); const float up = fminf(fmaxf((float)acc[ai][1][m][n][j] * (sr * su[n][j]) + bu[n][j], -7.0f), 7.0f);
                    h[n][j] = (up + 1.0f) * g * fsigmoid(1.702f * g); }
            u32x4 w; w.x = pk2(h[0][0], h[0][1]); w.y = pk2(h[0][2], h[0][3]); w.z = pk2(h[1][0], h[1][1]); w.w = pk2(h[1][2], h[1][3]);
            *(u32x4*)(O + (size_t)row * 1024 + col0) = w;
        EPI_ROWS_END
    }
};
struct EpiMoeOut {
    static constexpr bool PERM = true, I8 = false;
    bf16* YS; const float* bdn; const int* rtok; const float* rgate;
    __device__ __forceinline__ void operator()(const f32x4 (&acc)[2][2][4][2], const Unit& u, int wr, int wc, int fr, int fq) const {
        const int col0 = u.c0 + wc * 32 + 8 * fq; const float* bb = bdn + (size_t)u.aux * 1024 + col0;
        f32x4 bv[2][2];
#pragma unroll
        for (int bj = 0; bj < 2; ++bj)
#pragma unroll
            for (int n = 0; n < 2; ++n) bv[bj][n] = *(const f32x4*)(bb + bj * HALF + 4 * n);
        EPI_ROWS_BEGIN const int tk = rtok[row]; const float gt = rgate[row];
            if (tk >= 0) { bf16* rowp = YS + (size_t)tk * 1024 + col0;
#pragma unroll
                for (int bj = 0; bj < 2; ++bj) { const f32x4 v0 = (acc[ai][bj][m][0] + bv[bj][0]) * gt, v1 = (acc[ai][bj][m][1] + bv[bj][1]) * gt;
                    u32x4 w; w.x = pk2(v0[0], v0[1]); w.y = pk2(v0[2], v0[3]); w.z = pk2(v1[0], v1[1]); w.w = pk2(v1[2], v1[3]); *(u32x4*)(rowp + bj * HALF) = w; } }
        EPI_ROWS_END
    }
};
}
namespace rec {
template <int DK> struct LL {
    static constexpr int SD = (DK + 8) * 2;
    static constexpr int QIN = 0, KIN = QIN + 64 * SD, ST = KIN + 64 * SD, KSTT = ST + 64 * SD, VT = KSTT + DK * 144, ATT = VT + 64 * 144, TOT = ATT + 64 * 144, DEC = TOT + 8 * 128 * 4, END = DEC + 128 * 4;
};
template <bool RET> struct RegSet { f32x2 lf[RET ? 4 : 8]; unsigned qv[RET ? 4 : 8], kv[RET ? 4 : 8]; u32x4 vv; };
template <bool RET>
__device__ __forceinline__ void rec_unit(const Params& P, Frame& F, int b, int head, int dir, int vh) {
    constexpr int DK = RET ? 64 : 128, NT_ = RET ? 4 : 8, NVT = RET ? 2 : 4, KS = DK / 32;
    typedef LL<DK> L; constexpr int SD = L::SD;
    LAS unsigned char* lds = F.lds;
    const bf16* PROJ = WSP(bf16, WS_PROJ); const float* FFp = WSP(float, WS_FF); bf16* OR = WSP(bf16, WS_OREC) + (size_t)dir * NTOK * 1024;
    const int qcol = RET ? 2560 + head * 64 : head * 128, kcol = RET ? 2816 + head * 64 : 512 + dir * 512 + head * 128, fcol = dir * 512 + head * 128;
    const int vcol = (RET ? 3072 : 1536) + head * 128 + vh * 64, ocol = (RET ? 512 : 0) + head * 128 + vh * 64;
    const float lg = RET ? __logf(1.0f - exp2f(-5.0f - (float)(dir ? 3 - head : head))) : 0.f;
    const int dp = RET ? (F.tid & 31) : F.lane, tg = RET ? (F.tid >> 5) : F.wave;
    const int vs = F.tid >> 3, vc = (F.tid & 7) * 8;
    const int fr = F.lane & 15, fq = F.lane >> 4;
    const int sdt = RET ? (F.wave >> 1) : F.wave, svt0 = RET ? 2 * (F.wave & 1) : 0;
    f32x4 sacc[NVT];
#pragma unroll
    for (int i = 0; i < NVT; ++i) sacc[i] = (f32x4){0.f, 0.f, 0.f, 0.f};
    for (int idx = F.tid; idx < 64 * SD / 4; idx += NTHR) ((LAS unsigned*)(lds + L::ST))[idx] = 0u;
    if (RET && F.tid < 64) ((LAS float*)(lds + L::DEC))[F.tid] = __expf(64.0f * lg);
#define REC_BASE(n) ((n) < 4 ? NLAT + b * 256 + (dir ? 3 - (n) : (n)) * 64 : b * 2048 + (dir ? 35 - (n) : (n) - 4) * 64)
#define REC_ROW(base, j) ((base) + (dir ? 63 - (j) : (j)))
#define REC_LOAD(R, n) do { const int _bs = REC_BASE(n); _Pragma("unroll") for (int i = 0; i < NT_; ++i) { const size_t _r = (size_t)REC_ROW(_bs, NT_ * tg + i); \
        R.qv[i] = *(const unsigned*)(PROJ + _r * REC_IN + qcol + 2 * dp); R.kv[i] = *(const unsigned*)(PROJ + _r * REC_IN + kcol + 2 * dp); \
        if (!RET) R.lf[i] = *(const f32x2*)(FFp + _r * 1024 + fcol + 2 * dp); } \
        R.vv = *(const u32x4*)(PROJ + (size_t)REC_ROW(_bs, vs) * REC_IN + vcol + vc); } while (0)
    RegSet<RET> RA, RB;
    REC_LOAD(RA, 0); REC_LOAD(RB, 1);
#define REC_CHUNK(R, n) do { \
        const int base = REC_BASE(n); \
        float kst0[NT_], kst1[NT_]; \
        if (!RET) { \
            f32x2 cs[NT_]; f32x2 run = {0.f, 0.f}; \
            _Pragma("unroll") for (int i = 0; i < NT_; ++i) { run += R.lf[i]; cs[i] = run; } \
            *(LAS f32x2*)(lds + L::TOT + (tg * 128 + 2 * dp) * 4) = run; \
            __syncthreads(); \
            f32x2 pre = {0.f, 0.f}, all = {0.f, 0.f}; \
            _Pragma("unroll") for (int g = 0; g < 8; ++g) { const f32x2 t = *(const LAS f32x2*)(lds + L::TOT + (g * 128 + 2 * dp) * 4); all += t; if (g < tg) pre += t; } \
            const float eax = __expf(all.x), eay = __expf(all.y); \
            _Pragma("unroll") for (int i = 0; i < NT_; ++i) { const int j = NT_ * tg + i; const float ebx = fmaxf(__expf(pre.x + cs[i].x), 1e-35f), eby = fmaxf(__expf(pre.y + cs[i].y), 1e-35f); \
                const float rbx = __builtin_amdgcn_rcpf(ebx), rby = __builtin_amdgcn_rcpf(eby); \
                const float q0 = bflo(R.qv[i]), q1 = bfhi(R.qv[i]), k0 = bflo(R.kv[i]), k1 = bfhi(R.kv[i]); \
                *(LAS unsigned*)(lds + L::QIN + j * SD + 4 * dp) = pk2(q0 * ebx, q1 * eby); \
                *(LAS unsigned*)(lds + L::KIN + j * SD + 4 * dp) = pk2(k0 * rbx, k1 * rby); \
                kst0[i] = k0 * rbx * eax; kst1[i] = k1 * rby * eay; } \
            if (tg == 0) *(LAS f32x2*)(lds + L::DEC + 8 * dp) = (f32x2){eax, eay}; \
        } else { \
            _Pragma("unroll") for (int i = 0; i < NT_; ++i) { const int j = NT_ * tg + i; const float eb = __expf((float)(j + 1) * lg), enb = __expf(-(float)(j + 1) * lg), est = __expf((float)(63 - j) * lg); \
                const float q0 = bflo(R.qv[i]), q1 = bfhi(R.qv[i]), k0 = bflo(R.kv[i]), k1 = bfhi(R.kv[i]); \
                *(LAS unsigned*)(lds + L::QIN + j * SD + 4 * dp) = pk2(q0 * eb, q1 * eb); \
                *(LAS unsigned*)(lds + L::KIN + j * SD + 4 * dp) = pk2(k0 * enb, k1 * enb); \
                kst0[i] = k0 * est; kst1[i] = k1 * est; } \
        } \
        if (!RET) { u32x4 w0, w1; w0.x = pk2(kst0[0], kst0[1]); w0.y = pk2(kst0[2], kst0[3]); w0.z = pk2(kst0[NT_ - 4], kst0[NT_ - 3]); w0.w = pk2(kst0[NT_ - 2], kst0[NT_ - 1]); \
            w1.x = pk2(kst1[0], kst1[1]); w1.y = pk2(kst1[2], kst1[3]); w1.z = pk2(kst1[NT_ - 4], kst1[NT_ - 3]); w1.w = pk2(kst1[NT_ - 2], kst1[NT_ - 1]); \
            *(LAS u32x4*)(lds + L::KSTT + (2 * dp) * 144 + tg * 16) = w0; *(LAS u32x4*)(lds + L::KSTT + (2 * dp + 1) * 144 + tg * 16) = w1; \
        } else { u32x2 w0, w1; w0.x = pk2(kst0[0], kst0[1]); w0.y = pk2(kst0[2], kst0[3]); w1.x = pk2(kst1[0], kst1[1]); w1.y = pk2(kst1[2], kst1[3]); \
            *(LAS u32x2*)(lds + L::KSTT + (2 * dp) * 144 + tg * 8) = w0; *(LAS u32x2*)(lds + L::KSTT + (2 * dp + 1) * 144 + tg * 8) = w1; } \
        _Pragma("unroll") for (int i = 0; i < 8; ++i) *(LAS bf16*)(lds + L::VT + (vc + i) * 144 + vs * 2) = (bf16)(R.vv[i >> 1] >> (16 * (i & 1))); \
        if ((n) + 2 < 36) REC_LOAD(R, (n) + 2); \
        __syncthreads(); \
        { const int ti = F.wave >> 1; \
            _Pragma("unroll") for (int q = 0; q < 2; ++q) { const int si = 2 * (F.wave & 1) + q; f32x4 a4 = {0.f, 0.f, 0.f, 0.f}; \
                if (si <= ti) { \
                    _Pragma("unroll") for (int kk = 0; kk < KS; ++kk) { const bf16x8 a = *(const LAS bf16x8*)(lds + L::KIN + (si * 16 + fr) * SD + (kk * 32 + fq * 8) * 2); \
                        const bf16x8 bb = *(const LAS bf16x8*)(lds + L::QIN + (ti * 16 + fr) * SD + (kk * 32 + fq * 8) * 2); \
                        a4 = __builtin_amdgcn_mfma_f32_16x16x32_bf16(a, bb, a4, 0, 0, 0); } } \
                const int t = ti * 16 + fr, s0 = si * 16 + 4 * fq; \
                _Pragma("unroll") for (int j = 0; j < 4; ++j) if (s0 + j > t) a4[j] = 0.f; \
                u32x2 w; w.x = pk2(a4[0], a4[1]); w.y = pk2(a4[2], a4[3]); \
                *(LAS u32x2*)(lds + L::ATT + t * 144 + s0 * 2) = w; } } \
        __syncthreads(); \
        { const int ti = F.wave >> 1; const int t = ti * 16 + fr; bf16* orow = OR + (size_t)REC_ROW(base, t) * 1024 + ocol; \
            _Pragma("unroll") for (int q = 0; q < 2; ++q) { const int vi = 2 * (F.wave & 1) + q; f32x4 a4 = {0.f, 0.f, 0.f, 0.f}; \
                _Pragma("unroll") for (int kk = 0; kk < 2; ++kk) { const bf16x8 a = *(const LAS bf16x8*)(lds + L::VT + (vi * 16 + fr) * 144 + (kk * 32 + fq * 8) * 2); \
                    const bf16x8 bb = *(const LAS bf16x8*)(lds + L::ATT + t * 144 + (kk * 32 + fq * 8) * 2); \
                    a4 = __builtin_amdgcn_mfma_f32_16x16x32_bf16(a, bb, a4, 0, 0, 0); } \
                _Pragma("unroll") for (int kk = 0; kk < KS; ++kk) { const bf16x8 a = *(const LAS bf16x8*)(lds + L::ST + (vi * 16 + fr) * SD + (kk * 32 + fq * 8) * 2); \
                    const bf16x8 bb = *(const LAS bf16x8*)(lds + L::QIN + t * SD + (kk * 32 + fq * 8) * 2); \
                    a4 = __builtin_amdgcn_mfma_f32_16x16x32_bf16(a, bb, a4, 0, 0, 0); } \
                u32x2 w; w.x = pk2(a4[0], a4[1]); w.y = pk2(a4[2], a4[3]); \
                *(u32x2*)(orow + vi * 16 + 4 * fq) = w; } } \
        { const f32x4 dec4 = *(const LAS f32x4*)(lds + L::DEC + (sdt * 16 + 4 * fq) * 4); \
            _Pragma("unroll") for (int vt = 0; vt < NVT; ++vt) { f32x4 a4 = sacc[vt] * dec4; \
                _Pragma("unroll") for (int kk = 0; kk < 2; ++kk) { const bf16x8 a = *(const LAS bf16x8*)(lds + L::KSTT + (sdt * 16 + fr) * 144 + (kk * 32 + fq * 8) * 2); \
                    const bf16x8 bb = *(const LAS bf16x8*)(lds + L::VT + ((svt0 + vt) * 16 + fr) * 144 + (kk * 32 + fq * 8) * 2); \
                    a4 = __builtin_amdgcn_mfma_f32_16x16x32_bf16(a, bb, a4, 0, 0, 0); } \
                sacc[vt] = a4; } } \
        __syncthreads(); \
        _Pragma("unroll") for (int vt = 0; vt < NVT; ++vt) { u32x2 w; w.x = pk2(sacc[vt][0], sacc[vt][1]); w.y = pk2(sacc[vt][2], sacc[vt][3]); \
            *(LAS u32x2*)(lds + L::ST + ((svt0 + vt) * 16 + fr) * SD + (sdt * 16 + 4 * fq) * 2) = w; } \
    } while (0)
    for (int n = 0; n < 36; n += 2) { REC_CHUNK(RA, n); REC_CHUNK(RB, n + 1); }
#undef REC_CHUNK
#undef REC_BASE
#undef REC_ROW
#undef REC_LOAD
    __syncthreads();
}
}
__device__ __forceinline__ void phase_rec(const Params& P, Frame& F) {
    const int u = F.bid; const int vh = u & 1, dir = (u >> 1) & 1, head = (u >> 2) & 3, type = (u >> 4) & 1, b = u >> 5;
    if (type) rec::rec_unit<true>(P, F, b, head, dir, vh); else rec::rec_unit<false>(P, F, b, head, dir, vh);
}
__device__ __forceinline__ void phase_merge(const Params& P, Frame& F) {
    const int gw = F.vcu * NWAVES + F.wave, NGW = 256 * NWAVES; const int c0 = 16 * F.lane; const bool isret = F.lane >= 32;
    const float* gain = (isret ? P.in[I_RET_GAIN] : P.in[I_HG_GAIN]) + (c0 & 127);
    float gn[16];
#pragma unroll
    for (int i = 0; i < 16; ++i) gn[i] = gain[i];
    for (int r = gw; r < NTOK; r += NGW) {
        const bf16* o0 = WSP(bf16, WS_OREC) + (size_t)r * 1024 + c0; const bf16* o1 = o0 + (size_t)NTOK * 1024;
        const bf16* gp = WSP(bf16, WS_PROJ) + (size_t)r * REC_IN + c0 + (isret ? 3072 : 2048);
        u32x4 a[2] = {*(const u32x4*)o0, *(const u32x4*)(o0 + 8)}, bq[2] = {*(const u32x4*)o1, *(const u32x4*)(o1 + 8)}, g[2] = {*(const u32x4*)gp, *(const u32x4*)(gp + 8)};
        float o[16], gt[16]; float s1 = 0.f;
#pragma unroll
        for (int i = 0; i < 8; ++i) { const unsigned wa = a[i >> 2][i & 3], wb = bq[i >> 2][i & 3], wg = g[i >> 2][i & 3];
            o[2 * i] = bflo(wa) + bflo(wb); o[2 * i + 1] = bfhi(wa) + bfhi(wb); gt[2 * i] = bflo(wg); gt[2 * i + 1] = bfhi(wg); s1 += o[2 * i] + o[2 * i + 1]; }
        s1 += __shfl_xor(s1, 1); s1 += __shfl_xor(s1, 2); s1 += __shfl_xor(s1, 4);
        const float mean = isret ? s1 * (1.0f / 128.0f) : 0.f; float s2 = 0.f;
#pragma unroll
        for (int i = 0; i < 16; ++i) { o[i] -= mean; s2 += o[i] * o[i]; }
        s2 += __shfl_xor(s2, 1); s2 += __shfl_xor(s2, 2); s2 += __shfl_xor(s2, 4);
        const float rstd = rsqrtf(s2 * (1.0f / 128.0f) + NORM_EPS);
        float amax = 0.f;
#pragma unroll
        for (int i = 0; i < 16; ++i) { o[i] = o[i] * rstd * gn[i] * gt[i]; amax = fmaxf(amax, fabsf(o[i])); }
        amax = wave_max(amax); const float qs = amax > 0.f ? amax * (1.0f / 127.0f) : 1.0f, qi = 1.0f / qs;
        if (F.lane == 0) WSP(float, WS_ASC)[r] = qs;
        u32x4 w;
#pragma unroll
        for (int i = 0; i < 4; ++i) w[i] = q8pack(o[4 * i], o[4 * i + 1], o[4 * i + 2], o[4 * i + 3], qi);
        *(u32x4*)(WSP(signed char, WS_A8) + (size_t)r * 1024 + c0) = w;
    }
}
template <int NROWS, int LAYER>
__device__ __forceinline__ void phase_route(const Params& P, Frame& F, const float* H) {
    constexpr int RPB = NROWS / 256, NB = (RPB + 15) / 16, FS = 1028;
    LAS float* ftile = (LAS float*)F.lds;
    LAS float* part = (LAS float*)(F.lds + 16 * FS * 4);
    LAS int* hist = (LAS int*)(F.lds + 131072);
    if (F.tid < 32) hist[F.tid] = 0;
    const float* mod = WSP(float, WS_MOD); const float* wr = P.in[I_W_ROUTER] + (size_t)LAYER * 1024 * 32; const float* br = P.in[I_B_ROUTER] + LAYER * 32;
    const float* gain = P.in[I_NORM_FFN] + LAYER * 1024;
    int* tope = WSP(int, WS_TOPE); float* topg = WSP(float, WS_TOPG); int* rank = WSP(int, WS_RANK);
    const int l = F.lane, li = l & 15, lg = l >> 4;
    float wreg[2][32];
    { const float* wp = wr + (size_t)(128 * F.wave + 32 * lg) * 32 + li;
#pragma unroll
        for (int s2 = 0; s2 < 32; ++s2) { wreg[0][s2] = wp[s2 * 32]; wreg[1][s2] = wp[s2 * 32 + 16]; } }
    const int e = l & 31; const float bias = br[e];
    const int row0 = F.bid * RPB;
    __syncthreads();
    for (int bt = 0; bt < NB; ++bt) {
#pragma unroll
        for (int q = 0; q < 2; ++q) {
            const int rr = 2 * F.wave + q; const int lr = bt * 16 + rr; const bool valid = lr < RPB; const int r = row0 + (valid ? lr : 0);
            const float* src = H + (size_t)r * 1024; f32x4 v[4];
#pragma unroll
            for (int j = 0; j < 4; ++j) v[j] = *(const f32x4*)(src + 4 * l + 256 * j);
            float ss = 0.f;
#pragma unroll
            for (int j = 0; j < 4; ++j) ss += (v[j].x * v[j].x + v[j].y * v[j].y) + (v[j].z * v[j].z + v[j].w * v[j].w);
            const float rstd = rsqrtf(wave_sum(ss) * (1.0f / 1024.0f) + NORM_EPS);
            const float* m = mod + (size_t)(LAYER * 9 + mod_row(r)) * 6144; float amax = 0.f;
#pragma unroll
            for (int j = 0; j < 4; ++j) { const int c = 4 * l + 256 * j; const f32x4 gg = *(const f32x4*)(gain + c), s1 = *(const f32x4*)(m + 4096 + c), s0 = *(const f32x4*)(m + 3072 + c);
                const f32x4 a = v[j] * rstd * gg * (s1 + 1.0f) + s0; *(LAS f32x4*)(ftile + rr * FS + c) = a; v[j] = a;
                amax = fmaxf(amax, fmaxf(fmaxf(fabsf(a.x), fabsf(a.y)), fmaxf(fabsf(a.z), fabsf(a.w)))); }
            amax = wave_max(amax);
            const float qs = amax > 0.f ? amax * (1.0f / 127.0f) : 1.0f, qi = 1.0f / qs;
            if (valid) { signed char* orow = WSP(signed char, WS_F8) + (size_t)r * 1024; if (l == 0) WSP(float, WS_FSC)[r] = qs;
#pragma unroll
                for (int j = 0; j < 4; ++j) *(unsigned*)(orow + 4 * l + 256 * j) = q8pack(v[j].x, v[j].y, v[j].z, v[j].w, qi); }
        }
        __syncthreads();
        {
            f32x4 a0 = {0.f, 0.f, 0.f, 0.f}, a1 = {0.f, 0.f, 0.f, 0.f};
            const LAS float* fp = ftile + li * FS + 128 * F.wave + 32 * lg;
#pragma unroll
            for (int s4 = 0; s4 < 8; ++s4) { const f32x4 av = *(const LAS f32x4*)(fp + 4 * s4);
#pragma unroll
                for (int t = 0; t < 4; ++t) { a0 = __builtin_amdgcn_mfma_f32_16x16x4f32(av[t], wreg[0][4 * s4 + t], a0, 0, 0, 0); a1 = __builtin_amdgcn_mfma_f32_16x16x4f32(av[t], wreg[1][4 * s4 + t], a1, 0, 0, 0); } }
#pragma unroll
            for (int t = 0; t < 4; ++t) { part[(F.wave * 16 + 4 * lg + t) * 32 + li] = a0[t]; part[(F.wave * 16 + 4 * lg + t) * 32 + 16 + li] = a1[t]; }
        }
        __syncthreads();
#pragma unroll
        for (int q = 0; q < 2; ++q) {
            const int rr = 2 * F.wave + q; const int lr = bt * 16 + rr; if (lr >= RPB) continue;
            const int r = row0 + lr; float val = bias;
#pragma unroll
            for (int ww = 0; ww < 8; ++ww) val += part[(ww * 16 + rr) * 32 + e];
            float tv[4]; int ti[4];
#pragma unroll
            for (int k = 0; k < 4; ++k) { float mx = val;
#pragma unroll
                for (int o = 1; o < 32; o <<= 1) mx = fmaxf(mx, __shfl_xor(mx, o));
                const unsigned long long bal = __ballot(val == mx); const int idx = (__ffsll((long long)bal) - 1) & 31;
                tv[k] = mx; ti[k] = idx; if (e == idx) val = -3.0e38f; }
            const float e1 = __expf(tv[1] - tv[0]), e2 = __expf(tv[2] - tv[0]), e3 = __expf(tv[3] - tv[0]); const float inv = 1.0f / (1.0f + e1 + e2 + e3);
            if (l < 4) { const int k = l; const int ex = k == 0 ? ti[0] : k == 1 ? ti[1] : k == 2 ? ti[2] : ti[3]; const float gv = (k == 0 ? 1.0f : k == 1 ? e1 : k == 2 ? e2 : e3) * inv;
                const int rk = atomicAdd((int*)(hist + ex), 1);
                tope[r * 4 + k] = ex; topg[r * 4 + k] = gv; rank[r * 4 + k] = rk; }
        }
    }
    __syncthreads();
    if (F.tid < 32) WSP(int, WS_BCNT)[F.bid * 32 + F.tid] = hist[F.tid];
    __syncthreads();
}
template <int NROWS>
__device__ __forceinline__ void phase_scatter(const Params& P, Frame& F) {
    constexpr int RPB = NROWS / 256;
    LAS int* part_tot = (LAS int*)F.lds;
    LAS int* part_pre = part_tot + 512;
    LAS int* baseL = part_pre + 512;
    LAS int* padS = baseL + 32;
    LAS int* totL = padS + 40;
    const int* bcnt = WSP(int, WS_BCNT);
    { const int e = F.tid & 31, part = F.tid >> 5; int t = 0, pr = 0;
        for (int bb = part * 16; bb < part * 16 + 16; ++bb) { const int c = bcnt[bb * 32 + e]; t += c; if (bb < F.bid) pr += c; }
        part_tot[part * 32 + e] = t; part_pre[part * 32 + e] = pr; }
    __syncthreads();
    if (F.tid < 32) { int t = 0, pr = 0;
        for (int p = 0; p < 16; ++p) { t += part_tot[p * 32 + F.tid]; pr += part_pre[p * 32 + F.tid]; }
        totL[F.tid] = t; baseL[F.tid] = pr; }
    __syncthreads();
    if (F.tid == 0) { int run = 0; for (int e = 0; e < 32; ++e) { padS[e] = run; run += (totL[e] + 255) & ~255; } padS[32] = run; }
    __syncthreads();
    if (F.tid < 32) baseL[F.tid] += padS[F.tid];
    __syncthreads();
    const int* tope = WSP(int, WS_TOPE); const float* topg = WSP(float, WS_TOPG); const int* rank = WSP(int, WS_RANK);
    int* rtok = WSP(int, WS_RTOK); float* rgate = WSP(float, WS_RGATE);
    for (int a = F.wave; a < RPB * 4; a += NWAVES) {
        const int r = F.bid * RPB + (a >> 2), k = a & 3; const int ex = tope[r * 4 + k]; const int dest = baseL[ex] + rank[r * 4 + k];
        const u32x4* src = (const u32x4*)(WSP(signed char, WS_F8) + (size_t)r * 1024); u32x4* dst = (u32x4*)(WSP(signed char, WS_XS) + (size_t)dest * 1024);
        dst[F.lane] = src[F.lane];
        if (F.lane == 0) { rtok[dest] = r * 4 + k; rgate[dest] = topg[r * 4 + k]; WSP(float, WS_RSC)[dest] = WSP(float, WS_FSC)[r]; }
    }
    if (F.bid < 32) { const int e = F.bid; const int s = padS[e] + totL[e], en = padS[e + 1]; for (int i = s + F.tid; i < en; i += NTHR) { rtok[i] = -1; rgate[i] = 0.f; WSP(float, WS_RSC)[i] = 0.f; } }
    if (F.bid == 32) { int* blke = WSP(int, WS_BLKE); const int nrb = padS[32] >> 8;
        for (int rb = F.tid; rb < MAXRB; rb += NTHR) { int ex = -1; if (rb < nrb) { const int row = rb << 8; ex = 0; for (int e = 1; e < 32; ++e) if (row >= padS[e]) ex = e; } blke[rb] = ex; }
        if (F.tid == 0) blke[MAXRB] = nrb; }
    __syncthreads();
}
__device__ __forceinline__ void load8(const bf16* p, float (&x)[8]) { const u32x4 w = *(const u32x4*)p;
#pragma unroll
    for (int i = 0; i < 4; ++i) { x[2 * i] = bflo(w[i]); x[2 * i + 1] = bfhi(w[i]); } }
__device__ __forceinline__ void store8(bf16* p, const float (&x)[8]) { u32x4 w;
#pragma unroll
    for (int i = 0; i < 4; ++i) w[i] = pk2(x[2 * i], x[2 * i + 1]);
    *(u32x4*)p = w; }
__device__ __forceinline__ void rope8(float (&x)[8], const float* cs  ) {
    const f32x4 c0 = *(const f32x4*)cs, c1 = *(const f32x4*)(cs + 4); float y[8];
    y[0] = x[0] * c0[0] - x[1] * c0[1]; y[1] = x[0] * c0[1] + x[1] * c0[0]; y[2] = x[2] * c0[2] - x[3] * c0[3]; y[3] = x[2] * c0[3] + x[3] * c0[2];
    y[4] = x[4] * c1[0] - x[5] * c1[1]; y[5] = x[4] * c1[1] + x[5] * c1[0]; y[6] = x[6] * c1[2] - x[7] * c1[3]; y[7] = x[6] * c1[3] + x[7] * c1[2];
#pragma unroll
    for (int i = 0; i < 8; ++i) x[i] = y[i];
}
template <int GL>
__device__ __forceinline__ void headnorm8(float (&x)[8], const float* gain8) {
    float ss = 0.f;
#pragma unroll
    for (int i = 0; i < 8; ++i) ss += x[i] * x[i];
#pragma unroll
    for (int o = 1; o < GL; o <<= 1) ss += __shfl_xor(ss, o);
    const float rstd = rsqrtf(ss * (1.0f / (8.0f * GL)) + NORM_EPS);
#pragma unroll
    for (int i = 0; i < 8; ++i) x[i] = x[i] * rstd * gain8[i];
}
__device__ __forceinline__ void phase_qkv(const Params& P, Frame& F) {
    const int gw = F.vcu * NWAVES + F.wave, NGW = 256 * NWAVES; const int l = F.lane;
    const bf16* PR = WSP(bf16, WS_PROJ); const float* r64 = WSP(float, WS_ROPE64); const float* r128 = WSP(float, WS_ROPE128);
    float gq[8], gk[8], gdq[8], gdk[8];
#pragma unroll
    for (int i = 0; i < 8; ++i) { gq[i] = P.in[I_ATT_Q_GAIN][(8 * l) % 128 + i]; gk[i] = P.in[I_ATT_K_GAIN][(8 * l) % 128 + i]; gdq[i] = P.in[I_DQ_GAIN][(8 * l) % 64 + i]; gdk[i] = P.in[I_DK_GAIN][(8 * l) % 64 + i]; }
    for (int r = gw; r < NTOK; r += NGW) {
        const bool lat = r < NLAT; const int rc = r - NLAT; const int b = lat ? (r >> 11) : (rc >> 8); const int t = r & 2047; const int pos = lat ? 256 + t : (rc & 255);
        const bf16* row = PR + (size_t)r * ATT_IN; float x[8];
        const int c128 = (8 * l) % 128, c64 = (8 * l) % 64;
        if (lat) {
            load8(row + 8 * l, x); headnorm8<16>(x, gq); rope8(x, r128 + ((size_t)t * 64 + c128 / 2) * 2);
            store8(WSP(bf16, WS_GQ) + ((size_t)(b * 4 + (l >> 4)) * 2048 + t) * 128 + c128, x);
        }
        {
            load8(row + 512 + 8 * l, x); float xn[8];
#pragma unroll
            for (int i = 0; i < 8; ++i) xn[i] = x[i];
            headnorm8<16>(xn, gk); if (lat) rope8(xn, r128 + ((size_t)t * 64 + c128 / 2) * 2);
            const int kvh = (l >> 4) & 1; const size_t off = ((size_t)(b * 2 + kvh) * 2304 + pos) * 128 + c128;
            if (l < 32) store8(WSP(bf16, WS_GK) + off, xn); else store8(WSP(bf16, WS_GV) + off, x);
        }
        if (lat) {
            load8(row + 1024 + 8 * l, x); headnorm8<8>(x, gdq); rope8(x, r64 + ((size_t)t * 32 + c64 / 2) * 2);
            store8(WSP(bf16, WS_DQ) + ((size_t)(b * 8 + (l >> 3)) * 2048 + t) * 64 + c64, x);
        }
        {
            load8(row + 1536 + 8 * l, x); headnorm8<8>(x, gdk); if (lat) rope8(x, r64 + ((size_t)t * 32 + c64 / 2) * 2);
            store8(WSP(bf16, WS_DK) + ((size_t)(b * 8 + (l >> 3)) * 2304 + pos) * 64 + c64, x);
        }
        {
            load8(row + 2048 + 8 * l, x);
            store8(WSP(bf16, WS_DV) + ((size_t)(b * 4 + (l >> 4)) * 2304 + pos) * 128 + c128, x);
        }
    }
}

namespace attn {
constexpr int DV = 128, NW = 8, QBLK = 32, KVBLK = 64, SKV = 2304;
constexpr float THR = 8.f;
constexpr int SHM_V = KVBLK * DV * 2, SHM_K = KVBLK * 128 * 2;
#define KSWZ(row, colB) ((row) * 256 + ((colB) ^ (((row) & 7) << 4)))
#define SBAR() __builtin_amdgcn_sched_barrier(0)
__device__ __forceinline__ int crow(int r, int hi) { return (r & 3) + 8 * (r >> 2) + 4 * hi; }
__device__ __forceinline__ unsigned cvtpk(float lo, float hi) { return pk2(lo, hi); }
template <int NQ> struct Cst { static constexpr float SCALE = NQ == 8 ? 0.088388347648318440f : 0.125f; };
template <int NQ>
__device__ __forceinline__ void partialSM(f32x16& p0, f32x16& p1, float& m_reg, float& mn, float& alpha) {
    constexpr float SCALE = Cst<NQ>::SCALE; constexpr float C = SCALE * 1.4426950408889634f;
    float pmax = p0[0];
#pragma unroll
    for (int r = 1; r < 16; ++r) pmax = fmaxf(pmax, p0[r]);
#pragma unroll
    for (int r = 0; r < 16; ++r) pmax = fmaxf(pmax, p1[r]);
    { auto rr = __builtin_amdgcn_permlane32_swap(__float_as_uint(pmax), __float_as_uint(pmax), false, false);
      pmax = fmaxf(__uint_as_float(rr[0]), __uint_as_float(rr[1])); }
    if (__builtin_expect(__all(pmax - m_reg <= THR / SCALE), 1)) { mn = m_reg; alpha = 1.f; }
    else { mn = fmaxf(m_reg, pmax); alpha = __builtin_amdgcn_exp2f((m_reg - mn) * C); m_reg = mn; }
    const float mnC = -mn * C;
#pragma unroll
    for (int r = 0; r < 16; ++r) p0[r] = fmaf(p0[r], C, mnC);
#pragma unroll
    for (int r = 0; r < 16; ++r) p1[r] = fmaf(p1[r], C, mnC);
#pragma unroll
    for (int r = 0; r < 16; ++r) p0[r] = __builtin_amdgcn_exp2f(p0[r]);
}
__device__ __forceinline__ void finishSM(f32x16& p0, f32x16& p1, float alpha, float& l_reg, bf16x8& pa0, bf16x8& pa1, bf16x8& pa2, bf16x8& pa3) {
#pragma unroll
    for (int r = 0; r < 16; ++r) p1[r] = __builtin_amdgcn_exp2f(p1[r]);
    float ps = 0;
#pragma unroll
    for (int r = 0; r < 16; ++r) ps += p0[r];
#pragma unroll
    for (int r = 0; r < 16; ++r) ps += p1[r];
    { auto rr = __builtin_amdgcn_permlane32_swap(__float_as_uint(ps), __float_as_uint(ps), false, false);
      ps = __uint_as_float(rr[0]) + __uint_as_float(rr[1]); }
    l_reg = l_reg * alpha + ps;
#define PK4(PP, BASE, OUT) do { unsigned a0 = cvtpk(PP[BASE + 0], PP[BASE + 1]), a1 = cvtpk(PP[BASE + 2], PP[BASE + 3]);   \
    unsigned b0 = cvtpk(PP[BASE + 4], PP[BASE + 5]), b1 = cvtpk(PP[BASE + 6], PP[BASE + 7]);                              \
    auto r0 = __builtin_amdgcn_permlane32_swap(a0, b0, false, false); auto r1 = __builtin_amdgcn_permlane32_swap(a1, b1, false, false); \
    u32x4 w = {r0[0], r1[0], r0[1], r1[1]}; OUT = *reinterpret_cast<bf16x8*>(&w); } while (0)
    PK4(p0, 0, pa0); PK4(p0, 8, pa1); PK4(p1, 0, pa2); PK4(p1, 8, pa3);
#undef PK4
}
template <int NQ>
__device__ __forceinline__ void qkt(f32x16& p0, f32x16& p1, const char* Ks, const bf16x8* qr, int r32, int hi) {
    p0 = f32x16{}; p1 = f32x16{};
#pragma unroll
    for (int d0 = 0; d0 < NQ; ++d0) { const int cb = (d0 * 16 + hi * 8) * 2;
        const bf16x8 b0 = *reinterpret_cast<const bf16x8*>(Ks + KSWZ(r32, cb));
        const bf16x8 b1 = *reinterpret_cast<const bf16x8*>(Ks + KSWZ(32 + r32, cb));
        p0 = __builtin_amdgcn_mfma_f32_32x32x16_bf16(b0, qr[d0], p0, 0, 0, 0);
        p1 = __builtin_amdgcn_mfma_f32_32x32x16_bf16(b1, qr[d0], p1, 0, 0, 0); }
}
__device__ __forceinline__ int v_st(int k, int c) { const int kk = (k & ~0xC) | ((k & 4) << 1) | ((k & 8) >> 1); return ((kk >> 3) * 4 + (c >> 5)) * 512 + ((kk & 7) * 32 + (c & 31)) * 2; }
__device__ __forceinline__ int v_rd_base(int lane) { return ((lane & 3) << 3) | (((lane >> 2) & 3) << 6) | (((lane >> 4) & 1) << 5) | (((lane >> 5) & 1) << 8); }
constexpr int v_rd_off(int d0, int ks, int half) { return d0 * 512 + ks * 4096 + half * 2048; }
template <int OFF> __device__ __forceinline__ s16x4 tr_read(int vb) {
    s16x4 r; asm volatile("ds_read_b64_tr_b16 %0, %1 offset:%2" : "=&v"(r) : "v"(vb), "i"(OFF) : "memory"); return r;
}
template <int D0> __device__ __forceinline__ void pv_one(f32x16& od, int vb, bf16x8 pa0, bf16x8 pa1, bf16x8 pa2, bf16x8 pa3) {
    const s16x4 l0 = tr_read<v_rd_off(D0, 0, 0)>(vb), h0 = tr_read<v_rd_off(D0, 0, 1)>(vb), l1 = tr_read<v_rd_off(D0, 1, 0)>(vb), h1 = tr_read<v_rd_off(D0, 1, 1)>(vb);
    const s16x4 l2 = tr_read<v_rd_off(D0, 2, 0)>(vb), h2 = tr_read<v_rd_off(D0, 2, 1)>(vb), l3 = tr_read<v_rd_off(D0, 3, 0)>(vb), h3 = tr_read<v_rd_off(D0, 3, 1)>(vb);
    asm volatile("s_waitcnt lgkmcnt(0)" ::: "memory"); SBAR();
#define PKV(L, H) (bf16x8){L[0], L[1], L[2], L[3], H[0], H[1], H[2], H[3]}
    od = __builtin_amdgcn_mfma_f32_32x32x16_bf16(pa0, PKV(l0, h0), od, 0, 0, 0);
    od = __builtin_amdgcn_mfma_f32_32x32x16_bf16(pa1, PKV(l1, h1), od, 0, 0, 0);
    od = __builtin_amdgcn_mfma_f32_32x32x16_bf16(pa2, PKV(l2, h2), od, 0, 0, 0);
    od = __builtin_amdgcn_mfma_f32_32x32x16_bf16(pa3, PKV(l3, h3), od, 0, 0, 0);
#undef PKV
}
__device__ __forceinline__ void pv_d0(f32x16* o, int vb, bf16x8 pa0, bf16x8 pa1, bf16x8 pa2, bf16x8 pa3) {
    pv_one<0>(o[0], vb, pa0, pa1, pa2, pa3); pv_one<1>(o[1], vb, pa0, pa1, pa2, pa3); pv_one<2>(o[2], vb, pa0, pa1, pa2, pa3); pv_one<3>(o[3], vb, pa0, pa1, pa2, pa3);
}
template <int NQ, int EPI>
__device__ __forceinline__ void attn_body(const bf16* __restrict__ Qb, const bf16* __restrict__ Kh, const bf16* __restrict__ Vh, bf16* __restrict__ Y, float* scratch, float lam, const float* dgain, char* lds) {
    constexpr int LDQ = NQ * 16, LDK = NQ * 16, LDV = DV;
    const int tid = threadIdx.x, wid = __builtin_amdgcn_readfirstlane(tid >> 6), lane = tid & 63, r32 = lane & 31, hi = lane >> 5;
    char* V_lds = lds; char* K_lds = lds + 2 * SHM_V;
    float* wsf = (float*)(lds + 2 * SHM_V + 2 * SHM_K) + wid * 64; float* li_l = wsf; float* al_l = wsf + 32;
    float m_reg = -1e30f, l_reg = 0; f32x16 o[4] = {}; bf16x8 qr[NQ];
    const bf16* Qw = Qb + (size_t)(wid * QBLK + r32) * LDQ + hi * 8;
#pragma unroll
    for (int d0 = 0; d0 < NQ; ++d0) qr[d0] = *reinterpret_cast<const bf16x8*>(Qw + d0 * 16);
    const int sr = tid >> 4, sc = (tid & 15) * 8, vst0 = v_st(sr, sc), vst1 = v_st(32 + sr, sc);
    const int kr = NQ == 8 ? sr : (tid >> 3), kc = NQ == 8 ? sc : (tid & 7) * 8;
    const int vb0 = (int)(uintptr_t)V_lds + v_rd_base(lane);
    struct { bf16x8 vs0, vs1, ks0, ks1; } sr_[2];
    const unsigned voff0 = (unsigned)(sr * LDV + sc) * 2u, voff1 = voff0 + 32u * LDV * 2u, koff0 = (unsigned)(kr * LDK + kc) * 2u, koff1 = koff0 + 32u * LDK * 2u;
#define SLOAD(i, k0) do { const char* _vb = (const char*)Vh + (size_t)(k0) * (LDV * 2); const char* _kb = (const char*)Kh + (size_t)(k0) * (LDK * 2); \
    sr_[i].vs0 = *reinterpret_cast<const bf16x8*>(_vb + voff0); sr_[i].vs1 = *reinterpret_cast<const bf16x8*>(_vb + voff1); \
    sr_[i].ks0 = *reinterpret_cast<const bf16x8*>(_kb + koff0); if (NQ == 8) sr_[i].ks1 = *reinterpret_cast<const bf16x8*>(_kb + koff1); } while (0)
#define SWRITE(b, i) do { *(bf16x8*)(V_lds + (b) * SHM_V + vst0) = sr_[i].vs0; *(bf16x8*)(V_lds + (b) * SHM_V + vst1) = sr_[i].vs1; \
    *(bf16x8*)(K_lds + (b) * SHM_K + KSWZ(kr, kc * 2)) = sr_[i].ks0; if (NQ == 8) *(bf16x8*)(K_lds + (b) * SHM_K + KSWZ(32 + kr, kc * 2)) = sr_[i].ks1; } while (0)
#define SWAIT() do { if (NQ == 8) asm volatile("s_waitcnt vmcnt(4)" ::: "memory"); else asm volatile("s_waitcnt vmcnt(3)" ::: "memory"); } while (0)
#define RESC(a) do { if (__any((a) < 1.f)) { if (hi == 0) al_l[r32] = (a); asm volatile("s_waitcnt lgkmcnt(0)" ::: "memory"); \
    _Pragma("unroll") for (int d = 0; d < 4; ++d) _Pragma("unroll") for (int r = 0; r < 16; ++r) o[d][r] *= al_l[crow(r, hi)]; } } while (0)
    f32x16 pA0, pA1, pB0, pB1; float mnA, mnB, alA, alB; bf16x8 pa0, pa1, pa2, pa3; constexpr int NT = SKV / KVBLK;
    constexpr int SE = 0, SO = 1;
    SLOAD(SE, 0); asm volatile("s_waitcnt vmcnt(0)" ::: "memory"); SWRITE(0, SE); __syncthreads();
    qkt<NQ>(pA0, pA1, K_lds, qr, r32, hi); partialSM<NQ>(pA0, pA1, m_reg, mnA, alA);
    SLOAD(SO, KVBLK); SLOAD(SE, 2 * KVBLK);
    SWAIT(); SWRITE(1, SO); __syncthreads();
    for (int j = 1; j + 1 < NT; j += 2) {
        SBAR(); qkt<NQ>(pB0, pB1, K_lds + SHM_K, qr, r32, hi);
        finishSM(pA0, pA1, alA, l_reg, pa0, pa1, pa2, pa3); SBAR();
        SLOAD(SO, (j + 2) * KVBLK); SBAR();
        pv_d0(o, vb0, pa0, pa1, pa2, pa3); partialSM<NQ>(pB0, pB1, m_reg, mnB, alB);
        __syncthreads(); SWAIT(); SWRITE(0, SE);
        RESC(alB); __syncthreads();
        SBAR(); qkt<NQ>(pA0, pA1, K_lds, qr, r32, hi);
        finishSM(pB0, pB1, alB, l_reg, pa0, pa1, pa2, pa3); SBAR();
        if (j + 3 < NT) SLOAD(SE, (j + 3) * KVBLK); SBAR();
        pv_d0(o, vb0 + (int)SHM_V, pa0, pa1, pa2, pa3); partialSM<NQ>(pA0, pA1, m_reg, mnA, alA);
        __syncthreads(); SWAIT(); SWRITE(1, SO);
        RESC(alA); __syncthreads();
    }
    SBAR(); qkt<NQ>(pB0, pB1, K_lds + SHM_K, qr, r32, hi);
    finishSM(pA0, pA1, alA, l_reg, pa0, pa1, pa2, pa3); SBAR();
    pv_d0(o, vb0, pa0, pa1, pa2, pa3); partialSM<NQ>(pB0, pB1, m_reg, mnB, alB);
    __syncthreads(); RESC(alB);
    finishSM(pB0, pB1, alB, l_reg, pa0, pa1, pa2, pa3); SBAR();
    pv_d0(o, vb0 + (int)SHM_V, pa0, pa1, pa2, pa3);
    if (hi == 0) li_l[r32] = l_reg; asm volatile("s_waitcnt lgkmcnt(0)" ::: "memory");
    float rli[16];
#pragma unroll
    for (int r = 0; r < 16; ++r) rli[r] = __builtin_amdgcn_rcpf(li_l[crow(r, hi)]);
    if (EPI == 0) {
        bf16* Yw = Y + (size_t)(wid * QBLK) * 1024;
#pragma unroll
        for (int r = 0; r < 16; ++r) { const int orow = crow(r, hi);
#pragma unroll
            for (int d0 = 0; d0 < 4; ++d0) Yw[(size_t)orow * 1024 + d0 * 32 + r32] = (bf16)(pk2(o[d0][r] * rli[r], 0.f) & 0xffffu); }
    } else if (EPI == 1) {
#pragma unroll
        for (int r = 0; r < 16; ++r)
#pragma unroll
            for (int d0 = 0; d0 < 4; ++d0) scratch[((wid * 16 + r) * 4 + d0) * 64 + lane] = o[d0][r] * rli[r];
    } else {
        bf16* Yw = Y + (size_t)(wid * QBLK) * 1024; float gn[4];
#pragma unroll
        for (int d0 = 0; d0 < 4; ++d0) gn[d0] = dgain[d0 * 32 + r32] * (1.0f - LAM_INIT);
#pragma unroll
        for (int r = 0; r < 16; ++r) { float od[4]; float ss = 0.f;
#pragma unroll
            for (int d0 = 0; d0 < 4; ++d0) { od[d0] = scratch[((wid * 16 + r) * 4 + d0) * 64 + lane] - lam * (o[d0][r] * rli[r]); ss += od[d0] * od[d0]; }
#pragma unroll
            for (int of = 1; of < 32; of <<= 1) ss += __shfl_xor(ss, of);
            const float rstd = rsqrtf(ss * (1.0f / 128.0f) + NORM_EPS); const int orow = crow(r, hi);
#pragma unroll
            for (int d0 = 0; d0 < 4; ++d0) Yw[(size_t)orow * 1024 + d0 * 32 + r32] = (bf16)(pk2(od[d0] * rstd * gn[d0], 0.f) & 0xffffu); }
    }
#undef SLOAD
#undef SWRITE
#undef SWAIT
#undef RESC
}
}
__device__ __forceinline__ void phase_attn(const Params& P, Frame& F) {
    char* lds = (char*)(unsigned char*)F.lds;
    float lam; { const float* lp = P.in[I_DLAMBDA]; const float a = wave_sum(lp[F.lane] * lp[64 + F.lane]), b = wave_sum(lp[128 + F.lane] * lp[192 + F.lane]); lam = __expf(a) - __expf(b) + LAM_INIT; }
    const int u = F.vcu; const int b = u >> 5, h = (u >> 3) & 3, qb = u & 7;
    bf16* Y = WSP(bf16, WS_ABF) + (size_t)(b * 2048 + qb * 256) * 1024;
#ifndef ATTN_TEST
#define ATTN_TEST 7
#endif
    if (ATTN_TEST & 1) {
        const bf16* Q = WSP(bf16, WS_GQ) + ((size_t)(b * 4 + h) * 2048 + qb * 256) * 128;
        const bf16* K = WSP(bf16, WS_GK) + (size_t)(b * 2 + (h >> 1)) * 2304 * 128; const bf16* V = WSP(bf16, WS_GV) + (size_t)(b * 2 + (h >> 1)) * 2304 * 128;
        attn::attn_body<8, 0>(Q, K, V, Y + h * 128, nullptr, 0.f, nullptr, lds);
        __syncthreads();
    }
    {
        float* scr = WSP(float, WS_O0) + (size_t)F.bid * 32768;
        const bf16* V = WSP(bf16, WS_DV) + (size_t)(b * 4 + h) * 2304 * 128;
        const bf16* Q0 = WSP(bf16, WS_DQ) + ((size_t)(b * 8 + 2 * h) * 2048 + qb * 256) * 64; const bf16* K0 = WSP(bf16, WS_DK) + (size_t)(b * 8 + 2 * h) * 2304 * 64;
        if (ATTN_TEST & 2) attn::attn_body<4, 1>(Q0, K0, V, nullptr, scr, 0.f, nullptr, lds);
        __syncthreads();
        if (ATTN_TEST & 4) attn::attn_body<4, 2>(Q0 + (size_t)2048 * 64, K0 + (size_t)2304 * 64, V, Y + 512 + h * 128, scr, lam, P.in[I_DGAIN], lds);
        __syncthreads();
    }
}
#ifndef MK_N_LAUNCHES
#define MK_N_LAUNCHES 1
#endif
constexpr int N_PHASES = 20;
__global__ void __launch_bounds__(NTHR, 2) hybrid_fwd(Params P) {
    extern __shared__ __attribute__((aligned(16))) unsigned char lds_raw[];
    Frame F;
    F.lds = (LAS unsigned char*)lds_raw; F.ws = P.ws;
    F.tid = threadIdx.x; F.lane = F.tid & 63; F.wave = __builtin_amdgcn_readfirstlane(F.tid >> 6);
    F.bid = blockIdx.x; F.vcu = (F.bid & 7) * 32 + (F.bid >> 3);
    volatile LAS unsigned* MISC = (volatile LAS unsigned*)(F.lds + MISC_OFF);
    for (int u = F.tid; u < (LDS_BYTES - LDSCTL_OFF) / 4; u += NTHR) ((LAS unsigned*)(F.lds + LDSCTL_OFF))[u] = 0u;
    __syncthreads();
    XcdBarrier bar; bar.bar = (unsigned*)(P.ws + WS_CTL) + CW_BAR; bar.x = 0; bar.st = nullptr;
    const int lo = P.ph_lo, hi = P.ph_hi;
    if (hi - lo > 1) bar = xcd_barrier_post((unsigned*)(P.ws + WS_CTL) + CW_BAR, MISC + 8);
#ifndef PHASE_MASK
#define PHASE_MASK 0xFFFFF
#endif
#define IN(k) (((PHASE_MASK >> (k)) & 1) && lo <= (k) && (k) < hi)
#ifndef DUP_MASK
#define DUP_MASK 0
#endif
#define REP(k)
#define SEAM(k) do { if (IN(k) && IN((k) + 1)) xcd_barrier(bar); } while (0)
    const float* mod = WSP(float, WS_MOD);
    if (IN(0)) REP(0) { phase_pre(P, F); } SEAM(0);
    if (IN(1)) REP(1) { phase_norm0(P, F); } SEAM(1);
    if (IN(2)) REP(2) {
        pg8::DenseOrder<1024> S; S.init(WSP(signed char, WS_A8), WSP(signed char, WS_WT_RECIN), NTOK, REC_IN, F.bid);
        pg8::EpiRecIn<true> E{WSP(bf16, WS_PROJ), WSP(float, WS_FF), WSP(float, WS_LB), WSP(float, WS_ROPE64), WSP(float, WS_ASC), WSP(float, WS_SDN)};
        pg8::gemm_phase(F.lds, S, E);
    } SEAM(2);
    if (IN(3)) REP(3) { phase_rec(P, F); } SEAM(3);
    if (IN(4)) REP(4) { phase_merge(P, F); } SEAM(4);
    if (IN(5)) REP(5) {
        pg8::DenseOrder<1024> S; S.init(WSP(signed char, WS_A8), WSP(signed char, WS_WT_RECOUT), NTOK, DM, F.bid);
        pg8::EpiResidual<true> E{P.in[I_X], P.in[I_CTX], WSP(float, WS_H1), mod + 2 * 1024, WSP(float, WS_ASC), WSP(float, WS_SDN) + 4096};
        pg8::gemm_phase(F.lds, S, E);
    } SEAM(5);
    if (IN(6)) REP(6) { phase_route<NTOK, 0>(P, F, WSP(float, WS_H1)); } SEAM(6);
    if (IN(7)) REP(7) { phase_scatter<NTOK>(P, F); } SEAM(7);
    if (IN(8)) REP(8) {
        pg8::MoeOrder<8, true, 1024> S{(const char*)WSP(bf16, WS_XS), (const char*)WSP(bf16, WS_WT_GU), WSP(int, WS_BLKE), 0, F.vcu};
        S.nrb = __builtin_amdgcn_readfirstlane(__hip_atomic_load(WSP(int, WS_BLKE) + MAXRB, RLX_AGENT));
        pg8::EpiSwigluI8 E{WSP(bf16, WS_H1S), P.in[I_B_GU], WSP(float, WS_RSC), WSP(float, WS_SGU)};
        pg8::gemm_phase(F.lds, S, E);
    } SEAM(8);
    if (IN(9)) REP(9) {
        pg8::MoeOrder<4, false, 2048> S{(const char*)WSP(bf16, WS_H1S), (const char*)WSP(bf16, WS_WT_DN), WSP(int, WS_BLKE), 0, F.vcu};
        S.nrb = __builtin_amdgcn_readfirstlane(__hip_atomic_load(WSP(int, WS_BLKE) + MAXRB, RLX_AGENT));
        pg8::EpiMoeOut E{WSP(bf16, WS_YS), P.in[I_B_DOWN], WSP(int, WS_RTOK), WSP(float, WS_RGATE)};
        pg8::gemm_phase(F.lds, S, E);
    } SEAM(9);
    if (IN(10)) REP(10) { phase_norm1(P, F); } SEAM(10);
    if (IN(11)) REP(11) {
        pg8::DenseOrder<1024> S; S.init(WSP(signed char, WS_A8), WSP(signed char, WS_WT_ATTIN), NTOK, ATT_IN, F.bid);
        pg8::EpiBf16<true> E{WSP(bf16, WS_PROJ), ATT_IN, WSP(float, WS_ASC), WSP(float, WS_SDN) + 5120};
        pg8::gemm_phase(F.lds, S, E);
    } SEAM(11);
    if (IN(12)) REP(12) { phase_qkv(P, F); } SEAM(12);
    if (IN(13)) REP(13) { phase_attn(P, F); } SEAM(13);
    if (IN(14)) REP(14) {
        pg8::DenseOrder<2048> S; S.init(WSP(bf16, WS_ABF), WSP(bf16, WS_WT_ATTOUT), NLAT, DM, F.bid);
        pg8::EpiResidual<false> E{WSP(float, WS_H2), WSP(float, WS_H2) + (size_t)NLAT * 1024, WSP(float, WS_H3), mod + 9 * 6144 + 2 * 1024, nullptr, nullptr};
        pg8::gemm_phase(F.lds, S, E);
    } SEAM(14);
    if (IN(15)) REP(15) { phase_route<NLAT, 1>(P, F, WSP(float, WS_H3)); } SEAM(15);
    if (IN(16)) REP(16) { phase_scatter<NLAT>(P, F); } SEAM(16);
    if (IN(17)) REP(17) {
        pg8::MoeOrder<8, true, 1024> S{(const char*)WSP(bf16, WS_XS), (const char*)(WSP(signed char, WS_WT_GU) + (size_t)32 * 2048 * 1024), WSP(int, WS_BLKE), 0, F.vcu};
        S.nrb = __builtin_amdgcn_readfirstlane(__hip_atomic_load(WSP(int, WS_BLKE) + MAXRB, RLX_AGENT));
        pg8::EpiSwigluI8 E{WSP(bf16, WS_H1S), P.in[I_B_GU] + 32 * 2048, WSP(float, WS_RSC), WSP(float, WS_SGU) + 32 * 2048};
        pg8::gemm_phase(F.lds, S, E);
    } SEAM(17);
    if (IN(18)) REP(18) {
        pg8::MoeOrder<4, false, 2048> S{(const char*)WSP(bf16, WS_H1S), (const char*)(WSP(bf16, WS_WT_DN) + (size_t)32 * 1024 * 1024), WSP(int, WS_BLKE), 0, F.vcu};
        S.nrb = __builtin_amdgcn_readfirstlane(__hip_atomic_load(WSP(int, WS_BLKE) + MAXRB, RLX_AGENT));
        pg8::EpiMoeOut E{WSP(bf16, WS_YS), P.in[I_B_DOWN] + 32 * 1024, WSP(int, WS_RTOK), WSP(float, WS_RGATE)};
        pg8::gemm_phase(F.lds, S, E);
    } SEAM(18);
    if (IN(19)) REP(19) { phase_final(P, F); }
#undef IN
#undef SEAM
}

extern "C" void kernel_launch(void* const* d_in, const int* in_sizes, int n_in, void* d_out, int out_size, void* d_ws, size_t ws_size, hipStream_t stream) {
    static int grid = 0;
    if (grid == 0) {
        if (n_in != 27 || out_size != NLAT * DM || ws_size < WS_END) { fprintf(stderr, "kernel_launch: unexpected shapes: n_in %d out %d ws %zu (need >= %zu)\n", n_in, out_size, ws_size, (size_t)WS_END); grid = -1; return; }
        int dev = 0, cus = 0;
        if (hipGetDevice(&dev) != hipSuccess || hipDeviceGetAttribute(&cus, hipDeviceAttributeMultiprocessorCount, dev) != hipSuccess) { grid = -1; return; }
        if (hipFuncSetAttribute((const void*)hybrid_fwd, hipFuncAttributeMaxDynamicSharedMemorySize, LDS_BYTES) != hipSuccess) { fprintf(stderr, "kernel_launch: hipFuncSetAttribute failed\n"); grid = -1; return; }
        if (cus != 256) fprintf(stderr, "kernel_launch: %d CUs (built for 256)\n", cus);
        grid = 256;
    }
    if (grid < 0) return;
    if (hipMemsetAsync((char*)d_ws + WS_CTL, 0, CTL_ZERO_BYTES, stream) != hipSuccess) return;
    Params p{};
    for (int i = 0; i < 27; ++i) p.in[i] = (const float*)d_in[i];
    p.out = (float*)d_out; p.ws = (unsigned char*)d_ws;
#ifndef DBG_STAGE
#define DBG_STAGE 0
#endif
    const int n_ph = DBG_STAGE == 1 ? 6 : DBG_STAGE == 2 ? 11 : DBG_STAGE == 3 ? 15 : DBG_STAGE == 4 ? 3 : DBG_STAGE == 5 ? 3 : DBG_STAGE == 6 ? 4 : DBG_STAGE == 7 ? 2 : DBG_STAGE == 8 ? 1 : N_PHASES;
#if MK_N_LAUNCHES == 1
    p.ph_lo = 0; p.ph_hi = n_ph;
    hipLaunchKernelGGL(hybrid_fwd, dim3(grid), dim3(NTHR), LDS_BYTES, stream, p);
#else
    for (int k = 0; k < n_ph; ++k) for (int rep = 0; rep < (((DUP_MASK >> k) & 1) ? 2 : 1); ++rep) { p.ph_lo = k; p.ph_hi = k + 1; hipLaunchKernelGGL(hybrid_fwd, dim3(grid), dim3(NTHR), LDS_BYTES, stream, p); }
#endif
    if (DBG_STAGE) { const size_t off = DBG_STAGE == 1 ? WS_H1 : DBG_STAGE == 2 ? WS_H2 : DBG_STAGE == 3 ? WS_H3 : DBG_STAGE == 4 ? WS_FF : DBG_STAGE == 5 ? WS_PROJ : DBG_STAGE == 6 ? WS_OREC : DBG_STAGE == 7 ? WS_ABF : WS_WT_GU; (void)hipMemcpyAsync(d_out, (char*)d_ws + off, DBG_STAGE == 7 ? (size_t)36 * MiB : (size_t)NLAT * DM * 4, hipMemcpyDeviceToDevice, stream); }
}
```

```cpp
#include <hip/hip_runtime.h>
#include <cstdio>
#include <cstdint>

#define GAS __attribute__((address_space(1)))
#define LAS __attribute__((address_space(3)))
typedef unsigned short bf16;
typedef float f32x2 __attribute__((ext_vector_type(2)));
typedef float f32x4 __attribute__((ext_vector_type(4)));
typedef float f32x16 __attribute__((ext_vector_type(16)));
typedef unsigned u32x2 __attribute__((ext_vector_type(2)));
typedef unsigned u32x4 __attribute__((ext_vector_type(4)));
typedef short bf16x8 __attribute__((ext_vector_type(8)));
typedef short s16x4 __attribute__((ext_vector_type(4)));

constexpr int BATCH = 8, SEQ = 2048, CTXL = 256, DM = 1024;
constexpr int NLAT = BATCH * SEQ, NCTX = BATCH * CTXL, NTOK = NLAT + NCTX;
constexpr int REC_IN = 4096, ATT_IN = 2560, NEXP = 32, MAXRB = 320;
constexpr float NORM_EPS = 1e-6f;
constexpr float LAM_INIT = 0.35550906759f;
constexpr int NWAVES = 8, NTHR = 512;

constexpr size_t MiB = 1u << 20;
constexpr size_t WS_CTL = 0, CTL_ZERO_BYTES = 1 * MiB;
constexpr size_t WS_MOD = 1 * MiB;
constexpr size_t WS_LB = 2 * MiB;
constexpr size_t WS_ROPE64 = 2 * MiB + 65536;
constexpr size_t WS_ROPE128 = 3 * MiB;
constexpr size_t WS_TOPE = 4 * MiB;
constexpr size_t WS_TOPG = WS_TOPE + 512 * 1024;
constexpr size_t WS_RANK = WS_TOPG + 512 * 1024;
constexpr size_t WS_BCNT = WS_RANK + 512 * 1024;
constexpr size_t WS_RTOK = WS_BCNT + 64 * 1024;
constexpr size_t WS_RGATE = WS_RTOK + 512 * 1024;
constexpr size_t WS_BLKE = WS_RGATE + 512 * 1024;
constexpr size_t WS_SGU = 7 * MiB;
constexpr size_t WS_FSC = 7 * MiB + 512 * 1024;
constexpr size_t WS_RSC = 7 * MiB + 640 * 1024;
constexpr size_t WS_SDN = 26 * MiB;
constexpr size_t WS_ASC = 26 * MiB + 65536;
constexpr size_t WS_WT_RECIN = 8 * MiB, WS_WT_RECOUT = 16 * MiB, WS_WT_ATTIN = 18 * MiB, WS_WT_ATTOUT = 24 * MiB;
constexpr size_t WS_WT_GU = 32 * MiB, WS_WT_DN = 288 * MiB;
constexpr size_t WS_ABF = 416 * MiB, WS_PROJ = 452 * MiB, WS_FF = 596 * MiB, WS_OREC = 668 * MiB;
constexpr size_t WS_H1 = 740 * MiB, WS_H2 = 812 * MiB, WS_H3 = 884 * MiB;
constexpr size_t WS_XS = 948 * MiB, WS_H1S = 1108 * MiB, WS_YS = 1268 * MiB;
constexpr size_t WS_F8 = WS_XS + 80 * MiB;
constexpr size_t WS_A8 = WS_XS + 100 * MiB;
constexpr size_t WS_GQ = 1412 * MiB, WS_GK = 1428 * MiB, WS_GV = 1438 * MiB, WS_DQ = 1448 * MiB, WS_DK = 1464 * MiB, WS_DV = 1482 * MiB, WS_O0 = 1500 * MiB;
constexpr size_t WS_END = 1532 * MiB;
constexpr int CW_BAR = 4096;

constexpr int RING_BYTES = 131072;
constexpr int LDSCTL_OFF = RING_BYTES, MISC_OFF = LDSCTL_OFF + 320;
constexpr int LDS_BYTES = 147456;

#define RLX_AGENT __ATOMIC_RELAXED, __HIP_MEMORY_SCOPE_AGENT
#define LDS_WAIT() asm volatile("s_waitcnt lgkmcnt(0)" ::: "memory")
#define VM_WAIT() asm volatile("s_waitcnt vmcnt(0)" ::: "memory")

__device__ __forceinline__ float bf2f(unsigned u) { return __uint_as_float(u << 16); }
__device__ __forceinline__ float bflo(unsigned w) { return __uint_as_float(w << 16); }
__device__ __forceinline__ float bfhi(unsigned w) { return __uint_as_float(w & 0xffff0000u); }
typedef __bf16 bf16x2_t __attribute__((ext_vector_type(2)));
__device__ __forceinline__ unsigned pk2(float lo, float hi) { f32x2 v = {lo, hi}; bf16x2_t b = __builtin_convertvector(v, bf16x2_t); return __builtin_bit_cast(unsigned, b); }
__device__ __forceinline__ float wave_sum(float v) {
#pragma unroll
    for (int o = 1; o < 64; o <<= 1) v += __shfl_xor(v, o);
    return v;
}
__device__ __forceinline__ float fsigmoid(float x) { return __builtin_amdgcn_rcpf(1.0f + __builtin_amdgcn_exp2f(-1.4426950408889634f * x)); }
__device__ __forceinline__ float fsilu(float x) { return x * fsigmoid(x); }

__device__ __forceinline__ unsigned q8pack(float a, float b, float c, float d, float inv) {
    int q0 = (int)rintf(a * inv), q1 = (int)rintf(b * inv), q2 = (int)rintf(c * inv), q3 = (int)rintf(d * inv);
    q0 = q0 > 127 ? 127 : (q0 < -127 ? -127 : q0); q1 = q1 > 127 ? 127 : (q1 < -127 ? -127 : q1); q2 = q2 > 127 ? 127 : (q2 < -127 ? -127 : q2); q3 = q3 > 127 ? 127 : (q3 < -127 ? -127 : q3);
    return (unsigned)(q0 & 255) | ((unsigned)(q1 & 255) << 8) | ((unsigned)(q2 & 255) << 16) | ((unsigned)(q3 & 255) << 24);
}
__device__ __forceinline__ float wave_max(float v) {
#pragma unroll
    for (int o = 1; o < 64; o <<= 1) v = fmaxf(v, __shfl_xor(v, o));
    return v;
}
#define XB_TMO      128
#define XB_XCNT(j)  (256  + 64 * (j))
#define XB_XSUB(j)  (1280 + 64 * (j))
#define XB_XGEN(j)  (2304 + 64 * (j))
#define XB_TOP      3328
#define XB_TOPGEN   3392
#define XCD_BAR_WORDS 3456
#define XB_SPIN_CAP (1u << 18)
__device__ __forceinline__ unsigned xb_ld(unsigned* p)              { return __hip_atomic_load(p, __ATOMIC_RELAXED, __HIP_MEMORY_SCOPE_AGENT); }
__device__ __forceinline__ unsigned xb_add(unsigned* p, unsigned v) { return __hip_atomic_fetch_add(p, v, __ATOMIC_RELAXED, __HIP_MEMORY_SCOPE_AGENT); }
__device__ __forceinline__ unsigned xb_xcc_id() { return (unsigned)__builtin_amdgcn_s_getreg((3 << 11) | 20) & 0xFu; }
#define XB_SPIN(cond, bar) do { unsigned _sp = 0; while (cond) { __builtin_amdgcn_s_sleep(1); \
    if ((++_sp & 255u) == 0u) { if (xb_ld(&(bar)[XB_TMO])) break; if (_sp > XB_SPIN_CAP) { atomicAdd(&(bar)[XB_TMO], 1u); break; } } } } while (0)
struct XcdBarrier { unsigned* bar; unsigned x; volatile LAS unsigned* st; };
__device__ __forceinline__ XcdBarrier xcd_barrier_post(unsigned* bar, volatile LAS unsigned* st) {
    XcdBarrier b; b.bar = bar; b.x = xb_xcc_id(); b.st = st;
    if (threadIdx.x == 0) (void)xb_add(&bar[XB_XCNT(b.x)], 1u);
    return b;
}
__device__ __forceinline__ void xcd_barrier_complete(unsigned* bar, unsigned x, unsigned& nloc, unsigned& nx) {
    const unsigned G = gridDim.x * gridDim.y * gridDim.z;
    unsigned sum, cnt, mine, sp = 0u;
    for (;;) {
        sum = 0u; cnt = 0u; mine = 0u;
#pragma unroll
        for (unsigned j = 0; j < 16; ++j) { const unsigned c = xb_ld(&bar[XB_XCNT(j)]); sum += c; cnt += (c > 0u) ? 1u : 0u; mine = (j == x) ? c : mine; }
        if (sum == G) break;
        __builtin_amdgcn_s_sleep(1);
        if ((++sp & 255u) == 0u) { if (xb_ld(&bar[XB_TMO])) break; if (sp > XB_SPIN_CAP) { atomicAdd(&bar[XB_TMO], 1u); break; } }
    }
    nloc = mine > 0u ? mine : 1u; nx = cnt > 0u ? cnt : 1u;
}
__device__ __forceinline__ void xcd_barrier(const XcdBarrier& b) {
    asm volatile("s_waitcnt vmcnt(0)" ::: "memory");
    __syncthreads();
    if (threadIdx.x == 0) {
        unsigned* bar = b.bar;
        __builtin_amdgcn_s_waitcnt(0);
        unsigned nloc = b.st[0], nx = b.st[1];
        if (nloc == 0u) { xcd_barrier_complete(bar, b.x, nloc, nx); b.st[0] = nloc; b.st[1] = nx; }
        const unsigned old = xb_add(&bar[XB_XSUB(b.x)], 1u);
        const unsigned gen = old / nloc;
        if (old + 1u == (gen + 1u) * nloc) {
            __builtin_amdgcn_fence(__ATOMIC_RELEASE, "agent");
            asm volatile("s_waitcnt vmcnt(0)" ::: "memory");
            const unsigned og = xb_add(&bar[XB_TOP], 1u);
            const unsigned tg = og / nx;
            if (og + 1u == (tg + 1u) * nx) xb_add(&bar[XB_TOPGEN], 1u);
            else XB_SPIN(xb_ld(&bar[XB_TOPGEN]) == tg, bar);
            __builtin_amdgcn_fence(__ATOMIC_ACQUIRE, "agent");
            xb_add(&bar[XB_XGEN(b.x)], 1u);
            asm volatile("s_waitcnt vmcnt(0)" ::: "memory");
        } else {
            XB_SPIN(xb_ld(&bar[XB_XGEN(b.x)]) == gen, bar);
            __builtin_amdgcn_fence(__ATOMIC_ACQUIRE, "agent");
            asm volatile("s_waitcnt vmcnt(0)" ::: "memory");
        }
    }
    __syncthreads();
}

struct Params { const float* in[27]; float* out; unsigned char* ws; int ph_lo, ph_hi; };
struct Frame {
    LAS unsigned char* lds;
    unsigned char* ws;
    int tid, lane, wave, bid, vcu;
};
enum { I_X = 0, I_C, I_CTX, I_CCTX, I_NORM_MIX, I_NORM_FFN, I_W_ADA, I_B_ADA, I_REC_W_IN, I_REC_LB, I_REC_W_OUT, I_HG_GAIN, I_RET_GAIN,
       I_ATT_W_IN, I_ATT_W_OUT, I_ATT_Q_GAIN, I_ATT_K_GAIN, I_DQ_GAIN, I_DK_GAIN, I_DLAMBDA, I_DGAIN, I_W_ROUTER, I_B_ROUTER, I_W_GU, I_B_GU, I_W_DOWN, I_B_DOWN };
#define WSP(T, off) ((T*)(F.ws + (off)))
__device__ __forceinline__ int mod_row(int r) { return r < NLAT ? (r >> 11) : 8; }
__device__ __forceinline__ void pre_modulation(const Params& P, Frame& F) {
    LAS float* s = (LAS float*)F.lds;
    LAS float* red = (LAS float*)(F.lds + 36864);
    const float* c = P.in[I_C]; const float* cctx = P.in[I_CCTX];
    for (int idx = F.tid; idx < 9 * 1024; idx += NTHR) { const int r = idx >> 10, k = idx & 1023; const float cv = r < 8 ? c[r * 1024 + k] : cctx[k]; s[idx] = fsilu(cv); }
    __syncthreads();
    const int l = F.bid / 96, col0 = (F.bid % 96) * 64;
    const float* W = P.in[I_W_ADA] + (size_t)l * 1024 * 6144 + col0 + F.lane;
    float acc[9];
#pragma unroll
    for (int r = 0; r < 9; ++r) acc[r] = 0.f;
    const int k0 = F.wave * 128;
#pragma unroll 2
    for (int kk = 0; kk < 128; kk += 4) {
        float wv[4];
#pragma unroll
        for (int i = 0; i < 4; ++i) wv[i] = W[(size_t)(k0 + kk + i) * 6144];
#pragma unroll
        for (int r = 0; r < 9; ++r) { const f32x4 sv = *(const LAS f32x4*)(s + r * 1024 + k0 + kk); acc[r] += sv.x * wv[0] + sv.y * wv[1] + sv.z * wv[2] + sv.w * wv[3]; }
    }
#pragma unroll
    for (int r = 0; r < 9; ++r) red[(F.wave * 9 + r) * 64 + F.lane] = acc[r];
    __syncthreads();
    float* mod = WSP(float, WS_MOD);
    for (int idx = F.tid; idx < 9 * 64; idx += NTHR) { const int r = idx >> 6, cl = idx & 63; float t = P.in[I_B_ADA][l * 6144 + col0 + cl];
#pragma unroll
        for (int w = 0; w < 8; ++w) t += red[(w * 9 + r) * 64 + cl];
        mod[(size_t)(l * 9 + r) * 6144 + col0 + cl] = t; }
    __syncthreads();
}
__device__ __forceinline__ void pre_tables(const Params& P, Frame& F) {
    const int gt = F.bid * NTHR + F.tid, GT = 256 * NTHR;
    if (gt < 1024) { const float* lg = P.in[I_REC_LB]; const float a = lg[gt], b = lg[1024 + gt], c = lg[2048 + gt]; const float m = fmaxf(a, fmaxf(b, c));
        const float ea = expf(a - m), eb = expf(b - m), ec = expf(c - m); WSP(float, WS_LB)[gt] = ea / (ea + eb + ec); }
    for (int idx = gt; idx < 2048 * 96; idx += GT) {
        const int t = idx / 96, p = idx % 96; const int row = t >> 6, col = t & 63;
        float* dst; int axis_dim, pp;
        if (p < 32) { dst = WSP(float, WS_ROPE64) + ((size_t)t * 32 + p) * 2; axis_dim = 32; pp = p; }
        else { dst = WSP(float, WS_ROPE128) + ((size_t)t * 64 + (p - 32)) * 2; axis_dim = 64; pp = p - 32; }
        const int nf = axis_dim / 2; const int fi = pp < nf ? pp : pp - nf; const float pos = pp < nf ? (float)row : (float)col;
        const float inv = powf(10000.0f, -(float)(2 * fi) / (float)axis_dim); const float ang = pos * inv;
        dst[0] = cosf(ang); dst[1] = sinf(ang);
    }
}
constexpr int TI_ATTOUT = 256, TI_DN = 64 * 256;
constexpr int TI_TOTAL = TI_ATTOUT + TI_DN;
__device__ __forceinline__ void titem_decode(const Params& P, Frame& F, int it, const float*& src, bf16*& dst, int& N) {
    const float* m; bf16* d; int local;
    if (it < TI_ATTOUT) { N = 1024; m = P.in[I_ATT_W_OUT]; d = WSP(bf16, WS_WT_ATTOUT); local = it; }
    else { it -= TI_ATTOUT; N = 1024; const int mat = it >> 8; local = it & 255; m = P.in[I_W_DOWN] + (size_t)mat * 1024 * 1024; d = WSP(bf16, WS_WT_DN) + (size_t)mat * 1024 * 1024; }
    const int nblk = N >> 6, nb = local % nblk, kb = local / nblk;
    src = m + (size_t)(kb * 64) * N + nb * 64; dst = d + (size_t)(nb * 64) * 1024 + kb * 64;
}
__device__ __forceinline__ void pre_transposes(const Params& P, Frame& F) {
    LAS float* scr = (LAS float*)(F.lds + F.wave * 16384);
    const int gw = F.vcu * NWAVES + F.wave, NGW = 256 * NWAVES;
    const int lr = F.lane >> 4, lc = (F.lane & 15) * 4;
    f32x4 cur[16];
    const float* src; bf16* dst; int N;
    int it = gw;
    if (it < TI_TOTAL) { titem_decode(P, F, it, src, dst, N);
#pragma unroll
        for (int i = 0; i < 16; ++i) cur[i] = *(const f32x4*)(src + (size_t)(4 * i + lr) * N + lc); }
    while (it < TI_TOTAL) {
        const int itn = it + NGW; f32x4 nxt[16]; const float* srcn; bf16* dstn; int Nn;
        if (itn < TI_TOTAL) { titem_decode(P, F, itn, srcn, dstn, Nn);
#pragma unroll
            for (int i = 0; i < 16; ++i) nxt[i] = *(const f32x4*)(srcn + (size_t)(4 * i + lr) * Nn + lc); }
#pragma unroll
        for (int i = 0; i < 16; ++i) { const int k = 4 * i + lr; *(LAS f32x4*)(scr + k * 64 + (lc ^ (((k >> 3) & 7) << 2))) = cur[i]; }
        const int c = F.lane & 7;
#pragma unroll
        for (int j = 0; j < 8; ++j) { const int n = (F.lane >> 3) + 8 * j; const LAS float* sp = scr + (8 * c) * 64 + (n ^ (c << 2));
            u32x4 o; o.x = pk2(sp[0], sp[64]); o.y = pk2(sp[128], sp[192]); o.z = pk2(sp[256], sp[320]); o.w = pk2(sp[384], sp[448]);
            *(u32x4*)(dst + (size_t)n * 1024 + 8 * c) = o; }
        if (itn < TI_TOTAL) {
#pragma unroll
            for (int i = 0; i < 16; ++i) cur[i] = nxt[i];
            dst = dstn; }
        it = itn;
    }
}
constexpr int NSTRIP_GU = 64 * 32, NSTRIP = NSTRIP_GU + 64 + 16 + 40;
__device__ __forceinline__ void strip_src(const Params& P, Frame& F, int s, const float*& src, signed char*& dst, float*& sc, int& N) {
    if (s < 64) { N = 4096; src = P.in[I_REC_W_IN] + s * 64; dst = WSP(signed char, WS_WT_RECIN) + (size_t)s * 64 * 1024; sc = WSP(float, WS_SDN) + s * 64; }
    else if ((s -= 64) < 16) { N = 1024; src = P.in[I_REC_W_OUT] + s * 64; dst = WSP(signed char, WS_WT_RECOUT) + (size_t)s * 64 * 1024; sc = WSP(float, WS_SDN) + 4096 + s * 64; }
    else if ((s -= 16) < 40) { N = 2560; src = P.in[I_ATT_W_IN] + s * 64; dst = WSP(signed char, WS_WT_ATTIN) + (size_t)s * 64 * 1024; sc = WSP(float, WS_SDN) + 5120 + s * 64; }
    else { s -= 40; N = 2048; const int mat = s >> 5, nb = s & 31;
        src = P.in[I_W_GU] + (size_t)mat * 1024 * 2048 + nb * 64; dst = WSP(signed char, WS_WT_GU) + ((size_t)mat * 2048 + nb * 64) * 1024; sc = WSP(float, WS_SGU) + mat * 2048 + nb * 64; }
}
__device__ __forceinline__ void pre_strips(const Params& P, Frame& F) {
    LAS unsigned char* tile = F.lds; LAS float* wmax = (LAS float*)(F.lds + 133120); LAS float* scl = (LAS float*)(F.lds + 135168);
    const int w = F.wave, l = F.lane, lr = l >> 4, nq = (l & 15) * 4;
    f32x4 regs[32]; const float* src; signed char* dst; float* sc; int N;
    int s = F.vcu;
    if (s < NSTRIP) { strip_src(P, F, s, src, dst, sc, N);
#pragma unroll
        for (int i = 0; i < 32; ++i) regs[i] = *(const f32x4*)(src + (size_t)(i * 32 + w * 4 + lr) * N + nq); }
    while (s < NSTRIP) {
        f32x4 pm = {0.f, 0.f, 0.f, 0.f};
#pragma unroll
        for (int i = 0; i < 32; ++i) { const int kr = i * 32 + w * 4 + lr; const f32x4 v = regs[i];
            pm.x = fmaxf(pm.x, fabsf(v.x)); pm.y = fmaxf(pm.y, fabsf(v.y)); pm.z = fmaxf(pm.z, fabsf(v.z)); pm.w = fmaxf(pm.w, fabsf(v.w));
            u32x2 pw; pw.x = pk2(v.x, v.y); pw.y = pk2(v.z, v.w);
            *(LAS u32x2*)(tile + kr * 128 + ((nq ^ (((kr >> 4) & 7) * 8)) * 2)) = pw; }
#pragma unroll
        for (int j = 0; j < 4; ++j) { float t = pm[j]; t = fmaxf(t, __shfl_xor(t, 16)); t = fmaxf(t, __shfl_xor(t, 32)); pm[j] = t; }
        if (l < 16) *(LAS f32x4*)(wmax + w * 64 + nq) = pm;
        __syncthreads();
        if (F.tid < 64) { float m = 0.f;
#pragma unroll
            for (int ww = 0; ww < 8; ++ww) m = fmaxf(m, wmax[ww * 64 + F.tid]);
            const float scv = m > 0.f ? m * (1.0f / 127.0f) : 1.0f; scl[F.tid] = scv; sc[F.tid] = scv; }
        signed char* dcur = dst;
        const int sn = s + 256;
        if (sn < NSTRIP) { strip_src(P, F, sn, src, dst, sc, N);
#pragma unroll
            for (int i = 0; i < 32; ++i) regs[i] = *(const f32x4*)(src + (size_t)(i * 32 + w * 4 + lr) * N + nq); }
        __syncthreads();
        { const int n = (l >> 3) + 8 * w, c = l & 7; const float inv = 1.0f / scl[n]; const int nsw = (n ^ (c * 8)) * 2;
#pragma unroll 1
            for (int kb = 0; kb < 8; ++kb) { const int k0 = kb * 128 + c * 16; u32x4 o;
#pragma unroll
                for (int d = 0; d < 4; ++d) { unsigned wd = 0;
#pragma unroll
                    for (int b = 0; b < 4; ++b) { const float v = bf2f(*(const LAS bf16*)(tile + (k0 + 4 * d + b) * 128 + nsw)); int q = (int)rintf(v * inv); q = q > 127 ? 127 : (q < -127 ? -127 : q); wd |= (unsigned)(q & 255) << (8 * b); }
                    o[d] = wd; }
                *(u32x4*)(dcur + (size_t)n * 1024 + k0) = o; } }
        __syncthreads();
        s = sn;
    }
}
__device__ __forceinline__ void phase_pre(const Params& P, Frame& F) {
    if (F.bid < 192) pre_modulation(P, F);
    pre_tables(P, F);
    pre_strips(P, F);
    pre_transposes(P, F);
}

__device__ __forceinline__ void norm_mod_store(const f32x4 (&v)[4], const float* gain, const float* sc, const float* sh, bf16* orow, int lane) {
    float ss = 0.f;
#pragma unroll
    for (int j = 0; j < 4; ++j) ss += (v[j].x * v[j].x + v[j].y * v[j].y) + (v[j].z * v[j].z + v[j].w * v[j].w);
    const float rstd = rsqrtf(wave_sum(ss) * (1.0f / 1024.0f) + NORM_EPS);
#pragma unroll
    for (int j = 0; j < 4; ++j) { const int c = 4 * lane + 256 * j; const f32x4 g = *(const f32x4*)(gain + c), s1 = *(const f32x4*)(sc + c), s0 = *(const f32x4*)(sh + c);
        const f32x4 a = v[j] * rstd * g * (s1 + 1.0f) + s0; u32x2 w; w.x = pk2(a.x, a.y); w.y = pk2(a.z, a.w); *(u32x2*)(orow + c) = w; }
}
__device__ __forceinline__ void norm_mod_store_q8(const f32x4 (&v)[4], const float* gain, const float* sc, const float* sh, signed char* orow, float* oscale, int lane) {
    float ss = 0.f;
#pragma unroll
    for (int j = 0; j < 4; ++j) ss += (v[j].x * v[j].x + v[j].y * v[j].y) + (v[j].z * v[j].z + v[j].w * v[j].w);
    const float rstd = rsqrtf(wave_sum(ss) * (1.0f / 1024.0f) + NORM_EPS);
    f32x4 a[4]; float amax = 0.f;
#pragma unroll
    for (int j = 0; j < 4; ++j) { const int c = 4 * lane + 256 * j; const f32x4 g = *(const f32x4*)(gain + c), s1 = *(const f32x4*)(sc + c), s0 = *(const f32x4*)(sh + c);
        a[j] = v[j] * rstd * g * (s1 + 1.0f) + s0; amax = fmaxf(amax, fmaxf(fmaxf(fabsf(a[j].x), fabsf(a[j].y)), fmaxf(fabsf(a[j].z), fabsf(a[j].w)))); }
    amax = wave_max(amax); const float qs = amax > 0.f ? amax * (1.0f / 127.0f) : 1.0f, qi = 1.0f / qs;
    if (lane == 0) *oscale = qs;
#pragma unroll
    for (int j = 0; j < 4; ++j) *(unsigned*)(orow + 4 * lane + 256 * j) = q8pack(a[j].x, a[j].y, a[j].z, a[j].w, qi);
}
__device__ __forceinline__ void phase_norm0(const Params& P, Frame& F) {
    const int gw = F.vcu * NWAVES + F.wave, NGW = 256 * NWAVES; const float* mod = WSP(float, WS_MOD);
    for (int r = gw; r < NTOK; r += NGW) {
        const float* src = r < NLAT ? P.in[I_X] + (size_t)r * 1024 : P.in[I_CTX] + (size_t)(r - NLAT) * 1024; f32x4 v[4];
#pragma unroll
        for (int j = 0; j < 4; ++j) v[j] = *(const f32x4*)(src + 4 * F.lane + 256 * j);
        const float* m = mod + (size_t)mod_row(r) * 6144;
        norm_mod_store_q8(v, P.in[I_NORM_MIX], m + 1024, m, WSP(signed char, WS_A8) + (size_t)r * 1024, WSP(float, WS_ASC) + r, F.lane);
    }
}
__device__ __forceinline__ void load_moe_sum(const float* h1row, const bf16* ysrow  , const float* g2, f32x4 (&v)[4], int lane) {
#pragma unroll
    for (int j = 0; j < 4; ++j) { const int c = 4 * lane + 256 * j; f32x4 s = {0.f, 0.f, 0.f, 0.f};
#pragma unroll
        for (int sl = 0; sl < 4; ++sl) { const u32x2 w = *(const u32x2*)(ysrow + sl * 1024 + c); s.x += bflo(w.x); s.y += bfhi(w.x); s.z += bflo(w.y); s.w += bfhi(w.y); }
        v[j] = *(const f32x4*)(h1row + c) + *(const f32x4*)(g2 + c) * s; }
}
__device__ __forceinline__ void phase_norm1(const Params& P, Frame& F) {
    const int gw = F.vcu * NWAVES + F.wave, NGW = 256 * NWAVES; const float* mod = WSP(float, WS_MOD);
    for (int r = gw; r < NTOK; r += NGW) {
        f32x4 v[4]; const int mr = mod_row(r);
        load_moe_sum(WSP(float, WS_H1) + (size_t)r * 1024, WSP(bf16, WS_YS) + (size_t)r * 4096, mod + (size_t)mr * 6144 + 5 * 1024, v, F.lane);
        float* h2 = WSP(float, WS_H2) + (size_t)r * 1024;
#pragma unroll
        for (int j = 0; j < 4; ++j) *(f32x4*)(h2 + 4 * F.lane + 256 * j) = v[j];
        const float* m = mod + (size_t)(9 + mr) * 6144;
        norm_mod_store_q8(v, P.in[I_NORM_MIX] + 1024, m + 1024, m, WSP(signed char, WS_A8) + (size_t)r * 1024, WSP(float, WS_ASC) + r, F.lane);
    }
}
__device__ __forceinline__ void phase_final(const Params& P, Frame& F) {
    const int gw = F.vcu * NWAVES + F.wave, NGW = 256 * NWAVES; const float* mod = WSP(float, WS_MOD);
    for (int r = gw; r < NLAT; r += NGW) {
        f32x4 v[4]; const int mr = mod_row(r);
        load_moe_sum(WSP(float, WS_H3) + (size_t)r * 1024, WSP(bf16, WS_YS) + (size_t)r * 4096, mod + (size_t)(9 + mr) * 6144 + 5 * 1024, v, F.lane);
        float* o = P.out + (size_t)r * 1024;
#pragma unroll
        for (int j = 0; j < 4; ++j) *(f32x4*)(o + 4 * F.lane + 256 * j) = v[j];
    }
}
namespace pg8 {
constexpr int BM = 256, BK = 64, HALF = 128, HTB = HALF * BK * 2, STAGE_BYTES = 8 * HTB, KD = 1024;
__device__ __forceinline__ int lds_byte(int r, int c) { const int st = (r >> 4) * 2 + (c >> 5), rr = r & 15, cc = c & 31, ob = rr * 64 + cc * 2; return st * 1024 + (ob ^ (((ob >> 9) & 1) << 5)); }
__device__ __forceinline__ void stage_rc(int b, int& R, int& C) { const int st = b / 1024, sb = b % 1024, swz = sb ^ (((sb >> 9) & 1) << 5); R = (st >> 1) * 16 + swz / 64; C = (st & 1) * 32 + (swz % 64) / 2; }
__device__ __forceinline__ int perm32(int rho) { const int n = rho >> 4, i = rho & 15; return 8 * (i >> 2) + 4 * n + (i & 3); }

struct Unit { const char *A0, *A1, *B0, *B1; int r0, c0, aux; const int* ridx; };

typedef int i32x4 __attribute__((ext_vector_type(4)));
template <bool I8> struct AccT { typedef f32x4 T; };
template <> struct AccT<true> { typedef i32x4 T; };
template <bool I8> __device__ __forceinline__ typename AccT<I8>::T mma1(bf16x8 b, bf16x8 a, typename AccT<I8>::T c);
template <> __device__ __forceinline__ f32x4 mma1<false>(bf16x8 b, bf16x8 a, f32x4 c) { return __builtin_amdgcn_mfma_f32_16x16x32_bf16(b, a, c, 0, 0, 0); }
template <> __device__ __forceinline__ i32x4 mma1<true>(bf16x8 b, bf16x8 a, i32x4 c) { return __builtin_amdgcn_mfma_i32_16x16x64_i8(__builtin_bit_cast(i32x4, b), __builtin_bit_cast(i32x4, a), c, 0, 0, 0); }
template <class Epi, class Sched>
__device__ __forceinline__ void gemm_phase(LAS unsigned char* lds, const Sched& S, const Epi& E) {
    const int tid = threadIdx.x, wid = __builtin_amdgcn_readfirstlane(tid >> 6), lane = tid & 63, wr = wid >> 2, wc = wid & 3, fr = lane & 15, fq = lane >> 4;
    constexpr bool I8 = Epi::I8; typedef typename AccT<I8>::T acc_t;
    constexpr int K = I8 ? KD / 2 : KD  , nt = I8 ? KD / 128 : KD / BK;
    unsigned voffA[2], voffB[2];
#pragma unroll
    for (int i = 0; i < 2; ++i) { int R, C; stage_rc(tid * 16 + i * 8192, R, C); const int Rb = Epi::PERM ? ((R & ~31) + perm32(R & 31)) : R;
        voffA[i] = (unsigned)(R * K + C) * 2u; voffB[i] = (unsigned)(Rb * K + C) * 2u; }
    constexpr size_t kstep = (size_t)(BK * 2);
    const unsigned ldsw = (unsigned)wid * 1024u;
    const int aoff = lds_byte(wr * 64 + fr, fq * 8), boff = lds_byte(wc * 32 + fr, fq * 8);
    constexpr bool GATHER = Sched::GATHER;
    unsigned gcur[2][2];
    LAS u32x4* gstash = (LAS u32x4*)(lds + 136192) + tid;
#define PG8_GOFF(dst, u) do { int _R, _C; stage_rc(tid * 16, _R, _C); _Pragma("unroll") for (int _h = 0; _h < 2; ++_h) _Pragma("unroll") for (int _i = 0; _i < 2; ++_i) { int _t = (u).ridx[_h * HALF + _R + 64 * _i]; _t = _t < 0 ? 0 : (_t >> 2); \
        dst[_h][_i] = (unsigned)_t * (unsigned)(K * 2) + (unsigned)(_C * 2); } } while (0)
#define PG8_GSTASH(src) do { u32x4 _w; _w.x = src[0][0]; _w.y = src[0][1]; _w.z = src[1][0]; _w.w = src[1][1]; *gstash = _w; } while (0)
#define PG8_SA(b, h) (((b) * 2 + (h)) * HTB)
#define PG8_SB(b, h) ((4 + (b) * 2 + (h)) * HTB)
#define PG8_STAGE(bufoff, gbase, voff) do { _Pragma("unroll") for (int _i = 0; _i < 2; ++_i) \
        __builtin_amdgcn_global_load_lds((const unsigned*)((const char*)(gbase) + (voff)[_i]), (LAS unsigned*)(lds + (bufoff) + ldsw + _i * 8192), 16, 0, 0); } while (0)
#define PG8_LDA(dst, b, h) do { _Pragma("unroll") for (int m = 0; m < 4; ++m) _Pragma("unroll") for (int k = 0; k < 2; ++k) dst[m][k] = *(const LAS bf16x8*)(lds + PG8_SA(b, h) + aoff + m * 2048 + k * 1024); } while (0)
#define PG8_LDB(dst, b, h) do { _Pragma("unroll") for (int n = 0; n < 2; ++n) _Pragma("unroll") for (int k = 0; k < 2; ++k) dst[n][k] = *(const LAS bf16x8*)(lds + PG8_SB(b, h) + boff + n * 2048 + k * 1024); } while (0)
#define PG8_MMA(ai, bj, At, Bt) do { __builtin_amdgcn_s_setprio(1); _Pragma("unroll") for (int m = 0; m < 4; ++m) _Pragma("unroll") for (int n = 0; n < 2; ++n) _Pragma("unroll") for (int k = 0; k < 2; ++k) \
        acc[ai][bj][m][n] = mma1<I8>(Bt[n][k], At[m][k], acc[ai][bj][m][n]); __builtin_amdgcn_s_setprio(0); } while (0)
#define PG8_WAIT_V(n) asm volatile("s_waitcnt vmcnt(" #n ")" ::: "memory")
#define PG8_WAIT_L(n) asm volatile("s_waitcnt lgkmcnt(" #n ")" ::: "memory")
#define PG8_BAR __builtin_amdgcn_s_barrier()
#define PG8_SCHED __builtin_amdgcn_sched_barrier(0)
    Unit cur, nxt; int ui = 0;
    if (!S.next(0, cur)) return;
    acc_t acc[2][2][4][2];
#pragma unroll
    for (int a = 0; a < 2; ++a)
#pragma unroll
        for (int b = 0; b < 2; ++b)
#pragma unroll
            for (int m = 0; m < 4; ++m)
#pragma unroll
                for (int n = 0; n < 2; ++n) acc[a][b][m][n] = (acc_t){0, 0, 0, 0};
    bf16x8 At[4][2], B0[2][2], B1[2][2];
    if (GATHER) { PG8_GOFF(gcur, cur); Unit n1; unsigned t1[2][2]; if (S.next(1, n1)) PG8_GOFF(t1, n1); else { t1[0][0] = gcur[0][0]; t1[0][1] = gcur[0][1]; t1[1][0] = gcur[1][0]; t1[1][1] = gcur[1][1]; } PG8_GSTASH(t1); }
#define PG8_STAGE_A(bufoff, gbase, h, g) do { if (GATHER) PG8_STAGE(bufoff, gbase, g[h]); else PG8_STAGE(bufoff, gbase, voffA); } while (0)
    PG8_STAGE(PG8_SB(0, 0), cur.B0, voffB); PG8_STAGE(PG8_SB(0, 1), cur.B1, voffB); PG8_STAGE_A(PG8_SA(0, 0), cur.A0, 0, gcur); PG8_STAGE_A(PG8_SA(0, 1), cur.A1, 1, gcur);
    if (wr == 1) PG8_BAR;
    PG8_WAIT_V(2); PG8_BAR;
    PG8_STAGE(PG8_SB(1, 0), cur.B0 + kstep, voffB); PG8_STAGE_A(PG8_SA(1, 0), cur.A0 + kstep, 0, gcur); PG8_STAGE(PG8_SB(1, 1), cur.B1 + kstep, voffB);
    PG8_WAIT_V(6); PG8_BAR;
    for (;;) {
        const bool has_next = S.next(ui + 1, nxt);
        const char* nA0 = has_next ? nxt.A0 : cur.A0; const char* nA1 = has_next ? nxt.A1 : cur.A1;
        const char* nB0 = has_next ? nxt.B0 : cur.B0; const char* nB1 = has_next ? nxt.B1 : cur.B1;
        for (int t = 0; t < nt; t += 2) {
            const bool last = (t == nt - 2);
            const char* a1_1 = cur.A1 + (size_t)(t + 1) * kstep;
            const char* a2_0 = last ? nA0 : cur.A0 + (size_t)(t + 2) * kstep; const char* a2_1 = last ? nA1 : cur.A1 + (size_t)(t + 2) * kstep;
            const char* b2_0 = last ? nB0 : cur.B0 + (size_t)(t + 2) * kstep; const char* b2_1 = last ? nB1 : cur.B1 + (size_t)(t + 2) * kstep;
            const char* a3_0 = a2_0 + kstep; const char* b3_0 = b2_0 + kstep; const char* b3_1 = b2_1 + kstep;
            PG8_LDB(B0, 0, 0); PG8_LDB(B1, 0, 1); PG8_SCHED; PG8_LDA(At, 0, 0); PG8_STAGE_A(PG8_SA(1, 1), a1_1, 1, gcur);
            if (GATHER && last) { const u32x4 _w = *gstash; gcur[0][0] = _w.x; gcur[0][1] = _w.y; gcur[1][0] = _w.z; gcur[1][1] = _w.w; }
            PG8_WAIT_V(8); PG8_WAIT_L(0); PG8_BAR; PG8_MMA(0, 0, At, B0); PG8_MMA(0, 1, At, B1); PG8_BAR; PG8_SCHED;
            PG8_LDA(At, 0, 1); PG8_STAGE(PG8_SB(0, 0), b2_0, voffB); PG8_STAGE(PG8_SB(0, 1), b2_1, voffB); PG8_STAGE_A(PG8_SA(0, 0), a2_0, 0, gcur);
            PG8_WAIT_V(8); PG8_WAIT_L(0); PG8_BAR; PG8_MMA(1, 0, At, B0); PG8_MMA(1, 1, At, B1); PG8_BAR; PG8_SCHED;
            PG8_LDB(B0, 1, 0); PG8_LDB(B1, 1, 1); PG8_SCHED; PG8_LDA(At, 1, 0); PG8_STAGE_A(PG8_SA(0, 1), a2_1, 1, gcur);
            PG8_WAIT_V(8); PG8_WAIT_L(0); PG8_BAR; PG8_MMA(0, 0, At, B0); PG8_MMA(0, 1, At, B1); PG8_BAR; PG8_SCHED;
            PG8_LDA(At, 1, 1); PG8_STAGE(PG8_SB(1, 0), b3_0, voffB); PG8_STAGE(PG8_SB(1, 1), b3_1, voffB); PG8_STAGE_A(PG8_SA(1, 0), a3_0, 0, gcur);
            PG8_WAIT_V(8); PG8_WAIT_L(0); PG8_BAR; PG8_MMA(1, 0, At, B0); PG8_MMA(1, 1, At, B1); PG8_BAR; PG8_SCHED;
        }
        if (GATHER) { Unit n2; unsigned t2[2][2]; if (S.next(ui + 2, n2)) PG8_GOFF(t2, n2); else { t2[0][0] = gcur[0][0]; t2[0][1] = gcur[0][1]; t2[1][0] = gcur[1][0]; t2[1][1] = gcur[1][1]; } PG8_GSTASH(t2); }
        if (wr == 0) PG8_BAR;
        E(acc, cur, wr, wc, fr, fq);
        if (!has_next) break;
#pragma unroll
        for (int a = 0; a < 2; ++a)
#pragma unroll
            for (int b = 0; b < 2; ++b)
#pragma unroll
                for (int m = 0; m < 4; ++m)
#pragma unroll
                    for (int n = 0; n < 2; ++n) acc[a][b][m][n] = (acc_t){0, 0, 0, 0};
        cur = nxt; ++ui;
        if (wr == 1) PG8_BAR;
    }
    PG8_WAIT_V(0);
    PG8_BAR;
#undef PG8_SA
#undef PG8_SB
#undef PG8_STAGE
#undef PG8_STAGE_A
#undef PG8_GOFF
#undef PG8_GSTASH
#undef PG8_LDA
#undef PG8_LDB
#undef PG8_MMA
#undef PG8_WAIT_V
#undef PG8_WAIT_L
#undef PG8_BAR
#undef PG8_SCHED
}

template <int RP  >
struct DenseOrder {
    static constexpr bool GATHER = false;
    const char* A; const char* Bt; int nM, nN, nwg, c;
    __device__ __forceinline__ void init(const void* A_, const void* Bt_, int M, int N, int c_) { A = (const char*)A_; Bt = (const char*)Bt_; nM = M / BM; nN = N / BM; nwg = nM * nN; c = c_; }
    __device__ __forceinline__ bool next(int i, Unit& u) const {
        const int L = i * 256 + c; if (L >= nwg) return false;
        int wgid = L; { const int q = nwg / 8, r = nwg % 8, xcd = wgid % 8, off = wgid / 8; wgid = (xcd < r ? xcd * (q + 1) : r * (q + 1) + (xcd - r) * q) + off; }
        const int nig = 8 * nN, gid = wgid / nig, fm = gid * 8, gsz = (nM - fm) < 8 ? (nM - fm) : 8;
        const int pm = fm + ((wgid % nig) % gsz), pn = (wgid % nig) / gsz;
        u.A0 = A + (size_t)pm * (BM * RP); u.A1 = u.A0 + (size_t)HALF * RP; u.B0 = Bt + (size_t)pn * (BM * RP); u.B1 = u.B0 + (size_t)HALF * RP;
        u.r0 = pm * BM; u.c0 = pn * BM; u.aux = pn; u.ridx = nullptr; return true;
    }
};
template <int NPN, bool GU, int RP  >
struct MoeOrder {
    static constexpr bool GATHER = GU;
    const int* rtok;
    const char* A; const char* W; const LAS int* blke; int nrb, vcu;
    __device__ __forceinline__ bool next(int i, Unit& u) const {
        const int L = i * 256 + vcu; const int rb = L / NPN, pn = L % NPN; if (rb >= nrb) return false;
        const int e = __builtin_amdgcn_readfirstlane(blke[rb]);
        if (GU) { u.A0 = A; u.A1 = A; u.ridx = rtok + rb * BM; } else { u.A0 = A + (size_t)rb * (BM * RP); u.A1 = u.A0 + (size_t)HALF * RP; u.ridx = nullptr; }
        if (GU) { u.B0 = W + (size_t)e * (2048 * RP) + (size_t)pn * (HALF * RP); u.B1 = u.B0 + (size_t)1024 * RP; u.c0 = pn * HALF; }
        else    { u.B0 = W + (size_t)e * (1024 * RP) + (size_t)pn * (BM * RP); u.B1 = u.B0 + (size_t)HALF * RP; u.c0 = pn * BM; }
        u.r0 = rb * BM; u.aux = e; return true;
    }
};

template <bool I8> struct AccCvt;
template <> struct AccCvt<false> { static __device__ __forceinline__ f32x4 f(const f32x4& a, float, const f32x4&) { return a; } };
template <> struct AccCvt<true> { static __device__ __forceinline__ f32x4 f(const i32x4& a, float sr, const f32x4& sc) { return (f32x4){(float)a[0] * (sr * sc[0]), (float)a[1] * (sr * sc[1]), (float)a[2] * (sr * sc[2]), (float)a[3] * (sr * sc[3])}; } };
#define EPI_ROWS_BEGIN _Pragma("unroll") for (int ai = 0; ai < 2; ++ai) _Pragma("unroll") for (int m = 0; m < 4; ++m) { const int row = u.r0 + ai * HALF + wr * 64 + m * 16 + fr;
#define EPI_ROWS_END }
template <bool I8_>
struct EpiBf16 {
    static constexpr bool PERM = true, I8 = I8_;
    bf16* O; int ldc; const float* sa; const float* sb;
    __device__ __forceinline__ void operator()(const typename AccT<I8_>::T (&acc)[2][2][4][2], const Unit& u, int wr, int wc, int fr, int fq) const {
        const int col0 = u.c0 + wc * 32 + 8 * fq;
        f32x4 scv[2][2];
#pragma unroll
        for (int bj = 0; bj < 2; ++bj)
#pragma unroll
            for (int n = 0; n < 2; ++n) scv[bj][n] = I8_ ? *(const f32x4*)(sb + col0 + bj * HALF + 4 * n) : (f32x4){1.f, 1.f, 1.f, 1.f};
        EPI_ROWS_BEGIN bf16* rowp = O + (size_t)row * ldc + col0; const float sr = I8_ ? sa[row] : 1.f;
#pragma unroll
            for (int bj = 0; bj < 2; ++bj) { const f32x4 v0 = AccCvt<I8_>::f(acc[ai][bj][m][0], sr, scv[bj][0]), v1 = AccCvt<I8_>::f(acc[ai][bj][m][1], sr, scv[bj][1]); u32x4 w; w.x = pk2(v0[0], v0[1]); w.y = pk2(v0[2], v0[3]); w.z = pk2(v1[0], v1[1]); w.w = pk2(v1[2], v1[3]);
                *(u32x4*)(rowp + bj * HALF) = w; }
        EPI_ROWS_END
    }
};
template <bool I8_>
struct EpiRecIn {
    static constexpr bool PERM = true, I8 = I8_;
    bf16* O; float* FFo; const float* lb; const float* rope; const float* sa; const float* sb;
    __device__ __forceinline__ void operator()(const typename AccT<I8_>::T (&acc)[2][2][4][2], const Unit& u, int wr, int wc, int fr, int fq) const {
        const int pn = u.aux; const int col0 = u.c0 + wc * 32 + 8 * fq;
        f32x4 scv[2][2];
#pragma unroll
        for (int bj = 0; bj < 2; ++bj)
#pragma unroll
            for (int n = 0; n < 2; ++n) scv[bj][n] = I8_ ? *(const f32x4*)(sb + col0 + bj * HALF + 4 * n) : (f32x4){1.f, 1.f, 1.f, 1.f};
        if (pn >= 2 && pn < 6) {
            f32x4 lbv[2][2];
#pragma unroll
            for (int bj = 0; bj < 2; ++bj)
#pragma unroll
                for (int n = 0; n < 2; ++n) lbv[bj][n] = *(const f32x4*)(lb + col0 - 512 + bj * HALF + 4 * n);
            EPI_ROWS_BEGIN float* rowp = FFo + (size_t)row * 1024 + (col0 - 512); bf16* krow = O + (size_t)row * REC_IN + col0; const float sr = I8_ ? sa[row] : 1.f;
#pragma unroll
                for (int bj = 0; bj < 2; ++bj) { f32x4 kk[2];
#pragma unroll
                    for (int n = 0; n < 2; ++n) { const f32x4 z = AccCvt<I8_>::f(acc[ai][bj][m][n], sr, scv[bj][n]); f32x4 o;
#pragma unroll
                        for (int j = 0; j < 4; ++j) { const float sg = fsigmoid(z[j]); const float f = lbv[bj][n][j] + (1.0f - lbv[bj][n][j]) * sg; o[j] = __logf(f); kk[n][j] = (1.0f - lbv[bj][n][j]) * (1.0f - sg); }
                        *(f32x4*)(rowp + bj * HALF + 4 * n) = o; }
                    u32x4 w; w.x = pk2(kk[0][0], kk[0][1]); w.y = pk2(kk[0][2], kk[0][3]); w.z = pk2(kk[1][0], kk[1][1]); w.w = pk2(kk[1][2], kk[1][3]);
                    *(u32x4*)(krow + bj * HALF) = w; }
            EPI_ROWS_END
            return;
        }
        const int mode = (pn < 2) ? 1 : (pn == 8 || pn == 9 || pn >= 14) ? 2 : (pn == 10) ? 3 : (pn == 11) ? 4 : 0;
        EPI_ROWS_BEGIN bf16* rowp = O + (size_t)row * REC_IN + col0; const float sr = I8_ ? sa[row] : 1.f;
#pragma unroll
            for (int bj = 0; bj < 2; ++bj) { f32x4 v[2] = {AccCvt<I8_>::f(acc[ai][bj][m][0], sr, scv[bj][0]), AccCvt<I8_>::f(acc[ai][bj][m][1], sr, scv[bj][1])};
                if (mode == 1) {
#pragma unroll
                    for (int n = 0; n < 2; ++n)
#pragma unroll
                        for (int j = 0; j < 4; ++j) v[n][j] = fsilu(v[n][j]) * 0.08838834764831845f;
                } else if (mode == 2) {
#pragma unroll
                    for (int n = 0; n < 2; ++n)
#pragma unroll
                        for (int j = 0; j < 4; ++j) v[n][j] = fsilu(v[n][j]);
                } else if (mode >= 3) {
                    const float sc = (mode == 4) ? 0.125f : 1.0f;
                    if (row < NLAT) { const int t = row & 2047; const int p0 = ((col0 + bj * HALF) & 63) >> 1;
                        const f32x4 cs0 = *(const f32x4*)(rope + ((size_t)t * 32 + p0) * 2), cs1 = *(const f32x4*)(rope + ((size_t)t * 32 + p0 + 2) * 2);
                        f32x4 a = v[0], b = v[1];
                        v[0][0] = (a[0] * cs0[0] - a[1] * cs0[1]) * sc; v[0][1] = (a[0] * cs0[1] + a[1] * cs0[0]) * sc;
                        v[0][2] = (a[2] * cs0[2] - a[3] * cs0[3]) * sc; v[0][3] = (a[2] * cs0[3] + a[3] * cs0[2]) * sc;
                        v[1][0] = (b[0] * cs1[0] - b[1] * cs1[1]) * sc; v[1][1] = (b[0] * cs1[1] + b[1] * cs1[0]) * sc;
                        v[1][2] = (b[2] * cs1[2] - b[3] * cs1[3]) * sc; v[1][3] = (b[2] * cs1[3] + b[3] * cs1[2]) * sc;
                    } else { v[0] = v[0] * sc; v[1] = v[1] * sc; }
                }
                u32x4 w; w.x = pk2(v[0][0], v[0][1]); w.y = pk2(v[0][2], v[0][3]); w.z = pk2(v[1][0], v[1][1]); w.w = pk2(v[1][2], v[1][3]);
                *(u32x4*)(rowp + bj * HALF) = w; }
        EPI_ROWS_END
    }
};
template <bool I8_>
struct EpiResidual {
    static constexpr bool PERM = false, I8 = I8_;
    const float* baseLat; const float* baseCtx; float* out; const float* gate; const float* sa; const float* sb;
    __device__ __forceinline__ void operator()(const typename AccT<I8_>::T (&acc)[2][2][4][2], const Unit& u, int wr, int wc, int fr, int fq) const {
        const int col0 = u.c0 + wc * 32 + 4 * fq; const float* g = gate + (size_t)mod_row(u.r0) * 6144 + col0;
        f32x4 gv[2][2];
#pragma unroll
        for (int bj = 0; bj < 2; ++bj)
#pragma unroll
            for (int n = 0; n < 2; ++n) { gv[bj][n] = *(const f32x4*)(g + bj * HALF + n * 16); if (I8_) gv[bj][n] = gv[bj][n] * *(const f32x4*)(sb + col0 + bj * HALF + n * 16); }
        EPI_ROWS_BEGIN const float* bp = (row < NLAT ? baseLat + (size_t)row * 1024 : baseCtx + (size_t)(row - NLAT) * 1024) + col0; float* op = out + (size_t)row * 1024 + col0; const float sr = I8_ ? sa[row] : 1.f;
#pragma unroll
            for (int bj = 0; bj < 2; ++bj)
#pragma unroll
                for (int n = 0; n < 2; ++n) *(f32x4*)(op + bj * HALF + n * 16) = *(const f32x4*)(bp + bj * HALF + n * 16) + gv[bj][n] * AccCvt<I8_>::f(acc[ai][bj][m][n], sr, (f32x4){1.f, 1.f, 1.f, 1.f});
        EPI_ROWS_END
    }
};
struct EpiSwiglu {
    static constexpr bool PERM = true, I8 = false;
    bf16* O; const float* bgu;
    __device__ __forceinline__ void operator()(const f32x4 (&acc)[2][2][4][2], const Unit& u, int wr, int wc, int fr, int fq) const {
        const int col0 = u.c0 + wc * 32 + 8 * fq; const float* bb = bgu + (size_t)u.aux * 2048 + col0;
        f32x4 bg[2], bu[2];
#pragma unroll
        for (int n = 0; n < 2; ++n) { bg[n] = *(const f32x4*)(bb + 4 * n); bu[n] = *(const f32x4*)(bb + 1024 + 4 * n); }
        EPI_ROWS_BEGIN f32x4 h[2];
#pragma unroll
            for (int n = 0; n < 2; ++n)
#pragma unroll
                for (int j = 0; j < 4; ++j) { const float g = fminf(acc[ai][0][m][n][j] + bg[n][j], 7.0f); const float up = fminf(fmaxf(acc[ai][1][m][n][j] + bu[n][j], -7.0f), 7.0f);
                    h[n][j] = (up + 1.0f) * g * fsigmoid(1.702f * g); }
            u32x4 w; w.x = pk2(h[0][0], h[0][1]); w.y = pk2(h[0][2], h[0][3]); w.z = pk2(h[1][0], h[1][1]); w.w = pk2(h[1][2], h[1][3]);
            *(u32x4*)(O + (size_t)row * 1024 + col0) = w;
        EPI_ROWS_END
    }
};
struct EpiSwigluI8 {
    static constexpr bool PERM = true, I8 = true;
    bf16* O; const float* bgu; const float* sa; const float* sb;
    __device__ __forceinline__ void operator()(const i32x4 (&acc)[2][2][4][2], const Unit& u, int wr, int wc, int fr, int fq) const {
        const int col0 = u.c0 + wc * 32 + 8 * fq; const float* bb = bgu + (size_t)u.aux * 2048 + col0; const float* ss = sb + (size_t)u.aux * 2048 + col0;
        f32x4 bg[2], bu[2], sg[2], su[2];
#pragma unroll
        for (int n = 0; n < 2; ++n) { bg[n] = *(const f32x4*)(bb + 4 * n); bu[n] = *(const f32x4*)(bb + 1024 + 4 * n); sg[n] = *(const f32x4*)(ss + 4 * n); su[n] = *(const f32x4*)(ss + 1024 + 4 * n); }
        EPI_ROWS_BEGIN const float sr = sa[row]; f32x4 h[2];
#pragma unroll
            for (int n = 0; n < 2; ++n)
#pragma unroll
                for (int j = 0; j < 4; ++j) { const float g = fminf((float)acc[ai][0][m][n][j] * (sr * sg[n][j]) + bg[n][j], 7.0f); const float up = fminf(fmaxf((float)acc[ai][1][m][n][j] * (sr * su[n][j]) + bu[n][j], -7.0f), 7.0f);
                    h[n][j] = (up + 1.0f) * g * fsigmoid(1.702f * g); }
            u32x4 w; w.x = pk2(h[0][0], h[0][1]); w.y = pk2(h[0][2], h[0][3]); w.z = pk2(h[1][0], h[1][1]); w.w = pk2(h[1][2], h[1][3]);
            *(u32x4*)(O + (size_t)row * 1024 + col0) = w;
        EPI_ROWS_END
    }
};
struct EpiMoeOut {
    static constexpr bool PERM = true, I8 = false;
    bf16* YS; const float* bdn; const int* rtok; const float* rgate;
    __device__ __forceinline__ void operator()(const f32x4 (&acc)[2][2][4][2], const Unit& u, int wr, int wc, int fr, int fq) const {
        const int col0 = u.c0 + wc * 32 + 8 * fq; const float* bb = bdn + (size_t)u.aux * 1024 + col0;
        f32x4 bv[2][2];
#pragma unroll
        for (int bj = 0; bj < 2; ++bj)
#pragma unroll
            for (int n = 0; n < 2; ++n) bv[bj][n] = *(const f32x4*)(bb + bj * HALF + 4 * n);
        EPI_ROWS_BEGIN const int tk = rtok[row]; const float gt = rgate[row];
            if (tk >= 0) { bf16* rowp = YS + (size_t)tk * 1024 + col0;
#pragma unroll
                for (int bj = 0; bj < 2; ++bj) { const f32x4 v0 = (acc[ai][bj][m][0] + bv[bj][0]) * gt, v1 = (acc[ai][bj][m][1] + bv[bj][1]) * gt;
                    u32x4 w; w.x = pk2(v0[0], v0[1]); w.y = pk2(v0[2], v0[3]); w.z = pk2(v1[0], v1[1]); w.w = pk2(v1[2], v1[3]); *(u32x4*)(rowp + bj * HALF) = w; } }
        EPI_ROWS_END
    }
};
}
namespace rec {
template <int DK> struct LL {
    static constexpr int SD = (DK + 8) * 2;
    static constexpr int QIN = 0, KIN = QIN + 64 * SD, ST = KIN + 64 * SD, KSTT = ST + 64 * SD, VT = KSTT + DK * 144, ATT = VT + 64 * 144, TOT = ATT + 64 * 144, DEC = TOT + 8 * 128 * 4, END = DEC + 128 * 4;
};
template <bool RET> struct RegSet { f32x2 lf[RET ? 4 : 8]; unsigned qv[RET ? 4 : 8], kv[RET ? 4 : 8]; u32x4 vv; };
template <bool RET>
__device__ __forceinline__ void rec_unit(const Params& P, Frame& F, int b, int head, int dir, int vh) {
    constexpr int DK = RET ? 64 : 128, NT_ = RET ? 4 : 8, NVT = RET ? 2 : 4, KS = DK / 32;
    typedef LL<DK> L; constexpr int SD = L::SD;
    LAS unsigned char* lds = F.lds;
    const bf16* PROJ = WSP(bf16, WS_PROJ); const float* FFp = WSP(float, WS_FF); bf16* OR = WSP(bf16, WS_OREC) + (size_t)dir * NTOK * 1024;
    const int qcol = RET ? 2560 + head * 64 : head * 128, kcol = RET ? 2816 + head * 64 : 512 + dir * 512 + head * 128, fcol = dir * 512 + head * 128;
    const int vcol = (RET ? 3072 : 1536) + head * 128 + vh * 64, ocol = (RET ? 512 : 0) + head * 128 + vh * 64;
    const float lg = RET ? __logf(1.0f - exp2f(-5.0f - (float)(dir ? 3 - head : head))) : 0.f;
    const int dp = RET ? (F.tid & 31) : F.lane, tg = RET ? (F.tid >> 5) : F.wave;
    const int vs = F.tid >> 3, vc = (F.tid & 7) * 8;
    const int fr = F.lane & 15, fq = F.lane >> 4;
    const int sdt = RET ? (F.wave >> 1) : F.wave, svt0 = RET ? 2 * (F.wave & 1) : 0;
    f32x4 sacc[NVT];
#pragma unroll
    for (int i = 0; i < NVT; ++i) sacc[i] = (f32x4){0.f, 0.f, 0.f, 0.f};
    for (int idx = F.tid; idx < 64 * SD / 4; idx += NTHR) ((LAS unsigned*)(lds + L::ST))[idx] = 0u;
    if (RET && F.tid < 64) ((LAS float*)(lds + L::DEC))[F.tid] = __expf(64.0f * lg);
#define REC_BASE(n) ((n) < 4 ? NLAT + b * 256 + (dir ? 3 - (n) : (n)) * 64 : b * 2048 + (dir ? 35 - (n) : (n) - 4) * 64)
#define REC_ROW(base, j) ((base) + (dir ? 63 - (j) : (j)))
#define REC_LOAD(R, n) do { const int _bs = REC_BASE(n); _Pragma("unroll") for (int i = 0; i < NT_; ++i) { const size_t _r = (size_t)REC_ROW(_bs, NT_ * tg + i); \
        R.qv[i] = *(const unsigned*)(PROJ + _r * REC_IN + qcol + 2 * dp); R.kv[i] = *(const unsigned*)(PROJ + _r * REC_IN + kcol + 2 * dp); \
        if (!RET) R.lf[i] = *(const f32x2*)(FFp + _r * 1024 + fcol + 2 * dp); } \
        R.vv = *(const u32x4*)(PROJ + (size_t)REC_ROW(_bs, vs) * REC_IN + vcol + vc); } while (0)
    RegSet<RET> RA, RB;
    REC_LOAD(RA, 0); REC_LOAD(RB, 1);
#define REC_CHUNK(R, n) do { \
        const int base = REC_BASE(n); \
        float kst0[NT_], kst1[NT_]; \
        if (!RET) { \
            f32x2 cs[NT_]; f32x2 run = {0.f, 0.f}; \
            _Pragma("unroll") for (int i = 0; i < NT_; ++i) { run += R.lf[i]; cs[i] = run; } \
            *(LAS f32x2*)(lds + L::TOT + (tg * 128 + 2 * dp) * 4) = run; \
            __syncthreads(); \
            f32x2 pre = {0.f, 0.f}, all = {0.f, 0.f}; \
            _Pragma("unroll") for (int g = 0; g < 8; ++g) { const f32x2 t = *(const LAS f32x2*)(lds + L::TOT + (g * 128 + 2 * dp) * 4); all += t; if (g < tg) pre += t; } \
            const float eax = __expf(all.x), eay = __expf(all.y); \
            _Pragma("unroll") for (int i = 0; i < NT_; ++i) { const int j = NT_ * tg + i; const float ebx = fmaxf(__expf(pre.x + cs[i].x), 1e-35f), eby = fmaxf(__expf(pre.y + cs[i].y), 1e-35f); \
                const float rbx = __builtin_amdgcn_rcpf(ebx), rby = __builtin_amdgcn_rcpf(eby); \
                const float q0 = bflo(R.qv[i]), q1 = bfhi(R.qv[i]), k0 = bflo(R.kv[i]), k1 = bfhi(R.kv[i]); \
                *(LAS unsigned*)(lds + L::QIN + j * SD + 4 * dp) = pk2(q0 * ebx, q1 * eby); \
                *(LAS unsigned*)(lds + L::KIN + j * SD + 4 * dp) = pk2(k0 * rbx, k1 * rby); \
                kst0[i] = k0 * rbx * eax; kst1[i] = k1 * rby * eay; } \
            if (tg == 0) *(LAS f32x2*)(lds + L::DEC + 8 * dp) = (f32x2){eax, eay}; \
        } else { \
            _Pragma("unroll") for (int i = 0; i < NT_; ++i) { const int j = NT_ * tg + i; const float eb = __expf((float)(j + 1) * lg), enb = __expf(-(float)(j + 1) * lg), est = __expf((float)(63 - j) * lg); \
                const float q0 = bflo(R.qv[i]), q1 = bfhi(R.qv[i]), k0 = bflo(R.kv[i]), k1 = bfhi(R.kv[i]); \
                *(LAS unsigned*)(lds + L::QIN + j * SD + 4 * dp) = pk2(q0 * eb, q1 * eb); \
                *(LAS unsigned*)(lds + L::KIN + j * SD + 4 * dp) = pk2(k0 * enb, k1 * enb); \
                kst0[i] = k0 * est; kst1[i] = k1 * est; } \
        } \
        if (!RET) { u32x4 w0, w1; w0.x = pk2(kst0[0], kst0[1]); w0.y = pk2(kst0[2], kst0[3]); w0.z = pk2(kst0[NT_ - 4], kst0[NT_ - 3]); w0.w = pk2(kst0[NT_ - 2], kst0[NT_ - 1]); \
            w1.x = pk2(kst1[0], kst1[1]); w1.y = pk2(kst1[2], kst1[3]); w1.z = pk2(kst1[NT_ - 4], kst1[NT_ - 3]); w1.w = pk2(kst1[NT_ - 2], kst1[NT_ - 1]); \
            *(LAS u32x4*)(lds + L::KSTT + (2 * dp) * 144 + tg * 16) = w0; *(LAS u32x4*)(lds + L::KSTT + (2 * dp + 1) * 144 + tg * 16) = w1; \
        } else { u32x2 w0, w1; w0.x = pk2(kst0[0], kst0[1]); w0.y = pk2(kst0[2], kst0[3]); w1.x = pk2(kst1[0], kst1[1]); w1.y = pk2(kst1[2], kst1[3]); \
            *(LAS u32x2*)(lds + L::KSTT + (2 * dp) * 144 + tg * 8) = w0; *(LAS u32x2*)(lds + L::KSTT + (2 * dp + 1) * 144 + tg * 8) = w1; } \
        _Pragma("unroll") for (int i = 0; i < 8; ++i) *(LAS bf16*)(lds + L::VT + (vc + i) * 144 + vs * 2) = (bf16)(R.vv[i >> 1] >> (16 * (i & 1))); \
        if ((n) + 2 < 36) REC_LOAD(R, (n) + 2); \
        __syncthreads(); \
        { const int ti = F.wave >> 1; \
            _Pragma("unroll") for (int q = 0; q < 2; ++q) { const int si = 2 * (F.wave & 1) + q; f32x4 a4 = {0.f, 0.f, 0.f, 0.f}; \
                if (si <= ti) { \
                    _Pragma("unroll") for (int kk = 0; kk < KS; ++kk) { const bf16x8 a = *(const LAS bf16x8*)(lds + L::KIN + (si * 16 + fr) * SD + (kk * 32 + fq * 8) * 2); \
                        const bf16x8 bb = *(const LAS bf16x8*)(lds + L::QIN + (ti * 16 + fr) * SD + (kk * 32 + fq * 8) * 2); \
                        a4 = __builtin_amdgcn_mfma_f32_16x16x32_bf16(a, bb, a4, 0, 0, 0); } } \
                const int t = ti * 16 + fr, s0 = si * 16 + 4 * fq; \
                _Pragma("unroll") for (int j = 0; j < 4; ++j) if (s0 + j > t) a4[j] = 0.f; \
                u32x2 w; w.x = pk2(a4[0], a4[1]); w.y = pk2(a4[2], a4[3]); \
                *(LAS u32x2*)(lds + L::ATT + t * 144 + s0 * 2) = w; } } \
        __syncthreads(); \
        { const int ti = F.wave >> 1; const int t = ti * 16 + fr; bf16* orow = OR + (size_t)REC_ROW(base, t) * 1024 + ocol; \
            _Pragma("unroll") for (int q = 0; q < 2; ++q) { const int vi = 2 * (F.wave & 1) + q; f32x4 a4 = {0.f, 0.f, 0.f, 0.f}; \
                _Pragma("unroll") for (int kk = 0; kk < 2; ++kk) { const bf16x8 a = *(const LAS bf16x8*)(lds + L::VT + (vi * 16 + fr) * 144 + (kk * 32 + fq * 8) * 2); \
                    const bf16x8 bb = *(const LAS bf16x8*)(lds + L::ATT + t * 144 + (kk * 32 + fq * 8) * 2); \
                    a4 = __builtin_amdgcn_mfma_f32_16x16x32_bf16(a, bb, a4, 0, 0, 0); } \
                _Pragma("unroll") for (int kk = 0; kk < KS; ++kk) { const bf16x8 a = *(const LAS bf16x8*)(lds + L::ST + (vi * 16 + fr) * SD + (kk * 32 + fq * 8) * 2); \
                    const bf16x8 bb = *(const LAS bf16x8*)(lds + L::QIN + t * SD + (kk * 32 + fq * 8) * 2); \
                    a4 = __builtin_amdgcn_mfma_f32_16x16x32_bf16(a, bb, a4, 0, 0, 0); } \
                u32x2 w; w.x = pk2(a4[0], a4[1]); w.y = pk2(a4[2], a4[3]); \
                *(u32x2*)(orow + vi * 16 + 4 * fq) = w; } } \
        { const f32x4 dec4 = *(const LAS f32x4*)(lds + L::DEC + (sdt * 16 + 4 * fq) * 4); \
            _Pragma("unroll") for (int vt = 0; vt < NVT; ++vt) { f32x4 a4 = sacc[vt] * dec4; \
                _Pragma("unroll") for (int kk = 0; kk < 2; ++kk) { const bf16x8 a = *(const LAS bf16x8*)(lds + L::KSTT + (sdt * 16 + fr) * 144 + (kk * 32 + fq * 8) * 2); \
                    const bf16x8 bb = *(const LAS bf16x8*)(lds + L::VT + ((svt0 + vt) * 16 + fr) * 144 + (kk * 32 + fq * 8) * 2); \
                    a4 = __builtin_amdgcn_mfma_f32_16x16x32_bf16(a, bb, a4, 0, 0, 0); } \
                sacc[vt] = a4; } } \
        __syncthreads(); \
        _Pragma("unroll") for (int vt = 0; vt < NVT; ++vt) { u32x2 w; w.x = pk2(sacc[vt][0], sacc[vt][1]); w.y = pk2(sacc[vt][2], sacc[vt][3]); \
            *(LAS u32x2*)(lds + L::ST + ((svt0 + vt) * 16 + fr) * SD + (sdt * 16 + 4 * fq) * 2) = w; } \
    } while (0)
    for (int n = 0; n < 36; n += 2) { REC_CHUNK(RA, n); REC_CHUNK(RB, n + 1); }
#undef REC_CHUNK
#undef REC_BASE
#undef REC_ROW
#undef REC_LOAD
    __syncthreads();
}
}
__device__ __forceinline__ void phase_rec(const Params& P, Frame& F) {
    const int u = F.bid; const int vh = u & 1, dir = (u >> 1) & 1, head = (u >> 2) & 3, type = (u >> 4) & 1, b = u >> 5;
    if (type) rec::rec_unit<true>(P, F, b, head, dir, vh); else rec::rec_unit<false>(P, F, b, head, dir, vh);
}
__device__ __forceinline__ void phase_merge(const Params& P, Frame& F) {
    const int gw = F.vcu * NWAVES + F.wave, NGW = 256 * NWAVES; const int c0 = 16 * F.lane; const bool isret = F.lane >= 32;
    const float* gain = (isret ? P.in[I_RET_GAIN] : P.in[I_HG_GAIN]) + (c0 & 127);
    float gn[16];
#pragma unroll
    for (int i = 0; i < 16; ++i) gn[i] = gain[i];
    for (int r = gw; r < NTOK; r += NGW) {
        const bf16* o0 = WSP(bf16, WS_OREC) + (size_t)r * 1024 + c0; const bf16* o1 = o0 + (size_t)NTOK * 1024;
        const bf16* gp = WSP(bf16, WS_PROJ) + (size_t)r * REC_IN + c0 + (isret ? 3072 : 2048);
        u32x4 a[2] = {*(const u32x4*)o0, *(const u32x4*)(o0 + 8)}, bq[2] = {*(const u32x4*)o1, *(const u32x4*)(o1 + 8)}, g[2] = {*(const u32x4*)gp, *(const u32x4*)(gp + 8)};
        float o[16], gt[16]; float s1 = 0.f;
#pragma unroll
        for (int i = 0; i < 8; ++i) { const unsigned wa = a[i >> 2][i & 3], wb = bq[i >> 2][i & 3], wg = g[i >> 2][i & 3];
            o[2 * i] = bflo(wa) + bflo(wb); o[2 * i + 1] = bfhi(wa) + bfhi(wb); gt[2 * i] = bflo(wg); gt[2 * i + 1] = bfhi(wg); s1 += o[2 * i] + o[2 * i + 1]; }
        s1 += __shfl_xor(s1, 1); s1 += __shfl_xor(s1, 2); s1 += __shfl_xor(s1, 4);
        const float mean = isret ? s1 * (1.0f / 128.0f) : 0.f; float s2 = 0.f;
#pragma unroll
        for (int i = 0; i < 16; ++i) { o[i] -= mean; s2 += o[i] * o[i]; }
        s2 += __shfl_xor(s2, 1); s2 += __shfl_xor(s2, 2); s2 += __shfl_xor(s2, 4);
        const float rstd = rsqrtf(s2 * (1.0f / 128.0f) + NORM_EPS);
        float amax = 0.f;
#pragma unroll
        for (int i = 0; i < 16; ++i) { o[i] = o[i] * rstd * gn[i] * gt[i]; amax = fmaxf(amax, fabsf(o[i])); }
        amax = wave_max(amax); const float qs = amax > 0.f ? amax * (1.0f / 127.0f) : 1.0f, qi = 1.0f / qs;
        if (F.lane == 0) WSP(float, WS_ASC)[r] = qs;
        u32x4 w;
#pragma unroll
        for (int i = 0; i < 4; ++i) w[i] = q8pack(o[4 * i], o[4 * i + 1], o[4 * i + 2], o[4 * i + 3], qi);
        *(u32x4*)(WSP(signed char, WS_A8) + (size_t)r * 1024 + c0) = w;
    }
}
template <int NROWS, int LAYER>
__device__ __forceinline__ void phase_route(const Params& P, Frame& F, const float* H) {
    constexpr int RPB = NROWS / 256, NB = (RPB + 15) / 16, FS = 1028;
    LAS float* ftile = (LAS float*)F.lds;
    LAS float* part = (LAS float*)(F.lds + 16 * FS * 4);
    LAS int* hist = (LAS int*)(F.lds + 131072);
    if (F.tid < 32) hist[F.tid] = 0;
    const float* mod = WSP(float, WS_MOD); const float* wr = P.in[I_W_ROUTER] + (size_t)LAYER * 1024 * 32; const float* br = P.in[I_B_ROUTER] + LAYER * 32;
    const float* gain = P.in[I_NORM_FFN] + LAYER * 1024;
    int* tope = WSP(int, WS_TOPE); float* topg = WSP(float, WS_TOPG); int* rank = WSP(int, WS_RANK);
    const int l = F.lane, li = l & 15, lg = l >> 4;
    float wreg[2][32];
    { const float* wp = wr + (size_t)(128 * F.wave + 32 * lg) * 32 + li;
#pragma unroll
        for (int s2 = 0; s2 < 32; ++s2) { wreg[0][s2] = wp[s2 * 32]; wreg[1][s2] = wp[s2 * 32 + 16]; } }
    const int e = l & 31; const float bias = br[e];
    const int row0 = F.bid * RPB;
    __syncthreads();
    for (int bt = 0; bt < NB; ++bt) {
#pragma unroll
        for (int q = 0; q < 2; ++q) {
            const int rr = 2 * F.wave + q; const int lr = bt * 16 + rr; const bool valid = lr < RPB; const int r = row0 + (valid ? lr : 0);
            const float* src = H + (size_t)r * 1024; f32x4 v[4];
#pragma unroll
            for (int j = 0; j < 4; ++j) v[j] = *(const f32x4*)(src + 4 * l + 256 * j);
            float ss = 0.f;
#pragma unroll
            for (int j = 0; j < 4; ++j) ss += (v[j].x * v[j].x + v[j].y * v[j].y) + (v[j].z * v[j].z + v[j].w * v[j].w);
            const float rstd = rsqrtf(wave_sum(ss) * (1.0f / 1024.0f) + NORM_EPS);
            const float* m = mod + (size_t)(LAYER * 9 + mod_row(r)) * 6144; float amax = 0.f;
#pragma unroll
            for (int j = 0; j < 4; ++j) { const int c = 4 * l + 256 * j; const f32x4 gg = *(const f32x4*)(gain + c), s1 = *(const f32x4*)(m + 4096 + c), s0 = *(const f32x4*)(m + 3072 + c);
                const f32x4 a = v[j] * rstd * gg * (s1 + 1.0f) + s0; *(LAS f32x4*)(ftile + rr * FS + c) = a; v[j] = a;
                amax = fmaxf(amax, fmaxf(fmaxf(fabsf(a.x), fabsf(a.y)), fmaxf(fabsf(a.z), fabsf(a.w)))); }
            amax = wave_max(amax);
            const float qs = amax > 0.f ? amax * (1.0f / 127.0f) : 1.0f, qi = 1.0f / qs;
            if (valid) { signed char* orow = WSP(signed char, WS_F8) + (size_t)r * 1024; if (l == 0) WSP(float, WS_FSC)[r] = qs;
#pragma unroll
                for (int j = 0; j < 4; ++j) *(unsigned*)(orow + 4 * l + 256 * j) = q8pack(v[j].x, v[j].y, v[j].z, v[j].w, qi); }
        }
        __syncthreads();
        {
            f32x4 a0 = {0.f, 0.f, 0.f, 0.f}, a1 = {0.f, 0.f, 0.f, 0.f};
            const LAS float* fp = ftile + li * FS + 128 * F.wave + 32 * lg;
#pragma unroll
            for (int s4 = 0; s4 < 8; ++s4) { const f32x4 av = *(const LAS f32x4*)(fp + 4 * s4);
#pragma unroll
                for (int t = 0; t < 4; ++t) { a0 = __builtin_amdgcn_mfma_f32_16x16x4f32(av[t], wreg[0][4 * s4 + t], a0, 0, 0, 0); a1 = __builtin_amdgcn_mfma_f32_16x16x4f32(av[t], wreg[1][4 * s4 + t], a1, 0, 0, 0); } }
#pragma unroll
            for (int t = 0; t < 4; ++t) { part[(F.wave * 16 + 4 * lg + t) * 32 + li] = a0[t]; part[(F.wave * 16 + 4 * lg + t) * 32 + 16 + li] = a1[t]; }
        }
        __syncthreads();
#pragma unroll
        for (int q = 0; q < 2; ++q) {
            const int rr = 2 * F.wave + q; const int lr = bt * 16 + rr; if (lr >= RPB) continue;
            const int r = row0 + lr; float val = bias;
#pragma unroll
            for (int ww = 0; ww < 8; ++ww) val += part[(ww * 16 + rr) * 32 + e];
            float tv[4]; int ti[4];
#pragma unroll
            for (int k = 0; k < 4; ++k) { float mx = val;
#pragma unroll
                for (int o = 1; o < 32; o <<= 1) mx = fmaxf(mx, __shfl_xor(mx, o));
                const unsigned long long bal = __ballot(val == mx); const int idx = (__ffsll((long long)bal) - 1) & 31;
                tv[k] = mx; ti[k] = idx; if (e == idx) val = -3.0e38f; }
            const float e1 = __expf(tv[1] - tv[0]), e2 = __expf(tv[2] - tv[0]), e3 = __expf(tv[3] - tv[0]); const float inv = 1.0f / (1.0f + e1 + e2 + e3);
            if (l < 4) { const int k = l; const int ex = k == 0 ? ti[0] : k == 1 ? ti[1] : k == 2 ? ti[2] : ti[3]; const float gv = (k == 0 ? 1.0f : k == 1 ? e1 : k == 2 ? e2 : e3) * inv;
                const int rk = atomicAdd((int*)(hist + ex), 1);
                tope[r * 4 + k] = ex; topg[r * 4 + k] = gv; rank[r * 4 + k] = rk; }
        }
    }
    __syncthreads();
    if (F.tid < 32) WSP(int, WS_BCNT)[F.bid * 32 + F.tid] = hist[F.tid];
    __syncthreads();
}
template <int NROWS>
__device__ __forceinline__ void phase_scatter(const Params& P, Frame& F) {
    constexpr int RPB = NROWS / 256;
    LAS int* part_tot = (LAS int*)F.lds;
    LAS int* part_pre = part_tot + 512;
    LAS int* baseL = part_pre + 512;
    LAS int* padS = baseL + 32;
    LAS int* totL = padS + 40;
    const int* bcnt = WSP(int, WS_BCNT);
    { const int e = F.tid & 31, part = F.tid >> 5; int t = 0, pr = 0;
        for (int bb = part * 16; bb < part * 16 + 16; ++bb) { const int c = bcnt[bb * 32 + e]; t += c; if (bb < F.bid) pr += c; }
        part_tot[part * 32 + e] = t; part_pre[part * 32 + e] = pr; }
    __syncthreads();
    if (F.tid < 32) { int t = 0, pr = 0;
        for (int p = 0; p < 16; ++p) { t += part_tot[p * 32 + F.tid]; pr += part_pre[p * 32 + F.tid]; }
        totL[F.tid] = t; baseL[F.tid] = pr; }
    __syncthreads();
    if (F.tid == 0) { int run = 0; for (int e = 0; e < 32; ++e) { padS[e] = run; run += (totL[e] + 255) & ~255; } padS[32] = run; }
    __syncthreads();
    if (F.tid < 32) baseL[F.tid] += padS[F.tid];
    __syncthreads();
    const int* tope = WSP(int, WS_TOPE); const float* topg = WSP(float, WS_TOPG); const int* rank = WSP(int, WS_RANK);
    int* rtok = WSP(int, WS_RTOK); float* rgate = WSP(float, WS_RGATE);
    for (int a = F.tid; a < RPB * 4; a += NTHR) {
        const int r = F.bid * RPB + (a >> 2), k = a & 3; const int ex = tope[r * 4 + k]; const int dest = baseL[ex] + rank[r * 4 + k];
        { rtok[dest] = r * 4 + k; rgate[dest] = topg[r * 4 + k]; WSP(float, WS_RSC)[dest] = WSP(float, WS_FSC)[r]; }
    }
    if (F.bid < 32) { const int e = F.bid; const int s = padS[e] + totL[e], en = padS[e + 1]; for (int i = s + F.tid; i < en; i += NTHR) { rtok[i] = -1; rgate[i] = 0.f; WSP(float, WS_RSC)[i] = 0.f; } }
    if (F.bid == 32) { int* blke = WSP(int, WS_BLKE); const int nrb = padS[32] >> 8;
        for (int rb = F.tid; rb < MAXRB; rb += NTHR) { int ex = -1; if (rb < nrb) { const int row = rb << 8; ex = 0; for (int e = 1; e < 32; ++e) if (row >= padS[e]) ex = e; } blke[rb] = ex; }
        if (F.tid == 0) blke[MAXRB] = nrb; }
    __syncthreads();
}
__device__ __forceinline__ void load8(const bf16* p, float (&x)[8]) { const u32x4 w = *(const u32x4*)p;
#pragma unroll
    for (int i = 0; i < 4; ++i) { x[2 * i] = bflo(w[i]); x[2 * i + 1] = bfhi(w[i]); } }
__device__ __forceinline__ void store8(bf16* p, const float (&x)[8]) { u32x4 w;
#pragma unroll
    for (int i = 0; i < 4; ++i) w[i] = pk2(x[2 * i], x[2 * i + 1]);
    *(u32x4*)p = w; }
__device__ __forceinline__ void rope8(float (&x)[8], const float* cs  ) {
    const f32x4 c0 = *(const f32x4*)cs, c1 = *(const f32x4*)(cs + 4); float y[8];
    y[0] = x[0] * c0[0] - x[1] * c0[1]; y[1] = x[0] * c0[1] + x[1] * c0[0]; y[2] = x[2] * c0[2] - x[3] * c0[3]; y[3] = x[2] * c0[3] + x[3] * c0[2];
    y[4] = x[4] * c1[0] - x[5] * c1[1]; y[5] = x[4] * c1[1] + x[5] * c1[0]; y[6] = x[6] * c1[2] - x[7] * c1[3]; y[7] = x[6] * c1[3] + x[7] * c1[2];
#pragma unroll
    for (int i = 0; i < 8; ++i) x[i] = y[i];
}
template <int GL>
__device__ __forceinline__ void headnorm8(float (&x)[8], const float* gain8) {
    float ss = 0.f;
#pragma unroll
    for (int i = 0; i < 8; ++i) ss += x[i] * x[i];
#pragma unroll
    for (int o = 1; o < GL; o <<= 1) ss += __shfl_xor(ss, o);
    const float rstd = rsqrtf(ss * (1.0f / (8.0f * GL)) + NORM_EPS);
#pragma unroll
    for (int i = 0; i < 8; ++i) x[i] = x[i] * rstd * gain8[i];
}
__device__ __forceinline__ void phase_qkv(const Params& P, Frame& F) {
    const int gw = F.vcu * NWAVES + F.wave, NGW = 256 * NWAVES; const int l = F.lane;
    const bf16* PR = WSP(bf16, WS_PROJ); const float* r64 = WSP(float, WS_ROPE64); const float* r128 = WSP(float, WS_ROPE128);
    float gq[8], gk[8], gdq[8], gdk[8];
#pragma unroll
    for (int i = 0; i < 8; ++i) { gq[i] = P.in[I_ATT_Q_GAIN][(8 * l) % 128 + i]; gk[i] = P.in[I_ATT_K_GAIN][(8 * l) % 128 + i]; gdq[i] = P.in[I_DQ_GAIN][(8 * l) % 64 + i]; gdk[i] = P.in[I_DK_GAIN][(8 * l) % 64 + i]; }
    for (int r = gw; r < NTOK; r += NGW) {
        const bool lat = r < NLAT; const int rc = r - NLAT; const int b = lat ? (r >> 11) : (rc >> 8); const int t = r & 2047; const int pos = lat ? 256 + t : (rc & 255);
        const bf16* row = PR + (size_t)r * ATT_IN; float x[8];
        const int c128 = (8 * l) % 128, c64 = (8 * l) % 64;
        if (lat) {
            load8(row + 8 * l, x); headnorm8<16>(x, gq); rope8(x, r128 + ((size_t)t * 64 + c128 / 2) * 2);
            store8(WSP(bf16, WS_GQ) + ((size_t)(b * 4 + (l >> 4)) * 2048 + t) * 128 + c128, x);
        }
        {
            load8(row + 512 + 8 * l, x); float xn[8];
#pragma unroll
            for (int i = 0; i < 8; ++i) xn[i] = x[i];
            headnorm8<16>(xn, gk); if (lat) rope8(xn, r128 + ((size_t)t * 64 + c128 / 2) * 2);
            const int kvh = (l >> 4) & 1; const size_t off = ((size_t)(b * 2 + kvh) * 2304 + pos) * 128 + c128;
            if (l < 32) store8(WSP(bf16, WS_GK) + off, xn); else store8(WSP(bf16, WS_GV) + off, x);
        }
        if (lat) {
            load8(row + 1024 + 8 * l, x); headnorm8<8>(x, gdq); rope8(x, r64 + ((size_t)t * 32 + c64 / 2) * 2);
            store8(WSP(bf16, WS_DQ) + ((size_t)(b * 8 + (l >> 3)) * 2048 + t) * 64 + c64, x);
        }
        {
            load8(row + 1536 + 8 * l, x); headnorm8<8>(x, gdk); if (lat) rope8(x, r64 + ((size_t)t * 32 + c64 / 2) * 2);
            store8(WSP(bf16, WS_DK) + ((size_t)(b * 8 + (l >> 3)) * 2304 + pos) * 64 + c64, x);
        }
        {
            load8(row + 2048 + 8 * l, x);
            store8(WSP(bf16, WS_DV) + ((size_t)(b * 4 + (l >> 4)) * 2304 + pos) * 128 + c128, x);
        }
    }
}

namespace attn {
constexpr int DV = 128, NW = 8, QBLK = 32, KVBLK = 64, SKV = 2304;
constexpr float THR = 8.f;
constexpr int SHM_V = KVBLK * DV * 2, SHM_K = KVBLK * 128 * 2;
#define KSWZ(row, colB) ((row) * 256 + ((colB) ^ (((row) & 7) << 4)))
#define SBAR() __builtin_amdgcn_sched_barrier(0)
__device__ __forceinline__ int crow(int r, int hi) { return (r & 3) + 8 * (r >> 2) + 4 * hi; }
__device__ __forceinline__ unsigned cvtpk(float lo, float hi) { return pk2(lo, hi); }
template <int NQ> struct Cst { static constexpr float SCALE = NQ == 8 ? 0.088388347648318440f : 0.125f; };
template <int NQ>
__device__ __forceinline__ void partialSM(f32x16& p0, f32x16& p1, float& m_reg, float& mn, float& alpha) {
    constexpr float SCALE = Cst<NQ>::SCALE; constexpr float C = SCALE * 1.4426950408889634f;
    float pmax = p0[0];
#pragma unroll
    for (int r = 1; r < 16; ++r) pmax = fmaxf(pmax, p0[r]);
#pragma unroll
    for (int r = 0; r < 16; ++r) pmax = fmaxf(pmax, p1[r]);
    { auto rr = __builtin_amdgcn_permlane32_swap(__float_as_uint(pmax), __float_as_uint(pmax), false, false);
      pmax = fmaxf(__uint_as_float(rr[0]), __uint_as_float(rr[1])); }
    if (__builtin_expect(__all(pmax - m_reg <= THR / SCALE), 1)) { mn = m_reg; alpha = 1.f; }
    else { mn = fmaxf(m_reg, pmax); alpha = __builtin_amdgcn_exp2f((m_reg - mn) * C); m_reg = mn; }
    const float mnC = -mn * C;
#pragma unroll
    for (int r = 0; r < 16; ++r) p0[r] = fmaf(p0[r], C, mnC);
#pragma unroll
    for (int r = 0; r < 16; ++r) p1[r] = fmaf(p1[r], C, mnC);
#pragma unroll
    for (int r = 0; r < 16; ++r) p0[r] = __builtin_amdgcn_exp2f(p0[r]);
}
__device__ __forceinline__ void finishSM(f32x16& p0, f32x16& p1, float alpha, float& l_reg, bf16x8& pa0, bf16x8& pa1, bf16x8& pa2, bf16x8& pa3) {
#pragma unroll
    for (int r = 0; r < 16; ++r) p1[r] = __builtin_amdgcn_exp2f(p1[r]);
    float ps = 0;
#pragma unroll
    for (int r = 0; r < 16; ++r) ps += p0[r];
#pragma unroll
    for (int r = 0; r < 16; ++r) ps += p1[r];
    { auto rr = __builtin_amdgcn_permlane32_swap(__float_as_uint(ps), __float_as_uint(ps), false, false);
      ps = __uint_as_float(rr[0]) + __uint_as_float(rr[1]); }
    l_reg = l_reg * alpha + ps;
#define PK4(PP, BASE, OUT) do { unsigned a0 = cvtpk(PP[BASE + 0], PP[BASE + 1]), a1 = cvtpk(PP[BASE + 2], PP[BASE + 3]);   \
    unsigned b0 = cvtpk(PP[BASE + 4], PP[BASE + 5]), b1 = cvtpk(PP[BASE + 6], PP[BASE + 7]);                              \
    auto r0 = __builtin_amdgcn_permlane32_swap(a0, b0, false, false); auto r1 = __builtin_amdgcn_permlane32_swap(a1, b1, false, false); \
    u32x4 w = {r0[0], r1[0], r0[1], r1[1]}; OUT = *reinterpret_cast<bf16x8*>(&w); } while (0)
    PK4(p0, 0, pa0); PK4(p0, 8, pa1); PK4(p1, 0, pa2); PK4(p1, 8, pa3);
#undef PK4
}
template <int NQ>
__device__ __forceinline__ void qkt(f32x16& p0, f32x16& p1, const char* Ks, const bf16x8* qr, int r32, int hi) {
    p0 = f32x16{}; p1 = f32x16{};
#pragma unroll
    for (int d0 = 0; d0 < NQ; ++d0) { const int cb = (d0 * 16 + hi * 8) * 2;
        const bf16x8 b0 = *reinterpret_cast<const bf16x8*>(Ks + KSWZ(r32, cb));
        const bf16x8 b1 = *reinterpret_cast<const bf16x8*>(Ks + KSWZ(32 + r32, cb));
        p0 = __builtin_amdgcn_mfma_f32_32x32x16_bf16(b0, qr[d0], p0, 0, 0, 0);
        p1 = __builtin_amdgcn_mfma_f32_32x32x16_bf16(b1, qr[d0], p1, 0, 0, 0); }
}
__device__ __forceinline__ int v_st(int k, int c) { const int kk = (k & ~0xC) | ((k & 4) << 1) | ((k & 8) >> 1); return ((kk >> 3) * 4 + (c >> 5)) * 512 + ((kk & 7) * 32 + (c & 31)) * 2; }
__device__ __forceinline__ int v_rd_base(int lane) { return ((lane & 3) << 3) | (((lane >> 2) & 3) << 6) | (((lane >> 4) & 1) << 5) | (((lane >> 5) & 1) << 8); }
constexpr int v_rd_off(int d0, int ks, int half) { return d0 * 512 + ks * 4096 + half * 2048; }
template <int OFF> __device__ __forceinline__ s16x4 tr_read(int vb) {
    s16x4 r; asm volatile("ds_read_b64_tr_b16 %0, %1 offset:%2" : "=&v"(r) : "v"(vb), "i"(OFF) : "memory"); return r;
}
template <int D0> __device__ __forceinline__ void pv_one(f32x16& od, int vb, bf16x8 pa0, bf16x8 pa1, bf16x8 pa2, bf16x8 pa3) {
    const s16x4 l0 = tr_read<v_rd_off(D0, 0, 0)>(vb), h0 = tr_read<v_rd_off(D0, 0, 1)>(vb), l1 = tr_read<v_rd_off(D0, 1, 0)>(vb), h1 = tr_read<v_rd_off(D0, 1, 1)>(vb);
    const s16x4 l2 = tr_read<v_rd_off(D0, 2, 0)>(vb), h2 = tr_read<v_rd_off(D0, 2, 1)>(vb), l3 = tr_read<v_rd_off(D0, 3, 0)>(vb), h3 = tr_read<v_rd_off(D0, 3, 1)>(vb);
    asm volatile("s_waitcnt lgkmcnt(0)" ::: "memory"); SBAR();
#define PKV(L, H) (bf16x8){L[0], L[1], L[2], L[3], H[0], H[1], H[2], H[3]}
    od = __builtin_amdgcn_mfma_f32_32x32x16_bf16(pa0, PKV(l0, h0), od, 0, 0, 0);
    od = __builtin_amdgcn_mfma_f32_32x32x16_bf16(pa1, PKV(l1, h1), od, 0, 0, 0);
    od = __builtin_amdgcn_mfma_f32_32x32x16_bf16(pa2, PKV(l2, h2), od, 0, 0, 0);
    od = __builtin_amdgcn_mfma_f32_32x32x16_bf16(pa3, PKV(l3, h3), od, 0, 0, 0);
#undef PKV
}
__device__ __forceinline__ void pv_d0(f32x16* o, int vb, bf16x8 pa0, bf16x8 pa1, bf16x8 pa2, bf16x8 pa3) {
    pv_one<0>(o[0], vb, pa0, pa1, pa2, pa3); pv_one<1>(o[1], vb, pa0, pa1, pa2, pa3); pv_one<2>(o[2], vb, pa0, pa1, pa2, pa3); pv_one<3>(o[3], vb, pa0, pa1, pa2, pa3);
}
template <int NQ, int EPI>
__device__ __forceinline__ void attn_body(const bf16* __restrict__ Qb, const bf16* __restrict__ Kh, const bf16* __restrict__ Vh, bf16* __restrict__ Y, float* scratch, float lam, const float* dgain, char* lds) {
    constexpr int LDQ = NQ * 16, LDK = NQ * 16, LDV = DV;
    const int tid = threadIdx.x, wid = __builtin_amdgcn_readfirstlane(tid >> 6), lane = tid & 63, r32 = lane & 31, hi = lane >> 5;
    char* V_lds = lds; char* K_lds = lds + 2 * SHM_V;
    float* wsf = (float*)(lds + 2 * SHM_V + 2 * SHM_K) + wid * 64; float* li_l = wsf; float* al_l = wsf + 32;
    float m_reg = -1e30f, l_reg = 0; f32x16 o[4] = {}; bf16x8 qr[NQ];
    const bf16* Qw = Qb + (size_t)(wid * QBLK + r32) * LDQ + hi * 8;
#pragma unroll
    for (int d0 = 0; d0 < NQ; ++d0) qr[d0] = *reinterpret_cast<const bf16x8*>(Qw + d0 * 16);
    const int sr = tid >> 4, sc = (tid & 15) * 8, vst0 = v_st(sr, sc), vst1 = v_st(32 + sr, sc);
    const int kr = NQ == 8 ? sr : (tid >> 3), kc = NQ == 8 ? sc : (tid & 7) * 8;
    const int vb0 = (int)(uintptr_t)V_lds + v_rd_base(lane);
    struct { bf16x8 vs0, vs1, ks0, ks1; } sr_[2];
    const unsigned voff0 = (unsigned)(sr * LDV + sc) * 2u, voff1 = voff0 + 32u * LDV * 2u, koff0 = (unsigned)(kr * LDK + kc) * 2u, koff1 = koff0 + 32u * LDK * 2u;
#define SLOAD(i, k0) do { const char* _vb = (const char*)Vh + (size_t)(k0) * (LDV * 2); const char* _kb = (const char*)Kh + (size_t)(k0) * (LDK * 2); \
    sr_[i].vs0 = *reinterpret_cast<const bf16x8*>(_vb + voff0); sr_[i].vs1 = *reinterpret_cast<const bf16x8*>(_vb + voff1); \
    sr_[i].ks0 = *reinterpret_cast<const bf16x8*>(_kb + koff0); if (NQ == 8) sr_[i].ks1 = *reinterpret_cast<const bf16x8*>(_kb + koff1); } while (0)
#define SWRITE(b, i) do { *(bf16x8*)(V_lds + (b) * SHM_V + vst0) = sr_[i].vs0; *(bf16x8*)(V_lds + (b) * SHM_V + vst1) = sr_[i].vs1; \
    *(bf16x8*)(K_lds + (b) * SHM_K + KSWZ(kr, kc * 2)) = sr_[i].ks0; if (NQ == 8) *(bf16x8*)(K_lds + (b) * SHM_K + KSWZ(32 + kr, kc * 2)) = sr_[i].ks1; } while (0)
#define SWAIT() do { if (NQ == 8) asm volatile("s_waitcnt vmcnt(4)" ::: "memory"); else asm volatile("s_waitcnt vmcnt(3)" ::: "memory"); } while (0)
#define RESC(a) do { if (__any((a) < 1.f)) { if (hi == 0) al_l[r32] = (a); asm volatile("s_waitcnt lgkmcnt(0)" ::: "memory"); \
    _Pragma("unroll") for (int d = 0; d < 4; ++d) _Pragma("unroll") for (int r = 0; r < 16; ++r) o[d][r] *= al_l[crow(r, hi)]; } } while (0)
    f32x16 pA0, pA1, pB0, pB1; float mnA, mnB, alA, alB; bf16x8 pa0, pa1, pa2, pa3; constexpr int NT = SKV / KVBLK;
    constexpr int SE = 0, SO = 1;
    SLOAD(SE, 0); asm volatile("s_waitcnt vmcnt(0)" ::: "memory"); SWRITE(0, SE); __syncthreads();
    qkt<NQ>(pA0, pA1, K_lds, qr, r32, hi); partialSM<NQ>(pA0, pA1, m_reg, mnA, alA);
    SLOAD(SO, KVBLK); SLOAD(SE, 2 * KVBLK);
    SWAIT(); SWRITE(1, SO); __syncthreads();
    for (int j = 1; j + 1 < NT; j += 2) {
        SBAR(); qkt<NQ>(pB0, pB1, K_lds + SHM_K, qr, r32, hi);
        finishSM(pA0, pA1, alA, l_reg, pa0, pa1, pa2, pa3); SBAR();
        SLOAD(SO, (j + 2) * KVBLK); SBAR();
        pv_d0(o, vb0, pa0, pa1, pa2, pa3); partialSM<NQ>(pB0, pB1, m_reg, mnB, alB);
        __syncthreads(); SWAIT(); SWRITE(0, SE);
        RESC(alB); __syncthreads();
        SBAR(); qkt<NQ>(pA0, pA1, K_lds, qr, r32, hi);
        finishSM(pB0, pB1, alB, l_reg, pa0, pa1, pa2, pa3); SBAR();
        if (j + 3 < NT) SLOAD(SE, (j + 3) * KVBLK); SBAR();
        pv_d0(o, vb0 + (int)SHM_V, pa0, pa1, pa2, pa3); partialSM<NQ>(pA0, pA1, m_reg, mnA, alA);
        __syncthreads(); SWAIT(); SWRITE(1, SO);
        RESC(alA); __syncthreads();
    }
    SBAR(); qkt<NQ>(pB0, pB1, K_lds + SHM_K, qr, r32, hi);
    finishSM(pA0, pA1, alA, l_reg, pa0, pa1, pa2, pa3); SBAR();
    pv_d0(o, vb0, pa0, pa1, pa2, pa3); partialSM<NQ>(pB0, pB1, m_reg, mnB, alB);
    __syncthreads(); RESC(alB);
    finishSM(pB0, pB1, alB, l_reg, pa0, pa1, pa2, pa3); SBAR();
    pv_d0(o, vb0 + (int)SHM_V, pa0, pa1, pa2, pa3);
    if (hi == 0) li_l[r32] = l_reg; asm volatile("s_waitcnt lgkmcnt(0)" ::: "memory");
    float rli[16];
#pragma unroll
    for (int r = 0; r < 16; ++r) rli[r] = __builtin_amdgcn_rcpf(li_l[crow(r, hi)]);
    if (EPI == 0) {
        bf16* Yw = Y + (size_t)(wid * QBLK) * 1024;
#pragma unroll
        for (int r = 0; r < 16; ++r) { const int orow = crow(r, hi);
#pragma unroll
            for (int d0 = 0; d0 < 4; ++d0) Yw[(size_t)orow * 1024 + d0 * 32 + r32] = (bf16)(pk2(o[d0][r] * rli[r], 0.f) & 0xffffu); }
    } else if (EPI == 1) {
#pragma unroll
        for (int r = 0; r < 16; ++r)
#pragma unroll
            for (int d0 = 0; d0 < 4; ++d0) scratch[((wid * 16 + r) * 4 + d0) * 64 + lane] = o[d0][r] * rli[r];
    } else {
        bf16* Yw = Y + (size_t)(wid * QBLK) * 1024; float gn[4];
#pragma unroll
        for (int d0 = 0; d0 < 4; ++d0) gn[d0] = dgain[d0 * 32 + r32] * (1.0f - LAM_INIT);
#pragma unroll
        for (int r = 0; r < 16; ++r) { float od[4]; float ss = 0.f;
#pragma unroll
            for (int d0 = 0; d0 < 4; ++d0) { od[d0] = scratch[((wid * 16 + r) * 4 + d0) * 64 + lane] - lam * (o[d0][r] * rli[r]); ss += od[d0] * od[d0]; }
#pragma unroll
            for (int of = 1; of < 32; of <<= 1) ss += __shfl_xor(ss, of);
            const float rstd = rsqrtf(ss * (1.0f / 128.0f) + NORM_EPS); const int orow = crow(r, hi);
#pragma unroll
            for (int d0 = 0; d0 < 4; ++d0) Yw[(size_t)orow * 1024 + d0 * 32 + r32] = (bf16)(pk2(od[d0] * rstd * gn[d0], 0.f) & 0xffffu); }
    }
#undef SLOAD
#undef SWRITE
#undef SWAIT
#undef RESC
}
}
__device__ __forceinline__ void phase_attn(const Params& P, Frame& F) {
    char* lds = (char*)(unsigned char*)F.lds;
    float lam; { const float* lp = P.in[I_DLAMBDA]; const float a = wave_sum(lp[F.lane] * lp[64 + F.lane]), b = wave_sum(lp[128 + F.lane] * lp[192 + F.lane]); lam = __expf(a) - __expf(b) + LAM_INIT; }
    const int u = F.vcu; const int b = u >> 5, h = (u >> 3) & 3, qb = u & 7;
    bf16* Y = WSP(bf16, WS_ABF) + (size_t)(b * 2048 + qb * 256) * 1024;
#ifndef ATTN_TEST
#define ATTN_TEST 7
#endif
    if (ATTN_TEST & 1) {
        const bf16* Q = WSP(bf16, WS_GQ) + ((size_t)(b * 4 + h) * 2048 + qb * 256) * 128;
        const bf16* K = WSP(bf16, WS_GK) + (size_t)(b * 2 + (h >> 1)) * 2304 * 128; const bf16* V = WSP(bf16, WS_GV) + (size_t)(b * 2 + (h >> 1)) * 2304 * 128;
        attn::attn_body<8, 0>(Q, K, V, Y + h * 128, nullptr, 0.f, nullptr, lds);
        __syncthreads();
    }
    {
        float* scr = WSP(float, WS_O0) + (size_t)F.bid * 32768;
        const bf16* V = WSP(bf16, WS_DV) + (size_t)(b * 4 + h) * 2304 * 128;
        const bf16* Q0 = WSP(bf16, WS_DQ) + ((size_t)(b * 8 + 2 * h) * 2048 + qb * 256) * 64; const bf16* K0 = WSP(bf16, WS_DK) + (size_t)(b * 8 + 2 * h) * 2304 * 64;
        if (ATTN_TEST & 2) attn::attn_body<4, 1>(Q0, K0, V, nullptr, scr, 0.f, nullptr, lds);
        __syncthreads();
        if (ATTN_TEST & 4) attn::attn_body<4, 2>(Q0 + (size_t)2048 * 64, K0 + (size_t)2304 * 64, V, Y + 512 + h * 128, scr, lam, P.in[I_DGAIN], lds);
        __syncthreads();
    }
}
#ifndef MK_N_LAUNCHES
#define MK_N_LAUNCHES 1
#endif
constexpr int N_PHASES = 20;
__global__ void __launch_bounds__(NTHR, 2) hybrid_fwd(Params P) {
    extern __shared__ __attribute__((aligned(16))) unsigned char lds_raw[];
    Frame F;
    F.lds = (LAS unsigned char*)lds_raw; F.ws = P.ws;
    F.tid = threadIdx.x; F.lane = F.tid & 63; F.wave = __builtin_amdgcn_readfirstlane(F.tid >> 6);
    F.bid = blockIdx.x; F.vcu = (F.bid & 7) * 32 + (F.bid >> 3);
    volatile LAS unsigned* MISC = (volatile LAS unsigned*)(F.lds + MISC_OFF);
    for (int u = F.tid; u < (LDS_BYTES - LDSCTL_OFF) / 4; u += NTHR) ((LAS unsigned*)(F.lds + LDSCTL_OFF))[u] = 0u;
    __syncthreads();
    XcdBarrier bar; bar.bar = (unsigned*)(P.ws + WS_CTL) + CW_BAR; bar.x = 0; bar.st = nullptr;
    const int lo = P.ph_lo, hi = P.ph_hi;
    if (hi - lo > 1) bar = xcd_barrier_post((unsigned*)(P.ws + WS_CTL) + CW_BAR, MISC + 8);
#ifndef PHASE_MASK
#define PHASE_MASK 0xFFFFF
#endif
#define IN(k) (((PHASE_MASK >> (k)) & 1) && lo <= (k) && (k) < hi)
#ifndef DUP_MASK
#define DUP_MASK 0
#endif
#define REP(k)
#define MOE_TAB() const LAS int* blke_l = (const LAS int*)(F.lds + 132096); { int* g = WSP(int, WS_BLKE); for (int i = F.tid; i <= MAXRB; i += NTHR) ((LAS int*)(F.lds + 132096))[i] = __hip_atomic_load(g + i, RLX_AGENT); __syncthreads(); } \
    const int nrb_l = __builtin_amdgcn_readfirstlane(blke_l[MAXRB]);
#define SEAM(k) do { if (IN(k) && IN((k) + 1)) xcd_barrier(bar); } while (0)
    const float* mod = WSP(float, WS_MOD);
    if (IN(0)) REP(0) { phase_pre(P, F); } SEAM(0);
    if (IN(1)) REP(1) { phase_norm0(P, F); } SEAM(1);
    if (IN(2)) REP(2) {
        pg8::DenseOrder<1024> S; S.init(WSP(signed char, WS_A8), WSP(signed char, WS_WT_RECIN), NTOK, REC_IN, F.bid);
        pg8::EpiRecIn<true> E{WSP(bf16, WS_PROJ), WSP(float, WS_FF), WSP(float, WS_LB), WSP(float, WS_ROPE64), WSP(float, WS_ASC), WSP(float, WS_SDN)};
        pg8::gemm_phase(F.lds, S, E);
    } SEAM(2);
    if (IN(3)) REP(3) { phase_rec(P, F); } SEAM(3);
    if (IN(4)) REP(4) { phase_merge(P, F); } SEAM(4);
    if (IN(5)) REP(5) {
        pg8::DenseOrder<1024> S; S.init(WSP(signed char, WS_A8), WSP(signed char, WS_WT_RECOUT), NTOK, DM, F.bid);
        pg8::EpiResidual<true> E{P.in[I_X], P.in[I_CTX], WSP(float, WS_H1), mod + 2 * 1024, WSP(float, WS_ASC), WSP(float, WS_SDN) + 4096};
        pg8::gemm_phase(F.lds, S, E);
    } SEAM(5);
    if (IN(6)) REP(6) { phase_route<NTOK, 0>(P, F, WSP(float, WS_H1)); } SEAM(6);
    if (IN(7)) REP(7) { phase_scatter<NTOK>(P, F); } SEAM(7);
    if (IN(8)) REP(8) {
        MOE_TAB();
        pg8::MoeOrder<8, true, 1024> S{WSP(int, WS_RTOK), (const char*)WSP(signed char, WS_F8), (const char*)WSP(bf16, WS_WT_GU), blke_l, nrb_l, F.vcu};
        pg8::EpiSwigluI8 E{WSP(bf16, WS_H1S), P.in[I_B_GU], WSP(float, WS_RSC), WSP(float, WS_SGU)};
        pg8::gemm_phase(F.lds, S, E);
    } SEAM(8);
    if (IN(9)) REP(9) {
        MOE_TAB();
        pg8::MoeOrder<4, false, 2048> S{nullptr, (const char*)WSP(bf16, WS_H1S), (const char*)WSP(bf16, WS_WT_DN), blke_l, nrb_l, F.vcu};
        pg8::EpiMoeOut E{WSP(bf16, WS_YS), P.in[I_B_DOWN], WSP(int, WS_RTOK), WSP(float, WS_RGATE)};
        pg8::gemm_phase(F.lds, S, E);
    } SEAM(9);
    if (IN(10)) REP(10) { phase_norm1(P, F); } SEAM(10);
    if (IN(11)) REP(11) {
        pg8::DenseOrder<1024> S; S.init(WSP(signed char, WS_A8), WSP(signed char, WS_WT_ATTIN), NTOK, ATT_IN, F.bid);
        pg8::EpiBf16<true> E{WSP(bf16, WS_PROJ), ATT_IN, WSP(float, WS_ASC), WSP(float, WS_SDN) + 5120};
        pg8::gemm_phase(F.lds, S, E);
    } SEAM(11);
    if (IN(12)) REP(12) { phase_qkv(P, F); } SEAM(12);
    if (IN(13)) REP(13) { phase_attn(P, F); } SEAM(13);
    if (IN(14)) REP(14) {
        pg8::DenseOrder<2048> S; S.init(WSP(bf16, WS_ABF), WSP(bf16, WS_WT_ATTOUT), NLAT, DM, F.bid);
        pg8::EpiResidual<false> E{WSP(float, WS_H2), WSP(float, WS_H2) + (size_t)NLAT * 1024, WSP(float, WS_H3), mod + 9 * 6144 + 2 * 1024, nullptr, nullptr};
        pg8::gemm_phase(F.lds, S, E);
    } SEAM(14);
    if (IN(15)) REP(15) { phase_route<NLAT, 1>(P, F, WSP(float, WS_H3)); } SEAM(15);
    if (IN(16)) REP(16) { phase_scatter<NLAT>(P, F); } SEAM(16);
    if (IN(17)) REP(17) {
        MOE_TAB();
        pg8::MoeOrder<8, true, 1024> S{WSP(int, WS_RTOK), (const char*)WSP(signed char, WS_F8), (const char*)(WSP(signed char, WS_WT_GU) + (size_t)32 * 2048 * 1024), blke_l, nrb_l, F.vcu};
        pg8::EpiSwigluI8 E{WSP(bf16, WS_H1S), P.in[I_B_GU] + 32 * 2048, WSP(float, WS_RSC), WSP(float, WS_SGU) + 32 * 2048};
        pg8::gemm_phase(F.lds, S, E);
    } SEAM(17);
    if (IN(18)) REP(18) {
        MOE_TAB();
        pg8::MoeOrder<4, false, 2048> S{nullptr, (const char*)WSP(bf16, WS_H1S), (const char*)(WSP(bf16, WS_WT_DN) + (size_t)32 * 1024 * 1024), blke_l, nrb_l, F.vcu};
        pg8::EpiMoeOut E{WSP(bf16, WS_YS), P.in[I_B_DOWN] + 32 * 1024, WSP(int, WS_RTOK), WSP(float, WS_RGATE)};
        pg8::gemm_phase(F.lds, S, E);
    } SEAM(18);
    if (IN(19)) REP(19) { phase_final(P, F); }
#undef IN
#undef SEAM
}

extern "C" void kernel_launch(void* const* d_in, const int* in_sizes, int n_in, void* d_out, int out_size, void* d_ws, size_t ws_size, hipStream_t stream) {
    static int grid = 0;
    if (grid == 0) {
        if (n_in != 27 || out_size != NLAT * DM || ws_size < WS_END) { fprintf(stderr, "kernel_launch: unexpected shapes: n_in %d out %d ws %zu (need >= %zu)\n", n_in, out_size, ws_size, (size_t)WS_END); grid = -1; return; }
        int dev = 0, cus = 0;
        if (hipGetDevice(&dev) != hipSuccess || hipDeviceGetAttribute(&cus, hipDeviceAttributeMultiprocessorCount, dev) != hipSuccess) { grid = -1; return; }
        if (hipFuncSetAttribute((const void*)hybrid_fwd, hipFuncAttributeMaxDynamicSharedMemorySize, LDS_BYTES) != hipSuccess) { fprintf(stderr, "kernel_launch: hipFuncSetAttribute failed\n"); grid = -1; return; }
        if (cus != 256) fprintf(stderr, "kernel_launch: %d CUs (built for 256)\n", cus);
        grid = 256;
    }
    if (grid < 0) return;
    if (hipMemsetAsync((char*)d_ws + WS_CTL, 0, CTL_ZERO_BYTES, stream) != hipSuccess) return;
    Params p{};
    for (int i = 0; i < 27; ++i) p.in[i] = (const float*)d_in[i];
    p.out = (float*)d_out; p.ws = (unsigned char*)d_ws;
#ifndef DBG_STAGE
#define DBG_STAGE 0
#endif
    const int n_ph = DBG_STAGE == 1 ? 6 : DBG_STAGE == 2 ? 11 : DBG_STAGE == 3 ? 15 : DBG_STAGE == 4 ? 3 : DBG_STAGE == 5 ? 3 : DBG_STAGE == 6 ? 4 : DBG_STAGE == 7 ? 2 : DBG_STAGE == 8 ? 1 : N_PHASES;
#if MK_N_LAUNCHES == 1
    p.ph_lo = 0; p.ph_hi = n_ph;
    hipLaunchKernelGGL(hybrid_fwd, dim3(grid), dim3(NTHR), LDS_BYTES, stream, p);
#else
    for (int k = 0; k < n_ph; ++k) for (int rep = 0; rep < (((DUP_MASK >> k) & 1) ? 2 : 1); ++rep) { p.ph_lo = k; p.ph_hi = k + 1; hipLaunchKernelGGL(hybrid_fwd, dim3(grid), dim3(NTHR), LDS_BYTES, stream, p); }
#endif
    if (DBG_STAGE) { const size_t off = DBG_STAGE == 1 ? WS_H1 : DBG_STAGE == 2 ? WS_H2 : DBG_STAGE == 3 ? WS_H3 : DBG_STAGE == 4 ? WS_FF : DBG_STAGE == 5 ? WS_PROJ : DBG_STAGE == 6 ? WS_OREC : DBG_STAGE == 7 ? WS_ABF : WS_WT_GU; (void)hipMemcpyAsync(d_out, (char*)d_ws + off, DBG_STAGE == 7 ? (size_t)36 * MiB : (size_t)NLAT * DM * 4, hipMemcpyDeviceToDevice, stream); }
}
```
